# Optimizing an MI355X kernel written in HIP

```python
import math
import jax, jax.numpy as jnp
from jax import lax
import numpy as np

D_MODEL = 2048
BATCH = 2
SEQ = 8192
DEPTH = 1

D_MIX = D_MODEL
D_POOL = D_MIX // 2
D_SSM = D_MIX - D_POOL
POOL_WINDOWS = (2, 4, 8, 16)
N_POOL_GROUPS = len(POOL_WINDOWS)
POOL_GROUP = D_POOL // N_POOL_GROUPS
SSM_GROUP = 16
N_SSM_GROUPS = D_SSM // SSM_GROUP
SSM_STATE = 64
DT_MIN = 1e-3
DT_MAX = 1e-1
N_EXPERT_GROUPS = 4
EXPERTS_PER_GROUP = 8
N_EXPERTS = N_EXPERT_GROUPS * EXPERTS_PER_GROUP
TOP_K_INNER = 2
D_EXPERT = D_MODEL // 4
MOE_BLOCK = 128
LN_EPS = 1e-5

kernel_name = "hybrid_pool_s5_hmoe_deepnorm_encoder"


def layer_norm(h, g, b):
    hf = h.astype(jnp.float32)
    mu = jnp.mean(hf, axis=-1, keepdims=True)
    var = jnp.mean(jnp.square(hf - mu), axis=-1, keepdims=True)
    out = (hf - mu) * lax.rsqrt(var + LN_EPS) * g.astype(jnp.float32) + b.astype(jnp.float32)
    return out.astype(h.dtype)


def pool_mixer(u, pool_w, pool_scale):
    bsz, s, _ = u.shape
    uf = u.astype(jnp.float32)
    cs = jnp.concatenate([jnp.zeros((bsz, 1, D_POOL), jnp.float32), jnp.cumsum(uf, axis=1)], axis=1)
    pos = jnp.arange(s, dtype=jnp.int32)
    diffs = []
    for g, w in enumerate(POOL_WINDOWS):
        sl = slice(g * POOL_GROUP, (g + 1) * POOL_GROUP)
        lo = jnp.clip(pos - w // 2, 0, s)
        hi = jnp.clip(pos - w // 2 + w, 0, s)
        csg = cs[..., sl]
        cnt = (hi - lo).astype(jnp.float32)[None, :, None]
        mean = (csg[:, hi] - csg[:, lo]) / cnt
        diffs.append(mean - uf[..., sl])
    d = jnp.stack(diffs, axis=2).astype(u.dtype)
    y = jnp.einsum('bsgc,gcd->bsgd', d, pool_w).reshape(bsz, s, D_POOL)
    return y * pool_scale


def _complex_affine_combine(left, right):
    a1r, a1i, b1r, b1i = left
    a2r, a2i, b2r, b2i = right
    return (a1r * a2r - a1i * a2i,
            a1r * a2i + a1i * a2r,
            a2r * b1r - a2i * b1i + b2r,
            a2r * b1i + a2i * b1r + b2i)


def s5_bidirectional(u, a_re, a_im, log_dt, b_re, b_im, c_re, c_im, d_skip):
    bsz, s, _ = u.shape
    uf = u.astype(jnp.float32).reshape(bsz, s, N_SSM_GROUPS, SSM_GROUP).transpose(1, 0, 2, 3)
    y = d_skip.astype(jnp.float32).reshape(N_SSM_GROUPS, SSM_GROUP) * uf
    for dr in range(2):
        lr = a_re[dr].astype(jnp.float32)
        li = a_im[dr].astype(jnp.float32)
        dt = jnp.exp(log_dt[dr].astype(jnp.float32))[:, None]
        mag = jnp.exp(lr * dt)
        abar_r = mag * jnp.cos(li * dt)
        abar_i = mag * jnp.sin(li * dt)
        den = lr * lr + li * li
        zr = ((abar_r - 1.0) * lr + abar_i * li) / den
        zi = (abar_i * lr - (abar_r - 1.0) * li) / den
        br = b_re[dr].astype(jnp.float32)
        bi = b_im[dr].astype(jnp.float32)
        bbar_r = zr[..., None] * br - zi[..., None] * bi
        bbar_i = zr[..., None] * bi + zi[..., None] * br
        bu_r = jnp.einsum('sbgc,gpc->sbgp', uf, bbar_r)
        bu_i = jnp.einsum('sbgc,gpc->sbgp', uf, bbar_i)
        ar = jnp.broadcast_to(abar_r[None, None], (s, 1, N_SSM_GROUPS, SSM_STATE))
        ai = jnp.broadcast_to(abar_i[None, None], (s, 1, N_SSM_GROUPS, SSM_STATE))
        _, _, xr, xi = lax.associative_scan(_complex_affine_combine, (ar, ai, bu_r, bu_i),
                                            reverse=(dr == 1), axis=0)
        y = y + jnp.einsum('sbgp,gcp->sbgc', xr, c_re[dr].astype(jnp.float32)) \
              - jnp.einsum('sbgp,gcp->sbgc', xi, c_im[dr].astype(jnp.float32))
    return y.transpose(1, 0, 2, 3).reshape(bsz, s, D_SSM)


def hier_moe(h, router_g_w, router_g_b, router_e_w, router_e_b, w_gate, w_up, w_down):
    bsz, s, d = h.shape
    t = bsz * s
    xt = h.reshape(t, d)
    gl = (xt @ router_g_w).astype(jnp.float32) + router_g_b.astype(jnp.float32)
    gp = jax.nn.softmax(gl, axis=-1)
    grp = jnp.argmax(gl, axis=-1).astype(jnp.int32)
    p_grp = jnp.take_along_axis(gp, grp[:, None], axis=-1)
    el = (xt @ router_e_w).astype(jnp.float32) + router_e_b.astype(jnp.float32)
    el = el.reshape(t, N_EXPERT_GROUPS, EXPERTS_PER_GROUP)
    el_sel = jnp.take_along_axis(el, grp[:, None, None], axis=1)[:, 0]
    ep = jax.nn.softmax(el_sel, axis=-1)
    top_p, top_i = lax.top_k(ep, TOP_K_INNER)
    gate = p_grp * top_p / jnp.sum(top_p, axis=-1, keepdims=True)
    expert_id = grp[:, None] * EXPERTS_PER_GROUP + top_i.astype(jnp.int32)

    m = t * TOP_K_INNER
    e_flat = expert_id.reshape(m)
    tok = jnp.repeat(jnp.arange(t, dtype=jnp.int32), TOP_K_INNER)
    wt = gate.reshape(m)
    order = jnp.argsort(e_flat)
    e_sorted = e_flat[order]
    counts = jnp.bincount(e_flat, length=N_EXPERTS).astype(jnp.int32)
    starts = jnp.cumsum(counts) - counts
    pcounts = (counts + MOE_BLOCK - 1) // MOE_BLOCK * MOE_BLOCK
    pends = jnp.cumsum(pcounts)
    pstarts = pends - pcounts
    rank = jnp.arange(m, dtype=jnp.int32) - starts[e_sorted]
    dest = pstarts[e_sorted] + rank
    n_blocks = (m + MOE_BLOCK - 1) // MOE_BLOCK + N_EXPERTS
    n_slots = n_blocks * MOE_BLOCK
    slot_tok = jnp.full((n_slots,), t, jnp.int32).at[dest].set(tok[order])
    slot_w = jnp.zeros((n_slots,), jnp.float32).at[dest].set(wt[order])
    block_e = jnp.minimum(jnp.searchsorted(pends, jnp.arange(n_blocks, dtype=jnp.int32) * MOE_BLOCK,
                                           side='right'), N_EXPERTS - 1).astype(jnp.int32)
    x_pad = jnp.concatenate([xt, jnp.zeros((1, d), xt.dtype)], axis=0)
    xb = x_pad[slot_tok].reshape(n_blocks, MOE_BLOCK, d)

    def expert_block(args):
        xb_i, e = args
        hh = jax.nn.silu(xb_i @ w_gate[e]) * (xb_i @ w_up[e])
        return hh @ w_down[e]

    yb = lax.map(expert_block, (xb, block_e))
    yb = yb.reshape(n_slots, d).astype(jnp.float32) * slot_w[:, None]
    out = jnp.zeros((t + 1, d), jnp.float32).at[slot_tok].add(yb)[:t]
    return out.reshape(bsz, s, d).astype(h.dtype)


def setup_inputs(seed: int = 0) -> dict:
    key = jax.random.key(seed)
    ks = jax.random.split(key, 26)
    L = DEPTH
    f32 = jnp.float32
    beta = (8.0 * DEPTH) ** -0.25
    nrm = lambda k, shp, sc: jax.random.normal(k, shp, f32) * sc
    a_im_base = math.pi * jnp.arange(SSM_STATE, dtype=f32)
    return {
        "x": nrm(ks[0], (BATCH, SEQ, D_MODEL), 1.0),
        "w_in": nrm(ks[1], (L, D_MODEL, D_MIX), D_MODEL ** -0.5),
        "pool_w": nrm(ks[2], (L, N_POOL_GROUPS, POOL_GROUP, POOL_GROUP), POOL_GROUP ** -0.5),
        "pool_scale": 1.0 + nrm(ks[3], (L, D_POOL), 0.02),
        "ssm_a_re": -0.5 + nrm(ks[4], (L, 2, N_SSM_GROUPS, SSM_STATE), 0.01),
        "ssm_a_im": a_im_base + nrm(ks[5], (L, 2, N_SSM_GROUPS, SSM_STATE), 0.01),
        "ssm_log_dt": jax.random.uniform(ks[6], (L, 2, N_SSM_GROUPS), f32, math.log(DT_MIN), math.log(DT_MAX)),
        "ssm_b_re": nrm(ks[7], (L, 2, N_SSM_GROUPS, SSM_STATE, SSM_GROUP), (2 * SSM_GROUP) ** -0.5),
        "ssm_b_im": nrm(ks[8], (L, 2, N_SSM_GROUPS, SSM_STATE, SSM_GROUP), (2 * SSM_GROUP) ** -0.5),
        "ssm_c_re": nrm(ks[9], (L, 2, N_SSM_GROUPS, SSM_GROUP, SSM_STATE), SSM_STATE ** -0.5),
        "ssm_c_im": nrm(ks[10], (L, 2, N_SSM_GROUPS, SSM_GROUP, SSM_STATE), SSM_STATE ** -0.5),
        "ssm_d": nrm(ks[11], (L, D_SSM), 1.0),
        "glu_w": nrm(ks[12], (L, D_SSM, D_SSM), D_SSM ** -0.5),
        "glu_b": nrm(ks[13], (L, D_SSM), 0.01),
        "w_out": nrm(ks[14], (L, D_MIX, D_MODEL), beta * D_MIX ** -0.5),
        "ln1_g": 1.0 + nrm(ks[15], (L, D_MODEL), 0.02),
        "ln1_b": nrm(ks[16], (L, D_MODEL), 0.02),
        "router_g_w": nrm(ks[17], (L, D_MODEL, N_EXPERT_GROUPS), D_MODEL ** -0.5),
        "router_g_b": nrm(ks[18], (L, N_EXPERT_GROUPS), 0.01),
        "router_e_w": nrm(ks[19], (L, D_MODEL, N_EXPERTS), D_MODEL ** -0.5),
        "router_e_b": nrm(ks[20], (L, N_EXPERTS), 0.01),
        "w_gate": nrm(ks[21], (L, N_EXPERTS, D_MODEL, D_EXPERT), D_MODEL ** -0.5),
        "w_up": nrm(ks[22], (L, N_EXPERTS, D_MODEL, D_EXPERT), D_MODEL ** -0.5),
        "w_down": nrm(ks[23], (L, N_EXPERTS, D_EXPERT, D_MODEL), beta * D_EXPERT ** -0.5),
        "ln2_g": 1.0 + nrm(ks[24], (L, D_MODEL), 0.02),
        "ln2_b": nrm(ks[25], (L, D_MODEL), 0.02),
    }


def reference(x, w_in, pool_w, pool_scale, ssm_a_re, ssm_a_im, ssm_log_dt, ssm_b_re, ssm_b_im,
              ssm_c_re, ssm_c_im, ssm_d, glu_w, glu_b, w_out, ln1_g, ln1_b, router_g_w, router_g_b,
              router_e_w, router_e_b, w_gate, w_up, w_down, ln2_g, ln2_b):
    alpha = (2.0 * DEPTH) ** 0.25
    h = x
    for l in range(DEPTH):
        proj = h @ w_in[l]
        y_pool = pool_mixer(proj[..., :D_POOL], pool_w[l], pool_scale[l])
        y_ssm = s5_bidirectional(proj[..., D_POOL:], ssm_a_re[l], ssm_a_im[l], ssm_log_dt[l],
                                 ssm_b_re[l], ssm_b_im[l], ssm_c_re[l], ssm_c_im[l], ssm_d[l])
        y_ssm = jax.nn.gelu(y_ssm)
        y_ssm = (y_ssm * jax.nn.sigmoid(y_ssm @ glu_w[l].astype(jnp.float32)
                                        + glu_b[l].astype(jnp.float32))).astype(h.dtype)
        mix = jnp.concatenate([y_pool.astype(h.dtype), y_ssm], axis=-1) @ w_out[l]
        h = layer_norm(alpha * h + mix, ln1_g[l], ln1_b[l])
        ffn = hier_moe(h, router_g_w[l], router_g_b[l], router_e_w[l], router_e_b[l],
                       w_gate[l], w_up[l], w_down[l])
        h = layer_norm(alpha * h + ffn, ln2_g[l], ln2_b[l])
    return h
```

```cpp
#include <hip/hip_runtime.h>
#include <hip/hip_cooperative_groups.h>
#include <cstdio>
namespace cg = cooperative_groups;

#ifndef N_LAUNCH_MODE
#define N_LAUNCH_MODE 0
#endif
#ifndef NAIVE_MASK
#define NAIVE_MASK 0x00
#endif

typedef unsigned short bf16_t;
typedef short bf16x8 __attribute__((ext_vector_type(8)));
typedef float f32x4 __attribute__((ext_vector_type(4)));
typedef float f32x2 __attribute__((ext_vector_type(2)));
typedef unsigned u32x4 __attribute__((ext_vector_type(4)));
typedef unsigned u32x2 __attribute__((ext_vector_type(2)));

constexpr int T = 16384, D = 2048, S = 8192, NB = 2;
constexpr int DP = 1024, DS = 1024, NG = 64, GC = 16, NP = 64;
constexpr int NE = 32, DE = 512, NR = 36;
constexpr int MAXTILES = 161;
constexpr float LN_EPS = 1e-5f;
constexpr float ALPHA = 1.189207115002721f;

constexpr size_t MB = 1u << 20;
constexpr size_t WS_CTL = 0;
constexpr size_t WS_SSMP = 1 * MB;
constexpr size_t WS_RW = 3 * MB;
constexpr size_t WS_ROUTE = 4 * MB;
constexpr size_t WS_WIN = 6 * MB;
constexpr size_t WS_WOUT = 14 * MB;
constexpr size_t WS_GLU = 22 * MB;
constexpr size_t WS_POOLW = 24 * MB;
constexpr size_t WS_WGU = 25 * MB;
constexpr size_t WS_WD = 153 * MB;
constexpr size_t WS_XB = 217 * MB;
constexpr size_t WS_PROJ = 281 * MB;
constexpr size_t WS_DPOOL = 345 * MB;
constexpr size_t WS_YSSM = 377 * MB;
constexpr size_t WS_END = 409 * MB;

constexpr size_t RT_E = 0, RT_RANK = (size_t)T * 2 * 4, RT_GATE = (size_t)T * 4 * 4, RT_STOK = (size_t)T * 6 * 4, RT_SGATE = RT_STOK + (size_t)MAXTILES * 256 * 4;

constexpr int LDS_BYTES = 128 * 1024 + 4096;
constexpr int MISC_OFF = 128 * 1024;

struct Args { const float* in[26]; float* out; unsigned char* ws; int ph_lo, ph_hi; };

__device__ __forceinline__ float bf2f(bf16_t b) { return __uint_as_float(((unsigned)b) << 16); }
__device__ __forceinline__ float bflo(unsigned w) { return __uint_as_float(w << 16); }
__device__ __forceinline__ float bfhi(unsigned w) { return __uint_as_float(w & 0xffff0000u); }
__device__ __forceinline__ unsigned cvt_pk_bf16(float lo, float hi) { unsigned r; asm volatile("v_cvt_pk_bf16_f32 %0, %1, %2" : "=v"(r) : "v"(lo), "v"(hi)); return r; }
__device__ __forceinline__ float wave_sum(float v) {
#pragma unroll
    for (int o = 32; o >= 1; o >>= 1) v += __shfl_xor(v, o);
    return v;
}
__device__ __forceinline__ float gelu_tanh(float x) {
    const float u = 0.7978845608028654f * (x + 0.044715f * x * x * x);
    const float e = __expf(-2.0f * fabsf(u));
    float t = (1.0f - e) / (1.0f + e); t = u < 0.f ? -t : t;
    return 0.5f * x * (1.0f + t);
}
__device__ __forceinline__ float sigmoidf_(float z) { return 1.0f / (1.0f + __expf(-z)); }

struct Unit { int r0, c0, e, pad; };

template <class DS_>
__device__ void gemm_naive(const DS_& d) {
    const int tid = threadIdx.x, wid = tid >> 6, lane = tid & 63, wr = wid >> 2, wc = wid & 3, fr = lane & 15, fq = lane >> 4;
    const int K = d.K; const size_t ldb2 = (size_t)d.ldb * 2;
    for (int ui = blockIdx.x;; ui += gridDim.x) {
        Unit u; if (!d.get(ui, u)) break;
        f32x4 acc[2][2][4][2];
        const char* Bp = d.b_ptr(u);
#pragma unroll
        for (int ai = 0; ai < 2; ++ai)
#pragma unroll
            for (int m = 0; m < 4; ++m) {
                const int r = 128 * ai + 64 * wr + 16 * m + fr;
                const char* ap = d.A + d.a_off(u, r);
#pragma unroll
                for (int bj = 0; bj < 2; ++bj)
#pragma unroll
                    for (int n = 0; n < 2; ++n) {
                        const int c = 128 * bj + 32 * wc + 16 * n + 4 * fq;
                        const char* bp = Bp + (size_t)c * ldb2;
                        float s0 = 0.f, s1 = 0.f, s2 = 0.f, s3 = 0.f;
                        for (int k = 0; k < K; k += 8) {
                            const u32x4 av = *(const u32x4*)(ap + k * 2);
                            const u32x4 b0 = *(const u32x4*)(bp + k * 2), b1 = *(const u32x4*)(bp + ldb2 + k * 2), b2 = *(const u32x4*)(bp + 2 * ldb2 + k * 2), b3 = *(const u32x4*)(bp + 3 * ldb2 + k * 2);
#pragma unroll
                            for (int j = 0; j < 4; ++j) {
                                const float al = bflo(av[j]), ah = bfhi(av[j]);
                                s0 += al * bflo(b0[j]); s0 += ah * bfhi(b0[j]);
                                s1 += al * bflo(b1[j]); s1 += ah * bfhi(b1[j]);
                                s2 += al * bflo(b2[j]); s2 += ah * bfhi(b2[j]);
                                s3 += al * bflo(b3[j]); s3 += ah * bfhi(b3[j]);
                            }
                        }
                        acc[ai][bj][m][n] = (f32x4){s0, s1, s2, s3};
                    }
            }
        d.epi(acc, u, wr, wc, fr, fq);
    }
}

#define LAS __attribute__((address_space(3)))
constexpr int BK = 64, HALF = 128, HTB = HALF * BK * 2;
__device__ __forceinline__ int lds_byte(int r, int c) { const int st = (r >> 4) * 2 + (c >> 5), rr = r & 15, cc = c & 31, ob = rr * 64 + cc * 2; return st * 1024 + (ob ^ (((ob >> 9) & 1) << 5)); }
__device__ __forceinline__ void stage_rc(int b, int& R, int& C) { const int st = b / 1024, sb = b % 1024, swz = sb ^ (((sb >> 9) & 1) << 5); R = (st >> 1) * 16 + swz / 64; C = (st & 1) * 32 + (swz % 64) / 2; }

template <class DS_>
__device__ __forceinline__ void gemm_fast(LAS unsigned char* lds, const DS_& d) {
    const int tid = threadIdx.x, wid = __builtin_amdgcn_readfirstlane(tid >> 6), lane = tid & 63, wr = wid >> 2, wc = wid & 3, fr = lane & 15, fq = lane >> 4;
    const int K = d.K, nt = K / BK;
    int Rr[2], Cc[2]; unsigned voffB[2];
#pragma unroll
    for (int i = 0; i < 2; ++i) { stage_rc(tid * 16 + i * 8192, Rr[i], Cc[i]); voffB[i] = (unsigned)(Rr[i] * d.ldb + Cc[i]) * 2u; }
    const size_t kstep = (size_t)(BK * 2);
    const size_t hstepB = (size_t)HALF * d.ldb * 2;
    const unsigned ldsw = (unsigned)wid * 1024u;
    const int aoff = lds_byte(wr * 64 + fr, fq * 8), boff = lds_byte(wc * 32 + fr, fq * 8);
#define G_SA(b, h) (((b) * 2 + (h)) * HTB)
#define G_SB(b, h) ((4 + (b) * 2 + (h)) * HTB)
#define G_STAGE(bufoff, gbase, voff) do { _Pragma("unroll") for (int _i = 0; _i < 2; ++_i) \
        __builtin_amdgcn_global_load_lds((const unsigned*)((const char*)(gbase) + (voff)[_i]), (LAS unsigned*)(lds + (bufoff) + ldsw + _i * 8192), 16, 0, 0); } while (0)
#define G_LDA(dst, b, h) do { _Pragma("unroll") for (int m = 0; m < 4; ++m) _Pragma("unroll") for (int k = 0; k < 2; ++k) dst[m][k] = *(const LAS bf16x8*)(lds + G_SA(b, h) + aoff + m * 2048 + k * 1024); } while (0)
#define G_LDB(dst, b, h) do { _Pragma("unroll") for (int n = 0; n < 2; ++n) _Pragma("unroll") for (int k = 0; k < 2; ++k) dst[n][k] = *(const LAS bf16x8*)(lds + G_SB(b, h) + boff + n * 2048 + k * 1024); } while (0)
#define G_MMA(ai, bj, At, Bt) do { __builtin_amdgcn_s_setprio(1); _Pragma("unroll") for (int m = 0; m < 4; ++m) _Pragma("unroll") for (int n = 0; n < 2; ++n) _Pragma("unroll") for (int k = 0; k < 2; ++k) \
        acc[ai][bj][m][n] = __builtin_amdgcn_mfma_f32_16x16x32_bf16(Bt[n][k], At[m][k], acc[ai][bj][m][n], 0, 0, 0); __builtin_amdgcn_s_setprio(0); } while (0)
#define G_WAIT_V(n) asm volatile("s_waitcnt vmcnt(" #n ")" ::: "memory")
#define G_WAIT_L(n) asm volatile("s_waitcnt lgkmcnt(" #n ")" ::: "memory")
#define G_BAR __builtin_amdgcn_s_barrier()
#define G_SCHED __builtin_amdgcn_sched_barrier(0)
    Unit cur, nxt; int ui = blockIdx.x;
    if (!d.get(ui, cur)) return;
    f32x4 acc[2][2][4][2];
#pragma unroll
    for (int a_ = 0; a_ < 2; ++a_)
#pragma unroll
        for (int b_ = 0; b_ < 2; ++b_)
#pragma unroll
            for (int m = 0; m < 4; ++m)
#pragma unroll
                for (int n = 0; n < 2; ++n) acc[a_][b_][m][n] = (f32x4){0.f, 0.f, 0.f, 0.f};
    bf16x8 At[4][2], B0[2][2], B1[2][2];
    unsigned vA[2][2], nvA[2][2];
#pragma unroll
    for (int h = 0; h < 2; ++h)
#pragma unroll
        for (int i = 0; i < 2; ++i) vA[h][i] = d.a_off(cur, h * HALF + Rr[i]) + (unsigned)Cc[i] * 2u;
    const char* const Ab = d.A;
    const char* cB = d.b_ptr(cur);
    G_STAGE(G_SB(0, 0), cB, voffB); G_STAGE(G_SA(0, 0), Ab, vA[0]); G_STAGE(G_SB(0, 1), cB + hstepB, voffB); G_STAGE(G_SA(0, 1), Ab, vA[1]);
    if (wr == 1) G_BAR;
    G_WAIT_V(4); G_BAR;
    G_STAGE(G_SB(1, 0), cB + kstep, voffB); G_STAGE(G_SA(1, 0), Ab + kstep, vA[0]); G_STAGE(G_SB(1, 1), cB + hstepB + kstep, voffB);
    G_WAIT_V(6); G_BAR;
    for (;;) {
        const bool has_next = d.get(ui + (int)gridDim.x, nxt);
        const char* nB = has_next ? d.b_ptr(nxt) : cB;
#pragma unroll
        for (int h = 0; h < 2; ++h)
#pragma unroll
            for (int i = 0; i < 2; ++i) nvA[h][i] = has_next ? (d.a_off(nxt, h * HALF + Rr[i]) + (unsigned)Cc[i] * 2u) : vA[h][i];
        for (int t = 0; t < nt; t += 2) {
            const bool last = (t == nt - 2);
            const char* a1 = Ab + (size_t)(t + 1) * kstep;
            const char* a2 = last ? Ab : Ab + (size_t)(t + 2) * kstep; const char* b2 = last ? nB : cB + (size_t)(t + 2) * kstep;
            const char* a3 = a2 + kstep; const char* b3 = b2 + kstep;
            unsigned va2[2][2];
#pragma unroll
            for (int h = 0; h < 2; ++h)
#pragma unroll
                for (int i = 0; i < 2; ++i) va2[h][i] = last ? nvA[h][i] : vA[h][i];
            G_LDB(B0, 0, 0); G_SCHED; G_LDA(At, 0, 0); G_STAGE(G_SA(1, 1), a1, vA[1]);
            G_WAIT_L(8); G_BAR; G_WAIT_L(0); G_MMA(0, 0, At, B0); G_BAR; G_SCHED;
            G_LDB(B1, 0, 1); G_STAGE(G_SB(0, 0), b2, voffB);
            G_BAR; G_WAIT_L(0); G_MMA(0, 1, At, B1); G_BAR;
            G_LDA(At, 0, 1); G_STAGE(G_SA(0, 0), a2, va2[0]);
            G_BAR; G_WAIT_L(0); G_MMA(1, 0, At, B0); G_BAR; G_SCHED;
            G_STAGE(G_SB(0, 1), b2 + hstepB, voffB);
            G_WAIT_V(6); G_BAR; G_MMA(1, 1, At, B1); G_BAR;
            G_LDB(B0, 1, 0); G_SCHED; G_LDA(At, 1, 0); G_STAGE(G_SA(0, 1), a2, va2[1]);
            G_WAIT_L(8); G_BAR; G_WAIT_L(0); G_MMA(0, 0, At, B0); G_BAR; G_SCHED;
            G_LDB(B1, 1, 1); G_STAGE(G_SB(1, 0), b3, voffB);
            G_BAR; G_WAIT_L(0); G_MMA(0, 1, At, B1); G_BAR;
            G_LDA(At, 1, 1); G_STAGE(G_SA(1, 0), a3, va2[0]);
            G_BAR; G_WAIT_L(0); G_MMA(1, 0, At, B0); G_BAR; G_SCHED;
            G_STAGE(G_SB(1, 1), b3 + hstepB, voffB);
            G_WAIT_V(6); G_BAR; G_MMA(1, 1, At, B1); G_BAR;
        }
        d.epi(acc, cur, wr, wc, fr, fq);
        if (!has_next) break;
#pragma unroll
        for (int a_ = 0; a_ < 2; ++a_)
#pragma unroll
            for (int b_ = 0; b_ < 2; ++b_)
#pragma unroll
                for (int m = 0; m < 4; ++m)
#pragma unroll
                    for (int n = 0; n < 2; ++n) acc[a_][b_][m][n] = (f32x4){0.f, 0.f, 0.f, 0.f};
        cur = nxt; cB = nB; ui += (int)gridDim.x;
#pragma unroll
        for (int h = 0; h < 2; ++h)
#pragma unroll
            for (int i = 0; i < 2; ++i) vA[h][i] = nvA[h][i];
    }
    G_WAIT_V(0);
    if (wr == 0) G_BAR;
    G_BAR;
#undef G_SA
#undef G_SB
#undef G_STAGE
#undef G_LDA
#undef G_LDB
#undef G_MMA
#undef G_WAIT_V
#undef G_WAIT_L
#undef G_BAR
#undef G_SCHED
}
template <int BIT, class DS_>
__device__ __forceinline__ void gemm_run(unsigned char* lds, const DS_& d) {
    if constexpr ((NAIVE_MASK >> BIT) & 1) gemm_naive(d); else gemm_fast((LAS unsigned char*)lds, d);
}

__device__ __forceinline__ bool static_order(int L, int nM, int nN, int& pm, int& pn) {
    const int nwg = nM * nN; if (L >= nwg) return false;
    int wgid = L; { const int q = nwg / 8, r = nwg % 8, xcd = wgid % 8, off = wgid / 8; wgid = (xcd < r ? xcd * (q + 1) : r * (q + 1) + (xcd - r) * q) + off; }
    const int nig = 8 * nN, gid = wgid / nig, fm = gid * 8, gsz = (nM - fm) < 8 ? (nM - fm) : 8;
    pm = fm + ((wgid % nig) % gsz); pn = (wgid % nig) / gsz; return true;
}

#define EPI_LOOP_BEGIN _Pragma("unroll") for (int ai = 0; ai < 2; ++ai) _Pragma("unroll") for (int m = 0; m < 4; ++m) { const int lr = 128 * ai + 64 * wr + 16 * m + fr; \
    _Pragma("unroll") for (int bj = 0; bj < 2; ++bj) _Pragma("unroll") for (int n = 0; n < 2; ++n) { const int lc = 128 * bj + 32 * wc + 16 * n + 4 * fq; const f32x4 v = acc[ai][bj][m][n];
#define EPI_LOOP_END } }

struct DescProj {
    const char* A; const char* Bt; bf16_t* O; int K, ldb;
    __device__ bool get(int i, Unit& u) const { int pm, pn; if (!static_order(i, T / 256, D / 256, pm, pn)) return false; u.r0 = pm * 256; u.c0 = pn * 256; u.e = 0; u.pad = 0; return true; }
    __device__ unsigned a_off(const Unit& u, int r) const { return (unsigned)(u.r0 + r) * (unsigned)(D * 2); }
    __device__ const char* b_ptr(const Unit& u) const { return Bt + (size_t)u.c0 * D * 2; }
    __device__ void epi(const f32x4 (&acc)[2][2][4][2], const Unit& u, int wr, int wc, int fr, int fq) const {
        EPI_LOOP_BEGIN
            u32x2 w; w.x = cvt_pk_bf16(v[0], v[1]); w.y = cvt_pk_bf16(v[2], v[3]);
            *(u32x2*)(O + (size_t)(u.r0 + lr) * D + u.c0 + lc) = w;
        EPI_LOOP_END
    }
};
struct DescPool {
    const char* A; const char* Bt; bf16_t* O; const float* scale; int K, ldb;
    __device__ bool get(int i, Unit& u) const { if (i >= 256) return false; u.e = i & 3; u.r0 = (i >> 2) * 256; u.c0 = u.e * 256; u.pad = 0; return true; }
    __device__ unsigned a_off(const Unit& u, int r) const { return ((unsigned)(u.r0 + r) * (unsigned)DP + (unsigned)u.e * 256u) * 2u; }
    __device__ const char* b_ptr(const Unit& u) const { return Bt + (size_t)u.e * 256 * 256 * 2; }
    __device__ void epi(const f32x4 (&acc)[2][2][4][2], const Unit& u, int wr, int wc, int fr, int fq) const {
        EPI_LOOP_BEGIN
            const f32x4 sc = *(const f32x4*)(scale + u.c0 + lc);
            u32x2 w; w.x = cvt_pk_bf16(v[0] * sc[0], v[1] * sc[1]); w.y = cvt_pk_bf16(v[2] * sc[2], v[3] * sc[3]);
            *(u32x2*)(O + (size_t)(u.r0 + lr) * D + u.c0 + lc) = w;
        EPI_LOOP_END
    }
};
struct DescGlu {
    const char* A; const char* Bt; bf16_t* O; const float* bias; int K, ldb;
    __device__ bool get(int i, Unit& u) const { int pm, pn; if (!static_order(i, T / 256, DS / 256, pm, pn)) return false; u.r0 = pm * 256; u.c0 = pn * 256; u.e = 0; u.pad = 0; return true; }
    __device__ unsigned a_off(const Unit& u, int r) const { return (unsigned)(u.r0 + r) * (unsigned)(DS * 2); }
    __device__ const char* b_ptr(const Unit& u) const { return Bt + (size_t)u.c0 * DS * 2; }
    __device__ void epi(const f32x4 (&acc)[2][2][4][2], const Unit& u, int wr, int wc, int fr, int fq) const {
        EPI_LOOP_BEGIN
            const f32x4 bv = *(const f32x4*)(bias + u.c0 + lc);
            const u32x2 yw = *(const u32x2*)(A + ((size_t)(u.r0 + lr) * DS + u.c0 + lc) * 2);
            const float y0 = bflo(yw.x), y1 = bfhi(yw.x), y2 = bflo(yw.y), y3 = bfhi(yw.y);
            u32x2 w; w.x = cvt_pk_bf16(y0 * sigmoidf_(v[0] + bv[0]), y1 * sigmoidf_(v[1] + bv[1])); w.y = cvt_pk_bf16(y2 * sigmoidf_(v[2] + bv[2]), y3 * sigmoidf_(v[3] + bv[3]));
            *(u32x2*)(O + (size_t)(u.r0 + lr) * D + DP + u.c0 + lc) = w;
        EPI_LOOP_END
    }
};
struct DescOut {
    const char* A; const char* Bt; float* O; const float* X; int K, ldb;
    __device__ bool get(int i, Unit& u) const { int pm, pn; if (!static_order(i, T / 256, D / 256, pm, pn)) return false; u.r0 = pm * 256; u.c0 = pn * 256; u.e = 0; u.pad = 0; return true; }
    __device__ unsigned a_off(const Unit& u, int r) const { return (unsigned)(u.r0 + r) * (unsigned)(D * 2); }
    __device__ const char* b_ptr(const Unit& u) const { return Bt + (size_t)u.c0 * D * 2; }
    __device__ void epi(const f32x4 (&acc)[2][2][4][2], const Unit& u, int wr, int wc, int fr, int fq) const {
        EPI_LOOP_BEGIN
            const size_t o = (size_t)(u.r0 + lr) * D + u.c0 + lc;
            const f32x4 xv = *(const f32x4*)(X + o);
            *(f32x4*)(O + o) = xv * ALPHA + v;
        EPI_LOOP_END
    }
};
struct MoeTab { const int* tstart; };
__device__ __forceinline__ int moe_expert_of_tile(const int* tstart, int tile) { int e = 0;
#pragma unroll 1
    for (int j = 1; j < NE; ++j) e += (tile >= tstart[j]) ? 1 : 0;
    return e; }
struct DescGU {
    const char* A; const char* Bt; bf16_t* O; const int* slot_tok; const int* tstart; int K, ldb;
    __device__ bool get(int i, Unit& u) const { const int nt = tstart[NE]; if (i >= nt * 4) return false; const int tile = i >> 2; u.r0 = tile * 256; u.c0 = (i & 3) * 256; u.e = moe_expert_of_tile(tstart, tile); u.pad = 0; return true; }
    __device__ unsigned a_off(const Unit& u, int r) const { int t = slot_tok[u.r0 + r]; t = t < 0 ? 0 : t; return (unsigned)t * (unsigned)(D * 2); }
    __device__ const char* b_ptr(const Unit& u) const { return Bt + ((size_t)u.e * 1024 + u.c0) * D * 2; }
    __device__ void epi(const f32x4 (&acc)[2][2][4][2], const Unit& u, int wr, int wc, int fr, int fq) const {
#pragma unroll
        for (int ai = 0; ai < 2; ++ai)
#pragma unroll
            for (int m = 0; m < 4; ++m) { const int lr = 128 * ai + 64 * wr + 16 * m + fr;
#pragma unroll
                for (int n = 0; n < 2; ++n) { const int lc = 32 * wc + 16 * n + 4 * fq; const f32x4 g = acc[ai][0][m][n], up = acc[ai][1][m][n];
                    f32x4 h;
#pragma unroll
                    for (int j = 0; j < 4; ++j) h[j] = g[j] * sigmoidf_(g[j]) * up[j];
                    u32x2 w; w.x = cvt_pk_bf16(h[0], h[1]); w.y = cvt_pk_bf16(h[2], h[3]);
                    *(u32x2*)(O + (size_t)(u.r0 + lr) * DE + (u.c0 >> 1) + lc) = w; } }
    }
};
struct DescDown {
    const char* A; const char* Bt; float* O; const int* slot_tok; const float* slot_gate; const int* tstart; int K, ldb;
    __device__ bool get(int i, Unit& u) const { const int nt = tstart[NE]; if (i >= nt * 8) return false; const int tile = i >> 3; u.r0 = tile * 256; u.c0 = (i & 7) * 256; u.e = moe_expert_of_tile(tstart, tile); u.pad = 0; return true; }
    __device__ unsigned a_off(const Unit& u, int r) const { return (unsigned)(u.r0 + r) * (unsigned)(DE * 2); }
    __device__ const char* b_ptr(const Unit& u) const { return Bt + ((size_t)u.e * D + u.c0) * DE * 2; }
    __device__ void epi(const f32x4 (&acc)[2][2][4][2], const Unit& u, int wr, int wc, int fr, int fq) const {
#pragma unroll
        for (int ai = 0; ai < 2; ++ai)
#pragma unroll
            for (int m = 0; m < 4; ++m) { const int lr = 128 * ai + 64 * wr + 16 * m + fr; const int tok = slot_tok[u.r0 + lr]; const float gt = slot_gate[u.r0 + lr];
                if (tok >= 0) {
#pragma unroll
                    for (int bj = 0; bj < 2; ++bj)
#pragma unroll
                        for (int n = 0; n < 2; ++n) { const int lc = 128 * bj + 32 * wc + 16 * n + 4 * fq; const f32x4 v = acc[ai][bj][m][n]; float* p = O + (size_t)tok * D + u.c0 + lc;
#pragma unroll
                            for (int j = 0; j < 4; ++j) unsafeAtomicAdd(p + j, gt * v[j]); } } }
    }
};

__device__ __forceinline__ void tr_job(const Args& a, int j, const float*& src, int& lds_, bf16_t*& dst, int& ldd) {
    unsigned char* ws = a.ws;
    if (j < 1024) { const int kt = j >> 5, nt = j & 31; src = a.in[1] + (size_t)kt * 64 * D + nt * 64; lds_ = D; dst = (bf16_t*)(ws + WS_WIN) + (size_t)nt * 64 * D + kt * 64; ldd = D; return; }
    j -= 1024;
    if (j < 1024) { const int kt = j >> 5, nt = j & 31; src = a.in[14] + (size_t)kt * 64 * D + nt * 64; lds_ = D; dst = (bf16_t*)(ws + WS_WOUT) + (size_t)nt * 64 * D + kt * 64; ldd = D; return; }
    j -= 1024;
    if (j < 256) { const int kt = j >> 4, nt = j & 15; src = a.in[12] + (size_t)kt * 64 * DS + nt * 64; lds_ = DS; dst = (bf16_t*)(ws + WS_GLU) + (size_t)nt * 64 * DS + kt * 64; ldd = DS; return; }
    j -= 256;
    if (j < 64) { const int g = j >> 4, r = j & 15, kt = r >> 2, nt = r & 3; src = a.in[2] + (size_t)g * 65536 + kt * 64 * 256 + nt * 64; lds_ = 256; dst = (bf16_t*)(ws + WS_POOLW) + (size_t)g * 65536 + nt * 64 * 256 + kt * 64; ldd = 256; return; }
    j -= 64;
    if (j < 16384) { const int up = j >= 8192; if (up) j -= 8192; const int e = j >> 8, r = j & 255, kt = r >> 3, nt = r & 7, n0 = nt * 64;
        src = (up ? a.in[22] : a.in[21]) + (size_t)e * D * DE + (size_t)kt * 64 * DE + n0; lds_ = DE;
        const int drow = (n0 >> 7) * 256 + (n0 & 127) + (up ? 128 : 0);
        dst = (bf16_t*)(ws + WS_WGU) + ((size_t)e * 1024 + drow) * D + kt * 64; ldd = D; return; }
    j -= 16384;
    { const int e = j >> 8, r = j & 255, kt = r >> 5, nt = r & 31; src = a.in[23] + (size_t)e * DE * D + (size_t)kt * 64 * D + nt * 64; lds_ = D;
      dst = (bf16_t*)(ws + WS_WD) + ((size_t)e * D + nt * 64) * DE + kt * 64; ldd = DE; }
}
constexpr int TR_JOBS = 1024 + 1024 + 256 + 64 + 16384 + 8192;

__device__ void p0_prepass(const Args& a, unsigned char* lds) {
    const int tid = threadIdx.x, G = gridDim.x, bid = blockIdx.x;
    unsigned char* ws = a.ws;
    if (bid == 0 && tid < 64) ((unsigned*)(ws + WS_CTL))[tid] = 0u;
    {
        const f32x4* x4 = (const f32x4*)a.in[0]; u32x4* xb = (u32x4*)(ws + WS_XB);
        const size_t n8 = (size_t)T * D / 8, stride = (size_t)G * 512;
        for (size_t i = (size_t)bid * 512 + tid; i < n8; i += 4 * stride) {
            f32x4 v[8];
#pragma unroll
            for (int q = 0; q < 4; ++q) { const size_t ii = i + q * stride; if (ii < n8) { v[2 * q] = x4[2 * ii]; v[2 * q + 1] = x4[2 * ii + 1]; } }
#pragma unroll
            for (int q = 0; q < 4; ++q) { const size_t ii = i + q * stride; if (ii < n8) { u32x4 o; o.x = cvt_pk_bf16(v[2 * q][0], v[2 * q][1]); o.y = cvt_pk_bf16(v[2 * q][2], v[2 * q][3]);
                o.z = cvt_pk_bf16(v[2 * q + 1][0], v[2 * q + 1][1]); o.w = cvt_pk_bf16(v[2 * q + 1][2], v[2 * q + 1][3]); xb[ii] = o; } }
        }
    }
    {
        float* tl = (float*)lds;
        const int lr = tid >> 4, lc4 = (tid & 15) * 4;
        const int on = tid >> 3, okg = (tid & 7) * 8;
        for (int jg = bid * 4; jg < TR_JOBS; jg += G * 4) {
            f32x4 v[4][2]; bf16_t* dst[4]; int ldd[4];
#pragma unroll
            for (int q = 0; q < 4; ++q) { const float* src; int ls; tr_job(a, jg + q, src, ls, dst[q], ldd[q]);
                v[q][0] = *(const f32x4*)(src + (size_t)lr * ls + lc4); v[q][1] = *(const f32x4*)(src + (size_t)(lr + 32) * ls + lc4); }
            __syncthreads();
#pragma unroll
            for (int q = 0; q < 4; ++q) { float* t0 = tl + q * 64 * 65;
#pragma unroll
                for (int e = 0; e < 4; ++e) { t0[lr * 65 + lc4 + e] = v[q][0][e]; t0[(lr + 32) * 65 + lc4 + e] = v[q][1][e]; } }
            __syncthreads();
#pragma unroll
            for (int q = 0; q < 4; ++q) { const float* t0 = tl + q * 64 * 65; float f[8];
#pragma unroll
                for (int e = 0; e < 8; ++e) f[e] = t0[(okg + e) * 65 + on];
                u32x4 o; o.x = cvt_pk_bf16(f[0], f[1]); o.y = cvt_pk_bf16(f[2], f[3]); o.z = cvt_pk_bf16(f[4], f[5]); o.w = cvt_pk_bf16(f[6], f[7]);
                *(u32x4*)(dst[q] + (size_t)on * ldd[q] + okg) = o; }
        }
        __syncthreads();
    }
    {
        f32x2* abar = (f32x2*)(ws + WS_SSMP); f32x2* bbar = (f32x2*)(ws + WS_SSMP + 65536);
        for (int i = bid * 512 + tid; i < 2 * NG * NP; i += G * 512) {
            const int dg = i >> 6;
            const float lre = a.in[4][i], lim = a.in[5][i], dt = expf(a.in[6][dg]);
            const float mag = expf(lre * dt), ar = mag * cosf(lim * dt), ai = mag * sinf(lim * dt);
            const float den = lre * lre + lim * lim;
            const float zr = ((ar - 1.0f) * lre + ai * lim) / den, zi = (ai * lre - (ar - 1.0f) * lim) / den;
            abar[i] = (f32x2){ar, ai};
#pragma unroll
            for (int c = 0; c < GC; ++c) { const float br = a.in[7][(size_t)i * GC + c], bi = a.in[8][(size_t)i * GC + c];
                bbar[(size_t)i * GC + c] = (f32x2){zr * br - zi * bi, zr * bi + zi * br}; }
        }
    }
    {
        float* rw = (float*)(ws + WS_RW);
        for (int i = bid * 512 + tid; i < NR * D; i += G * 512) { const int j = i / D, k = i % D; rw[i] = j < 4 ? a.in[17][k * 4 + j] : a.in[19][k * NE + (j - 4)]; }
    }
}

__device__ void p2_pooldiff(const Args& a) {
    const bf16_t* proj = (const bf16_t*)(a.ws + WS_PROJ); bf16_t* dp = (bf16_t*)(a.ws + WS_DPOOL);
    const int n = T * (DP / 8);
    for (int i = blockIdx.x * 512 + threadIdx.x; i < n; i += gridDim.x * 512) {
        const int t = i >> 7, c8 = (i & 127) * 8, s = t & (S - 1), g = c8 >> 8, w = 2 << g, hw = w >> 1;
        int lo = s - hw, hi = s - hw + w; lo = lo < 0 ? 0 : lo; hi = hi > S ? S : hi;
        float sum[8];
#pragma unroll
        for (int e = 0; e < 8; ++e) sum[e] = 0.f;
        const bf16_t* base = proj + (size_t)(t - s) * D + c8;
        for (int q = lo; q < hi; ++q) { const u32x4 v = *(const u32x4*)(base + (size_t)q * D);
#pragma unroll
            for (int e = 0; e < 4; ++e) { sum[2 * e] += bflo(v[e]); sum[2 * e + 1] += bfhi(v[e]); } }
        const float inv = 1.0f / (float)(hi - lo);
        const u32x4 self = *(const u32x4*)(base + (size_t)s * D);
        u32x4 o;
#pragma unroll
        for (int e = 0; e < 4; ++e) o[e] = cvt_pk_bf16(sum[2 * e] * inv - bflo(self[e]), sum[2 * e + 1] * inv - bfhi(self[e]));
        *(u32x4*)(dp + (size_t)t * DP + c8) = o;
    }
}

__device__ void p2_ssm_naive(const Args& a, unsigned char* lds) {
    const int tid = threadIdx.x, wid = tid >> 6, lane = tid & 63;
    unsigned char* ws = a.ws;
    const bf16_t* proj = (const bf16_t*)(ws + WS_PROJ); float* yf = (float*)(ws + WS_XB); bf16_t* yssm = (bf16_t*)(ws + WS_YSSM);
    const f32x2* abar = (const f32x2*)(ws + WS_SSMP); const f32x2* bbar = (const f32x2*)(ws + WS_SSMP + 65536);
    float* U = (float*)lds;
    f32x2* BX = (f32x2*)(lds + 4096);
    f32x2* Cm = (f32x2*)(lds + 4096 + 64 * 65 * 8);
    for (int job = blockIdx.x; job < NB * NG; job += gridDim.x) {
        const int b = job >> 6, g = job & 63;
        for (int dr = 0; dr < 2; ++dr) {
            __syncthreads();
            for (int i = tid; i < GC * NP; i += 512) { const size_t o = ((size_t)(dr * NG + g) * GC) * NP + i; Cm[i] = (f32x2){a.in[9][o], a.in[10][o]}; }
            const int p = lane;
            f32x2 bb[GC];
#pragma unroll
            for (int c = 0; c < GC; ++c) bb[c] = bbar[((size_t)(dr * NG + g) * NP + p) * GC + c];
            const f32x2 ab = abar[(dr * NG + g) * NP + p];
            float xr = 0.f, xi = 0.f;
            for (int ci = 0; ci < S / 64; ++ci) {
                const int chunk = dr == 0 ? ci : (S / 64 - 1 - ci); const size_t t0 = (size_t)b * S + (size_t)chunk * 64;
                __syncthreads();
                if (tid < 256) { const int t = tid >> 2, c4 = (tid & 3) * 4; const u32x2 v = *(const u32x2*)(proj + (t0 + t) * D + DP + g * GC + c4);
                    U[t * 16 + c4] = bflo(v.x); U[t * 16 + c4 + 1] = bfhi(v.x); U[t * 16 + c4 + 2] = bflo(v.y); U[t * 16 + c4 + 3] = bfhi(v.y); }
                __syncthreads();
#pragma unroll 1
                for (int tt = 0; tt < 8; ++tt) { const int t = wid * 8 + tt; float sr = 0.f, si = 0.f;
#pragma unroll
                    for (int c = 0; c < GC; ++c) { const float uv = U[t * 16 + c]; sr += bb[c].x * uv; si += bb[c].y * uv; }
                    BX[t * 65 + p] = (f32x2){sr, si}; }
                __syncthreads();
                if (wid == 0) {
#pragma unroll 1
                    for (int q = 0; q < 64; ++q) { const int t = dr == 0 ? q : 63 - q; const f32x2 bu = BX[t * 65 + p];
                        const float nr = ab.x * xr - ab.y * xi + bu.x, ni = ab.x * xi + ab.y * xr + bu.y; xr = nr; xi = ni; BX[t * 65 + p] = (f32x2){xr, xi}; }
                }
                __syncthreads();
                if (tid < 256) { const int t = tid >> 2, c4 = (tid & 3) * 4; float o[4];
#pragma unroll
                    for (int cc = 0; cc < 4; ++cc) { float s = 0.f;
#pragma unroll 8
                        for (int q = 0; q < NP; ++q) { const f32x2 cv = Cm[(c4 + cc) * NP + q], xv = BX[t * 65 + q]; s += cv.x * xv.x - cv.y * xv.y; }
                        o[cc] = s; }
                    const size_t oi = (t0 + t) * DS + g * GC + c4;
                    if (dr == 0) { f32x4 r;
#pragma unroll
                        for (int cc = 0; cc < 4; ++cc) r[cc] = o[cc] + a.in[11][g * GC + c4 + cc] * U[t * 16 + c4 + cc];
                        *(f32x4*)(yf + oi) = r; }
                    else { const f32x4 r = *(const f32x4*)(yf + oi); u32x2 w2; w2.x = cvt_pk_bf16(gelu_tanh(r[0] + o[0]), gelu_tanh(r[1] + o[1])); w2.y = cvt_pk_bf16(gelu_tanh(r[2] + o[2]), gelu_tanh(r[3] + o[3]));
                        *(u32x2*)(yssm + oi) = w2; } }
            }
        }
    }
}

__device__ void p5_ln1_router(const Args& a) {
    const int tid = threadIdx.x, wid = tid >> 6, lane = tid & 63;
    unsigned char* ws = a.ws;
    float* out = a.out; bf16_t* h1b = (bf16_t*)(ws + WS_PROJ); const float* rw = (const float*)(ws + WS_RW);
    const float* g1 = a.in[15]; const float* b1 = a.in[16];
    unsigned* cnt = (unsigned*)(ws + WS_CTL);
    int* tok_e = (int*)(ws + WS_ROUTE + RT_E); int* tok_rank = (int*)(ws + WS_ROUTE + RT_RANK); float* tok_gate = (float*)(ws + WS_ROUTE + RT_GATE);
    const int nw = gridDim.x * 8;
    constexpr int TPW = 2;
    for (int tg = blockIdx.x * 8 + wid; tg < T / TPW; tg += nw) {
        f32x4 h[TPW][8];
#pragma unroll
        for (int q = 0; q < TPW; ++q) {
            float* row = out + (size_t)(tg * TPW + q) * D; float s = 0.f;
#pragma unroll
            for (int i = 0; i < 8; ++i) { h[q][i] = *(const f32x4*)(row + i * 256 + lane * 4); s += (h[q][i][0] + h[q][i][1]) + (h[q][i][2] + h[q][i][3]); }
            const float mu = wave_sum(s) * (1.0f / D); float vq = 0.f;
#pragma unroll
            for (int i = 0; i < 8; ++i) { const f32x4 d = h[q][i] - mu; vq += (d[0] * d[0] + d[1] * d[1]) + (d[2] * d[2] + d[3] * d[3]); }
            const float rstd = rsqrtf(wave_sum(vq) * (1.0f / D) + LN_EPS);
#pragma unroll
            for (int i = 0; i < 8; ++i) { const f32x4 gv = *(const f32x4*)(g1 + i * 256 + lane * 4), bv = *(const f32x4*)(b1 + i * 256 + lane * 4);
                const f32x4 hv = (h[q][i] - mu) * rstd * gv + bv; h[q][i] = hv;
                *(f32x4*)(row + i * 256 + lane * 4) = hv * ALPHA;
                u32x2 w; w.x = cvt_pk_bf16(hv[0], hv[1]); w.y = cvt_pk_bf16(hv[2], hv[3]);
                *(u32x2*)(h1b + (size_t)(tg * TPW + q) * D + i * 256 + lane * 4) = w; }
            asm volatile("" ::: "memory");
        }
        float lg[TPW];
#pragma unroll
        for (int q = 0; q < TPW; ++q) lg[q] = 0.f;
#pragma unroll 1
        for (int j = 0; j < NR; ++j) {
            f32x4 wv[8];
#pragma unroll
            for (int i = 0; i < 8; ++i) wv[i] = *(const f32x4*)(rw + (size_t)j * D + i * 256 + lane * 4);
#pragma unroll
            for (int q = 0; q < TPW; ++q) { float s = 0.f;
#pragma unroll
                for (int i = 0; i < 8; ++i) { const f32x4 pr = h[q][i] * wv[i]; s += (pr[0] + pr[1]) + (pr[2] + pr[3]); }
                s = wave_sum(s); lg[q] = (lane == j) ? s : lg[q]; }
            asm volatile("" ::: "memory");
        }
        const float bias = lane < 4 ? a.in[18][lane] : (lane < NR ? a.in[20][lane - 4] : 0.f);
#pragma unroll
        for (int q = 0; q < TPW; ++q) {
            const float l = lg[q] + bias;
            const float g0 = __shfl(l, 0), g1v = __shfl(l, 1), g2 = __shfl(l, 2), g3 = __shfl(l, 3);
            int grp = 0; float gm = g0; if (g1v > gm) { gm = g1v; grp = 1; } if (g2 > gm) { gm = g2; grp = 2; } if (g3 > gm) { gm = g3; grp = 3; }
            const float pg = 1.0f / (expf(g0 - gm) + expf(g1v - gm) + expf(g2 - gm) + expf(g3 - gm));
            float el[8];
#pragma unroll
            for (int i = 0; i < 8; ++i) el[i] = __shfl(l, 4 + grp * 8 + i);
            int i1 = 0; float m1 = el[0];
#pragma unroll
            for (int i = 1; i < 8; ++i) if (el[i] > m1) { m1 = el[i]; i1 = i; }
            int i2 = -1; float m2 = -3.0e38f;
#pragma unroll
            for (int i = 0; i < 8; ++i) if (i != i1 && el[i] > m2) { m2 = el[i]; i2 = i; }
            const float e2 = expf(m2 - m1), inv = 1.0f / (1.0f + e2);
            if (lane == 0) {
                const int t = tg * TPW + q; const int ea = grp * 8 + i1, eb = grp * 8 + i2;
                const unsigned ra = atomicAdd(cnt + ea, 1u), rb = atomicAdd(cnt + eb, 1u);
                tok_e[t * 2] = ea; tok_e[t * 2 + 1] = eb; tok_rank[t * 2] = (int)ra; tok_rank[t * 2 + 1] = (int)rb; tok_gate[t * 2] = pg * inv; tok_gate[t * 2 + 1] = pg * e2 * inv;
            }
        }
    }
}

__device__ __forceinline__ void moe_build_tab(const Args& a, int* tstart) {
    if (threadIdx.x == 0) { const unsigned* cnt = (const unsigned*)(a.ws + WS_CTL); int acc = 0;
        for (int e = 0; e < NE; ++e) { tstart[e] = acc; acc += ((int)__hip_atomic_load(cnt + e, __ATOMIC_RELAXED, __HIP_MEMORY_SCOPE_AGENT) + 255) >> 8; }
        tstart[NE] = acc; }
    __syncthreads();
}

__device__ void p6_slots(const Args& a, int* tstart) {
    unsigned char* ws = a.ws;
    const unsigned* cnt = (const unsigned*)(ws + WS_CTL);
    const int* tok_e = (const int*)(ws + WS_ROUTE + RT_E); const int* tok_rank = (const int*)(ws + WS_ROUTE + RT_RANK); const float* tok_gate = (const float*)(ws + WS_ROUTE + RT_GATE);
    int* slot_tok = (int*)(ws + WS_ROUTE + RT_STOK); float* slot_gate = (float*)(ws + WS_ROUTE + RT_SGATE);
    for (int i = blockIdx.x * 512 + threadIdx.x; i < T * 2; i += gridDim.x * 512) {
        const int e = tok_e[i], s = tstart[e] * 256 + tok_rank[i]; slot_tok[s] = i >> 1; slot_gate[s] = tok_gate[i]; }
    const int ns = tstart[NE] * 256;
    for (int s = blockIdx.x * 512 + threadIdx.x; s < ns; s += gridDim.x * 512) {
        const int e = moe_expert_of_tile(tstart, s >> 8); const int r = s - tstart[e] * 256;
        if (r >= (int)cnt[e]) { slot_tok[s] = -1; slot_gate[s] = 0.f; } }
}

__device__ void p9_ln2(const Args& a) {
    const int tid = threadIdx.x, wid = tid >> 6, lane = tid & 63;
    const float* g2 = a.in[24]; const float* b2 = a.in[25];
    const int nw = gridDim.x * 8;
    for (int t = blockIdx.x * 8 + wid; t < T; t += nw) {
        float* row = a.out + (size_t)t * D; f32x4 h[8]; float s = 0.f;
#pragma unroll
        for (int i = 0; i < 8; ++i) { h[i] = *(const f32x4*)(row + i * 256 + lane * 4); s += (h[i][0] + h[i][1]) + (h[i][2] + h[i][3]); }
        const float mu = wave_sum(s) * (1.0f / D); float vq = 0.f;
#pragma unroll
        for (int i = 0; i < 8; ++i) { const f32x4 d = h[i] - mu; vq += (d[0] * d[0] + d[1] * d[1]) + (d[2] * d[2] + d[3] * d[3]); }
        const float rstd = rsqrtf(wave_sum(vq) * (1.0f / D) + LN_EPS);
#pragma unroll
        for (int i = 0; i < 8; ++i) { const f32x4 gv = *(const f32x4*)(g2 + i * 256 + lane * 4), bv = *(const f32x4*)(b2 + i * 256 + lane * 4);
            *(f32x4*)(row + i * 256 + lane * 4) = (h[i] - mu) * rstd * gv + bv; }
    }
}

constexpr int NPHASE = 10;
__global__ void __launch_bounds__(512, 2) fwd(Args a) {
    extern __shared__ __attribute__((aligned(16))) unsigned char lds[];
    cg::grid_group grid = cg::this_grid();
    unsigned char* ws = a.ws;
    int* tstart = (int*)(lds + MISC_OFF);
#define IN(k) (a.ph_lo <= (k) && (k) < a.ph_hi)
#define SEAM(k) do { if (IN(k) && IN((k) + 1)) grid.sync(); } while (0)
    if (IN(0)) p0_prepass(a, lds);
    SEAM(0);
    if (IN(1)) { DescProj d{(const char*)(ws + WS_XB), (const char*)(ws + WS_WIN), (bf16_t*)(ws + WS_PROJ), D, D}; gemm_run<0>(lds, d); }
    SEAM(1);
    if (IN(2)) { p2_pooldiff(a); p2_ssm_naive(a, lds); }
    SEAM(2);
    if (IN(3)) {
        { DescPool d{(const char*)(ws + WS_DPOOL), (const char*)(ws + WS_POOLW), (bf16_t*)(ws + WS_XB), a.in[3], 256, 256}; gemm_run<1>(lds, d); }
        { DescGlu d{(const char*)(ws + WS_YSSM), (const char*)(ws + WS_GLU), (bf16_t*)(ws + WS_XB), a.in[13], DS, DS}; gemm_run<2>(lds, d); }
    }
    SEAM(3);
    if (IN(4)) { DescOut d{(const char*)(ws + WS_XB), (const char*)(ws + WS_WOUT), a.out, a.in[0], D, D}; gemm_run<3>(lds, d); }
    SEAM(4);
    if (IN(5)) p5_ln1_router(a);
    SEAM(5);
    if (IN(6)) { moe_build_tab(a, tstart); p6_slots(a, tstart); }
    SEAM(6);
    if (IN(7)) { moe_build_tab(a, tstart);
        DescGU d{(const char*)(ws + WS_PROJ), (const char*)(ws + WS_WGU), (bf16_t*)(ws + WS_DPOOL), (const int*)(ws + WS_ROUTE + RT_STOK), tstart, D, D}; gemm_run<4>(lds, d); }
    SEAM(7);
    if (IN(8)) { moe_build_tab(a, tstart);
        DescDown d{(const char*)(ws + WS_DPOOL), (const char*)(ws + WS_WD), a.out, (const int*)(ws + WS_ROUTE + RT_STOK), (const float*)(ws + WS_ROUTE + RT_SGATE), tstart, DE, DE}; gemm_run<5>(lds, d); }
    SEAM(8);
    if (IN(9)) p9_ln2(a);
#undef IN
#undef SEAM
}

extern "C" void kernel_launch(void* const* d_in, const int* in_sizes, int n_in, void* d_out, int out_size, void* d_ws, size_t ws_size, hipStream_t stream) {
    static int grid = 0;
    if (grid == 0) {
        if (n_in != 26 || out_size != T * D || ws_size < WS_END) { fprintf(stderr, "kernel_launch: unexpected shapes (n_in %d out %d ws %zu)\n", n_in, out_size, ws_size); grid = -1; return; }
        int dev = 0, cus = 0, per_cu = 0;
        (void)hipGetDevice(&dev); (void)hipDeviceGetAttribute(&cus, hipDeviceAttributeMultiprocessorCount, dev);
        (void)hipFuncSetAttribute((const void*)fwd, hipFuncAttributeMaxDynamicSharedMemorySize, LDS_BYTES);
        (void)hipOccupancyMaxActiveBlocksPerMultiprocessor(&per_cu, (const void*)fwd, 512, LDS_BYTES);
        if (per_cu < 1) { fprintf(stderr, "kernel_launch: occupancy query says %d blocks/CU\n", per_cu); per_cu = 1; }
        grid = cus;
    }
    if (grid < 0) return;
    Args a{};
    for (int i = 0; i < 26; ++i) a.in[i] = (const float*)d_in[i];
    a.out = (float*)d_out; a.ws = (unsigned char*)d_ws;
#if N_LAUNCH_MODE == 0
    a.ph_lo = 0; a.ph_hi = NPHASE;
    void* args[] = {&a};
    hipError_t e = hipLaunchCooperativeKernel((const void*)fwd, dim3(grid), dim3(512), args, LDS_BYTES, stream);
    if (e != hipSuccess) fprintf(stderr, "cooperative launch failed: %s (grid %d)\n", hipGetErrorString(e), grid);
#else
    for (int p = 0; p < NPHASE; ++p) { a.ph_lo = p; a.ph_hi = p + 1; hipLaunchKernelGGL(fwd, dim3(grid), dim3(512), LDS_BYTES, stream, a); }
#endif
}
```

```cpp
#include <hip/hip_runtime.h>
#include <hip/hip_cooperative_groups.h>
#include <cstdio>
namespace cg = cooperative_groups;

#ifndef N_LAUNCH_MODE
#define N_LAUNCH_MODE 0
#endif
#ifndef PROBE_PHASE
#define PROBE_PHASE -1
#endif
#ifndef PROBE_REP
#define PROBE_REP 1
#endif
#ifndef PROBE_SYNC
#define PROBE_SYNC 0
#endif
#ifndef PROBE_GEMM
#define PROBE_GEMM -1
#endif
#ifndef NAIVE_MASK
#define NAIVE_MASK 0x00
#endif

typedef unsigned short bf16_t;
typedef short bf16x8 __attribute__((ext_vector_type(8)));
typedef float f32x4 __attribute__((ext_vector_type(4)));
typedef float f32x2 __attribute__((ext_vector_type(2)));
typedef unsigned u32x4 __attribute__((ext_vector_type(4)));
typedef unsigned u32x2 __attribute__((ext_vector_type(2)));

constexpr int T = 16384, D = 2048, S = 8192, NB = 2;
constexpr int DP = 1024, DS = 1024, NG = 64, GC = 16, NP = 64;
constexpr int NE = 32, DE = 512, NR = 36;
constexpr int MAXTILES = 161;
constexpr float LN_EPS = 1e-5f;
constexpr float ALPHA = 1.189207115002721f;

constexpr size_t MB = 1u << 20;
constexpr size_t WS_CTL = 0;
constexpr size_t WS_BAR = 65536;
constexpr size_t CTL_ZERO_BYTES = 131072;
constexpr size_t WS_YS = 217 * MB;
constexpr size_t WS_SSMP = 1 * MB;
constexpr size_t WS_RW = 3 * MB;
constexpr size_t WS_ROUTE = 4 * MB;
constexpr size_t WS_WIN = 6 * MB;
constexpr size_t WS_WOUT = 14 * MB;
constexpr size_t WS_GLU = 22 * MB;
constexpr size_t WS_POOLW = 24 * MB;
constexpr size_t WS_WGU = 25 * MB;
constexpr size_t WS_WD = 153 * MB;
constexpr size_t WS_XB = 217 * MB;
constexpr size_t WS_PROJ = 281 * MB;
constexpr size_t WS_DPOOL = 409 * MB;
constexpr size_t WS_YSSM = 441 * MB;
constexpr size_t WS_A2 = 345 * MB;
constexpr size_t WS_W1T = 473 * MB;
constexpr size_t WS_W2T = 481 * MB;
constexpr size_t WS_END = 497 * MB;
constexpr size_t SSMP_A16 = 1536 * 1024;

constexpr size_t RT_E = 0, RT_RANK = (size_t)T * 2 * 4, RT_GATE = (size_t)T * 4 * 4, RT_STOK = (size_t)T * 6 * 4, RT_SGATE = RT_STOK + (size_t)MAXTILES * 256 * 4;

constexpr int LDS_BYTES = 128 * 1024 + 4096;
constexpr int MISC_OFF = 128 * 1024;

struct Args { const float* in[26]; float* out; unsigned char* ws; int ph_lo, ph_hi; };

__device__ __forceinline__ float bf2f(bf16_t b) { return __uint_as_float(((unsigned)b) << 16); }
__device__ __forceinline__ float bflo(unsigned w) { return __uint_as_float(w << 16); }
__device__ __forceinline__ float bfhi(unsigned w) { return __uint_as_float(w & 0xffff0000u); }
__device__ __forceinline__ unsigned cvt_pk_bf16(float lo, float hi) { unsigned r; asm volatile("v_cvt_pk_bf16_f32 %0, %1, %2" : "=v"(r) : "v"(lo), "v"(hi)); return r; }
__device__ __forceinline__ float wave_sum(float v) {
#pragma unroll
    for (int o = 32; o >= 1; o >>= 1) v += __shfl_xor(v, o);
    return v;
}
__device__ __forceinline__ float gelu_tanh(float x) {
    const float u = 0.7978845608028654f * (x + 0.044715f * x * x * x);
    const float e = __expf(-2.0f * fabsf(u));
    float t = (1.0f - e) / (1.0f + e); t = u < 0.f ? -t : t;
    return 0.5f * x * (1.0f + t);
}
__device__ __forceinline__ float sigmoidf_(float z) { return 1.0f / (1.0f + __expf(-z)); }

#define LAS __attribute__((address_space(3)))
#define XB_TMO      128
#define XB_XCNT(j)  (256  + 64 * (j))
#define XB_XSUB(j)  (1280 + 64 * (j))
#define XB_XGEN(j)  (2304 + 64 * (j))
#define XB_TOP      3328
#define XB_TOPGEN   3392
#define XCD_BAR_WORDS 3456
#define XB_SPIN_CAP (1u << 18)
__device__ __forceinline__ unsigned xb_ld(unsigned* p)              { return __hip_atomic_load(p, __ATOMIC_RELAXED, __HIP_MEMORY_SCOPE_AGENT); }
__device__ __forceinline__ unsigned xb_add(unsigned* p, unsigned v) { return __hip_atomic_fetch_add(p, v, __ATOMIC_RELAXED, __HIP_MEMORY_SCOPE_AGENT); }
__device__ __forceinline__ unsigned xb_xcc_id() { return (unsigned)__builtin_amdgcn_s_getreg((3 << 11) | 20) & 0xFu; }
#define XB_SPIN(cond, bar) do { unsigned _sp = 0; while (cond) { __builtin_amdgcn_s_sleep(1); \
    if ((++_sp & 255u) == 0u) { if (xb_ld(&(bar)[XB_TMO])) break; if (_sp > XB_SPIN_CAP) { atomicAdd(&(bar)[XB_TMO], 1u); break; } } } } while (0)
struct XcdBarrier { unsigned* bar; unsigned x; volatile LAS unsigned* st; };
__device__ __forceinline__ XcdBarrier xcd_barrier_post(unsigned* bar, volatile LAS unsigned* st) {
    XcdBarrier b; b.bar = bar; b.x = xb_xcc_id(); b.st = st;
    if (threadIdx.x == 0) (void)xb_add(&bar[XB_XCNT(b.x)], 1u);
    return b;
}
__device__ __forceinline__ void xcd_barrier_complete(unsigned* bar, unsigned x, unsigned& nloc, unsigned& nx) {
    const unsigned G = gridDim.x * gridDim.y * gridDim.z;
    unsigned sum, cnt, mine, sp = 0u;
    for (;;) {
        sum = 0u; cnt = 0u; mine = 0u;
#pragma unroll
        for (unsigned j = 0; j < 16; ++j) { const unsigned c = xb_ld(&bar[XB_XCNT(j)]); sum += c; cnt += (c > 0u) ? 1u : 0u; mine = (j == x) ? c : mine; }
        if (sum == G) break;
        __builtin_amdgcn_s_sleep(1);
        if ((++sp & 255u) == 0u) { if (xb_ld(&bar[XB_TMO])) break; if (sp > XB_SPIN_CAP) { atomicAdd(&bar[XB_TMO], 1u); break; } }
    }
    nloc = mine > 0u ? mine : 1u; nx = cnt > 0u ? cnt : 1u;
}
__device__ __forceinline__ void xcd_barrier(const XcdBarrier& b) {
    asm volatile("s_waitcnt vmcnt(0)" ::: "memory");
    __syncthreads();
    if (threadIdx.x == 0) {
        unsigned* bar = b.bar;
        __builtin_amdgcn_s_waitcnt(0);
        unsigned nloc = b.st[0], nx = b.st[1];
        if (nloc == 0u) { xcd_barrier_complete(bar, b.x, nloc, nx); b.st[0] = nloc; b.st[1] = nx; }
        const unsigned old = xb_add(&bar[XB_XSUB(b.x)], 1u);
        const unsigned gen = old / nloc;
        if (old + 1u == (gen + 1u) * nloc) {
            __builtin_amdgcn_fence(__ATOMIC_RELEASE, "agent");
            asm volatile("s_waitcnt vmcnt(0)" ::: "memory");
            const unsigned og = xb_add(&bar[XB_TOP], 1u);
            const unsigned tg = og / nx;
            if (og + 1u == (tg + 1u) * nx) xb_add(&bar[XB_TOPGEN], 1u);
            else XB_SPIN(xb_ld(&bar[XB_TOPGEN]) == tg, bar);
            __builtin_amdgcn_fence(__ATOMIC_ACQUIRE, "agent");
            xb_add(&bar[XB_XGEN(b.x)], 1u);
            asm volatile("s_waitcnt vmcnt(0)" ::: "memory");
        } else {
            XB_SPIN(xb_ld(&bar[XB_XGEN(b.x)]) == gen, bar);
            __builtin_amdgcn_fence(__ATOMIC_ACQUIRE, "agent");
            asm volatile("s_waitcnt vmcnt(0)" ::: "memory");
        }
    }
    __syncthreads();
}

struct Unit { int r0, c0, e, pad; };

template <class DS_>
__device__ void gemm_naive(const DS_& d) {
    const int tid = threadIdx.x, wid = tid >> 6, lane = tid & 63, wr = wid >> 2, wc = wid & 3, fr = lane & 15, fq = lane >> 4;
    const int K = d.K; const size_t ldb2 = (size_t)d.ldb * 2;
    for (int ui = blockIdx.x;; ui += gridDim.x) {
        Unit u; if (!d.get(ui, u)) break;
        f32x4 acc[2][2][4][2];
        const char* Bp = d.b_ptr(u);
#pragma unroll
        for (int ai = 0; ai < 2; ++ai)
#pragma unroll
            for (int m = 0; m < 4; ++m) {
                const int r = 128 * ai + 64 * wr + 16 * m + fr;
                const char* ap = d.A + d.a_off(u, r);
#pragma unroll
                for (int bj = 0; bj < 2; ++bj)
#pragma unroll
                    for (int n = 0; n < 2; ++n) {
                        const int c = 128 * bj + 32 * wc + 16 * n + 4 * fq;
                        const char* bp = Bp + (size_t)c * ldb2;
                        float s0 = 0.f, s1 = 0.f, s2 = 0.f, s3 = 0.f;
                        for (int k = 0; k < K; k += 8) {
                            const u32x4 av = *(const u32x4*)(ap + k * 2);
                            const u32x4 b0 = *(const u32x4*)(bp + k * 2), b1 = *(const u32x4*)(bp + ldb2 + k * 2), b2 = *(const u32x4*)(bp + 2 * ldb2 + k * 2), b3 = *(const u32x4*)(bp + 3 * ldb2 + k * 2);
#pragma unroll
                            for (int j = 0; j < 4; ++j) {
                                const float al = bflo(av[j]), ah = bfhi(av[j]);
                                s0 += al * bflo(b0[j]); s0 += ah * bfhi(b0[j]);
                                s1 += al * bflo(b1[j]); s1 += ah * bfhi(b1[j]);
                                s2 += al * bflo(b2[j]); s2 += ah * bfhi(b2[j]);
                                s3 += al * bflo(b3[j]); s3 += ah * bfhi(b3[j]);
                            }
                        }
                        acc[ai][bj][m][n] = (f32x4){s0, s1, s2, s3};
                    }
            }
        d.epi(acc, u, wr, wc, fr, fq);
    }
}

constexpr int BK = 64, HALF = 128, HTB = HALF * BK * 2;
__device__ __forceinline__ int lds_byte(int r, int c) { const int st = (r >> 4) * 2 + (c >> 5), rr = r & 15, cc = c & 31, ob = rr * 64 + cc * 2; return st * 1024 + (ob ^ (((ob >> 9) & 1) << 5)); }
__device__ __forceinline__ void stage_rc(int b, int& R, int& C) { const int st = b / 1024, sb = b % 1024, swz = sb ^ (((sb >> 9) & 1) << 5); R = (st >> 1) * 16 + swz / 64; C = (st & 1) * 32 + (swz % 64) / 2; }

template <class DS_>
__device__ __forceinline__ void gemm_fast(LAS unsigned char* lds, const DS_& d) {
    const int tid = threadIdx.x, wid = __builtin_amdgcn_readfirstlane(tid >> 6), lane = tid & 63, wr = wid >> 2, wc = wid & 3, fr = lane & 15, fq = lane >> 4;
    const int K = d.K, nt = K / BK;
    int Rr[2], Cc[2]; unsigned voffB[2];
#pragma unroll
    for (int i = 0; i < 2; ++i) { stage_rc(tid * 16 + i * 8192, Rr[i], Cc[i]); voffB[i] = (unsigned)(Rr[i] * d.ldb + Cc[i]) * 2u; }
    const size_t kstep = (size_t)(BK * 2);
    const size_t hstepB = (size_t)HALF * d.ldb * 2;
    const unsigned ldsw = (unsigned)wid * 1024u;
    const int aoff = lds_byte(wr * 64 + fr, fq * 8), boff = lds_byte(wc * 32 + fr, fq * 8);
#define G_SA(b, h) (((b) * 2 + (h)) * HTB)
#define G_SB(b, h) ((4 + (b) * 2 + (h)) * HTB)
#define G_STAGE(bufoff, gbase, voff) do { _Pragma("unroll") for (int _i = 0; _i < 2; ++_i) \
        __builtin_amdgcn_global_load_lds((const unsigned*)((const char*)(gbase) + (voff)[_i]), (LAS unsigned*)(lds + (bufoff) + ldsw + _i * 8192), 16, 0, 0); } while (0)
#define G_LDA(dst, b, h) do { _Pragma("unroll") for (int m = 0; m < 4; ++m) _Pragma("unroll") for (int k = 0; k < 2; ++k) dst[m][k] = *(const LAS bf16x8*)(lds + G_SA(b, h) + aoff + m * 2048 + k * 1024); } while (0)
#define G_LDB(dst, b, h) do { _Pragma("unroll") for (int n = 0; n < 2; ++n) _Pragma("unroll") for (int k = 0; k < 2; ++k) dst[n][k] = *(const LAS bf16x8*)(lds + G_SB(b, h) + boff + n * 2048 + k * 1024); } while (0)
#define G_MMA(ai, bj, At, Bt) do { __builtin_amdgcn_s_setprio(1); _Pragma("unroll") for (int m = 0; m < 4; ++m) _Pragma("unroll") for (int n = 0; n < 2; ++n) _Pragma("unroll") for (int k = 0; k < 2; ++k) \
        acc[ai][bj][m][n] = __builtin_amdgcn_mfma_f32_16x16x32_bf16(Bt[n][k], At[m][k], acc[ai][bj][m][n], 0, 0, 0); __builtin_amdgcn_s_setprio(0); } while (0)
#define G_WAIT_V(n) asm volatile("s_waitcnt vmcnt(" #n ")" ::: "memory")
#define G_WAIT_L(n) asm volatile("s_waitcnt lgkmcnt(" #n ")" ::: "memory")
#define G_BAR __builtin_amdgcn_s_barrier()
#define G_SCHED __builtin_amdgcn_sched_barrier(0)
    Unit cur, nxt; int ui = blockIdx.x;
    if (!d.get(ui, cur)) return;
    f32x4 acc[2][2][4][2];
#pragma unroll
    for (int a_ = 0; a_ < 2; ++a_)
#pragma unroll
        for (int b_ = 0; b_ < 2; ++b_)
#pragma unroll
            for (int m = 0; m < 4; ++m)
#pragma unroll
                for (int n = 0; n < 2; ++n) acc[a_][b_][m][n] = (f32x4){0.f, 0.f, 0.f, 0.f};
    bf16x8 At[4][2], B0[2][2], B1[2][2];
    unsigned vA[2][2], nvA[2][2];
#pragma unroll
    for (int h = 0; h < 2; ++h)
#pragma unroll
        for (int i = 0; i < 2; ++i) vA[h][i] = d.a_off(cur, h * HALF + Rr[i]) + (unsigned)Cc[i] * 2u;
    const char* const Ab = d.A;
    const char* cB = d.b_ptr(cur);
    G_STAGE(G_SB(0, 0), cB, voffB); G_STAGE(G_SA(0, 0), Ab, vA[0]); G_STAGE(G_SB(0, 1), cB + hstepB, voffB); G_STAGE(G_SA(0, 1), Ab, vA[1]);
    if (wr == 1) G_BAR;
    G_WAIT_V(4); G_BAR;
    G_STAGE(G_SB(1, 0), cB + kstep, voffB); G_STAGE(G_SA(1, 0), Ab + kstep, vA[0]); G_STAGE(G_SB(1, 1), cB + hstepB + kstep, voffB);
    G_WAIT_V(6); G_BAR;
    for (;;) {
        const bool has_next = d.get(ui + (int)gridDim.x, nxt);
        const char* nB = has_next ? d.b_ptr(nxt) : cB;
#pragma unroll
        for (int h = 0; h < 2; ++h)
#pragma unroll
            for (int i = 0; i < 2; ++i) nvA[h][i] = has_next ? (d.a_off(nxt, h * HALF + Rr[i]) + (unsigned)Cc[i] * 2u) : vA[h][i];
        for (int t = 0; t < nt; t += 2) {
            const bool last = (t == nt - 2);
            const char* a1 = Ab + (size_t)(t + 1) * kstep;
            const char* a2 = last ? Ab : Ab + (size_t)(t + 2) * kstep; const char* b2 = last ? nB : cB + (size_t)(t + 2) * kstep;
            const char* a3 = a2 + kstep; const char* b3 = b2 + kstep;
            unsigned va2[2][2];
#pragma unroll
            for (int h = 0; h < 2; ++h)
#pragma unroll
                for (int i = 0; i < 2; ++i) va2[h][i] = last ? nvA[h][i] : vA[h][i];
            G_LDB(B0, 0, 0); G_SCHED; G_LDA(At, 0, 0); G_STAGE(G_SA(1, 1), a1, vA[1]);
            G_WAIT_L(8); G_BAR; G_WAIT_L(0); G_MMA(0, 0, At, B0); G_BAR; G_SCHED;
            G_LDB(B1, 0, 1); G_STAGE(G_SB(0, 0), b2, voffB);
            G_BAR; G_WAIT_L(0); G_MMA(0, 1, At, B1); G_BAR;
            G_LDA(At, 0, 1); G_STAGE(G_SA(0, 0), a2, va2[0]);
            G_BAR; G_WAIT_L(0); G_MMA(1, 0, At, B0); G_BAR; G_SCHED;
            G_STAGE(G_SB(0, 1), b2 + hstepB, voffB);
            G_WAIT_V(6); G_BAR; G_MMA(1, 1, At, B1); G_BAR;
            G_LDB(B0, 1, 0); G_SCHED; G_LDA(At, 1, 0); G_STAGE(G_SA(0, 1), a2, va2[1]);
            G_WAIT_L(8); G_BAR; G_WAIT_L(0); G_MMA(0, 0, At, B0); G_BAR; G_SCHED;
            G_LDB(B1, 1, 1); G_STAGE(G_SB(1, 0), b3, voffB);
            G_BAR; G_WAIT_L(0); G_MMA(0, 1, At, B1); G_BAR;
            G_LDA(At, 1, 1); G_STAGE(G_SA(1, 0), a3, va2[0]);
            G_BAR; G_WAIT_L(0); G_MMA(1, 0, At, B0); G_BAR; G_SCHED;
            G_STAGE(G_SB(1, 1), b3 + hstepB, voffB);
            G_WAIT_V(6); G_BAR; G_MMA(1, 1, At, B1); G_BAR;
        }
        d.epi(acc, cur, wr, wc, fr, fq);
        if (!has_next) break;
#pragma unroll
        for (int a_ = 0; a_ < 2; ++a_)
#pragma unroll
            for (int b_ = 0; b_ < 2; ++b_)
#pragma unroll
                for (int m = 0; m < 4; ++m)
#pragma unroll
                    for (int n = 0; n < 2; ++n) acc[a_][b_][m][n] = (f32x4){0.f, 0.f, 0.f, 0.f};
        cur = nxt; cB = nB; ui += (int)gridDim.x;
#pragma unroll
        for (int h = 0; h < 2; ++h)
#pragma unroll
            for (int i = 0; i < 2; ++i) vA[h][i] = nvA[h][i];
    }
    G_WAIT_V(0);
    if (wr == 0) G_BAR;
    G_BAR;
#undef G_SA
#undef G_SB
#undef G_STAGE
#undef G_LDA
#undef G_LDB
#undef G_MMA
#undef G_WAIT_V
#undef G_WAIT_L
#undef G_BAR
#undef G_SCHED
}
template <int BIT, class DS_>
__device__ __forceinline__ void gemm_run(unsigned char* lds, const DS_& d) {
    if constexpr ((NAIVE_MASK >> BIT) & 1) gemm_naive(d); else gemm_fast((LAS unsigned char*)lds, d);
}

__device__ __forceinline__ bool static_order(int L, int nM, int nN, int& pm, int& pn) {
    const int nwg = nM * nN; if (L >= nwg) return false;
    int wgid = L; { const int q = nwg / 8, r = nwg % 8, xcd = wgid % 8, off = wgid / 8; wgid = (xcd < r ? xcd * (q + 1) : r * (q + 1) + (xcd - r) * q) + off; }
    const int nig = 8 * nN, gid = wgid / nig, fm = gid * 8, gsz = (nM - fm) < 8 ? (nM - fm) : 8;
    pm = fm + ((wgid % nig) % gsz); pn = (wgid % nig) / gsz; return true;
}

#define EPI_LOOP_BEGIN _Pragma("unroll") for (int ai = 0; ai < 2; ++ai) _Pragma("unroll") for (int m = 0; m < 4; ++m) { const int lr = 128 * ai + 64 * wr + 16 * m + fr; \
    _Pragma("unroll") for (int bj = 0; bj < 2; ++bj) _Pragma("unroll") for (int n = 0; n < 2; ++n) { const int lc = 128 * bj + 32 * wc + 16 * n + 4 * fq; const f32x4 v = acc[ai][bj][m][n];
#define EPI_LOOP_END } }

struct DescProj {
    const char* A; const char* Bt; bf16_t* O; bf16_t* A2; int K, ldb;
    __device__ bool get(int i, Unit& u) const { int pm, pn; if (i >= 512 * ((0) == PROBE_GEMM ? PROBE_REP : 1)) return false; i %= 512; if (!static_order(i, T / 256, D / 256, pm, pn)) return false; u.r0 = pm * 256; u.c0 = pn * 256; u.e = 0; u.pad = 0; return true; }
    __device__ unsigned a_off(const Unit& u, int r) const { return (unsigned)(u.r0 + r) * (unsigned)(D * 2); }
    __device__ const char* b_ptr(const Unit& u) const { return Bt + (size_t)u.c0 * D * 2; }
    __device__ void epi(const f32x4 (&acc)[2][2][4][2], const Unit& u, int wr, int wc, int fr, int fq) const {
        EPI_LOOP_BEGIN
            u32x2 w; w.x = cvt_pk_bf16(v[0], v[1]); w.y = cvt_pk_bf16(v[2], v[3]);
            const int t = u.r0 + lr, nn = u.c0 + lc;
            if (u.c0 < DP) *(u32x2*)(O + (size_t)t * D + nn) = w;
            else { const int g = (nn - DP) >> 4, co = (nn - DP) & 15; *(u32x2*)(A2 + ((size_t)(g * 1024 + (t >> 4))) * 512 + (t & 15) * 16 + co) = w; }
        EPI_LOOP_END
    }
};
struct DescS1 {
    const char* A; const char* Bt; float* O; int K, ldb;
    __device__ bool get(int i, Unit& u) const { if (i >= 256 * ((6) == PROBE_GEMM ? PROBE_REP : 1)) return false; i &= 255; u.e = i >> 2; u.r0 = (i & 3) * 256; u.c0 = 0; u.pad = 0; return true; }
    __device__ unsigned a_off(const Unit& u, int r) const { return (unsigned)(u.e * 1024 + u.r0 + r) * 1024u; }
    __device__ const char* b_ptr(const Unit& u) const { return Bt + (size_t)u.e * 256 * 256 * 2; }
    __device__ void epi(const f32x4 (&acc)[2][2][4][2], const Unit& u, int wr, int wc, int fr, int fq) const {
        EPI_LOOP_BEGIN
            *(f32x4*)(O + ((size_t)(u.e * 1024 + u.r0 + lr)) * 256 + lc) = v;
        EPI_LOOP_END
    }
};
struct DescS2 {
    const char* A; const char* Bt; bf16_t* O; int K, ldb;
    __device__ bool get(int i, Unit& u) const { if (i >= 256 * ((7) == PROBE_GEMM ? PROBE_REP : 1)) return false; i &= 255; u.e = i >> 2; u.r0 = (i & 3) * 256; u.c0 = 0; u.pad = 0; return true; }
    __device__ unsigned a_off(const Unit& u, int r) const { return (unsigned)(u.e * 1024 + u.r0 + r) * 1024u; }
    __device__ const char* b_ptr(const Unit& u) const { return Bt + (size_t)u.e * 256 * 512 * 2; }
    __device__ void epi(const f32x4 (&acc)[2][2][4][2], const Unit& u, int wr, int wc, int fr, int fq) const {
        EPI_LOOP_BEGIN
            const int t = (u.r0 + lr) * 16 + (lc >> 4), co = lc & 15;
            u32x2 w; w.x = cvt_pk_bf16(gelu_tanh(v[0]), gelu_tanh(v[1])); w.y = cvt_pk_bf16(gelu_tanh(v[2]), gelu_tanh(v[3]));
            *(u32x2*)(O + (size_t)t * DS + u.e * 16 + co) = w;
        EPI_LOOP_END
    }
};
struct DescPool {
    const char* A; const char* Bt; bf16_t* O; const float* scale; int K, ldb;
    __device__ bool get(int i, Unit& u) const { if (i >= 256 * ((1) == PROBE_GEMM ? PROBE_REP : 1)) return false; i &= 255; u.e = i & 3; u.r0 = (i >> 2) * 256; u.c0 = u.e * 256; u.pad = 0; return true; }
    __device__ unsigned a_off(const Unit& u, int r) const { return ((unsigned)(u.r0 + r) * (unsigned)DP + (unsigned)u.e * 256u) * 2u; }
    __device__ const char* b_ptr(const Unit& u) const { return Bt + (size_t)u.e * 256 * 256 * 2; }
    __device__ void epi(const f32x4 (&acc)[2][2][4][2], const Unit& u, int wr, int wc, int fr, int fq) const {
        EPI_LOOP_BEGIN
            const f32x4 sc = *(const f32x4*)(scale + u.c0 + lc);
            u32x2 w; w.x = cvt_pk_bf16(v[0] * sc[0], v[1] * sc[1]); w.y = cvt_pk_bf16(v[2] * sc[2], v[3] * sc[3]);
            *(u32x2*)(O + (size_t)(u.r0 + lr) * D + u.c0 + lc) = w;
        EPI_LOOP_END
    }
};
struct DescGlu {
    const char* A; const char* Bt; bf16_t* O; const float* bias; int K, ldb;
    __device__ bool get(int i, Unit& u) const { int pm, pn; if (i >= 256 * ((2) == PROBE_GEMM ? PROBE_REP : 1)) return false; i %= 256; if (!static_order(i, T / 256, DS / 256, pm, pn)) return false; u.r0 = pm * 256; u.c0 = pn * 256; u.e = 0; u.pad = 0; return true; }
    __device__ unsigned a_off(const Unit& u, int r) const { return (unsigned)(u.r0 + r) * (unsigned)(DS * 2); }
    __device__ const char* b_ptr(const Unit& u) const { return Bt + (size_t)u.c0 * DS * 2; }
    __device__ void epi(const f32x4 (&acc)[2][2][4][2], const Unit& u, int wr, int wc, int fr, int fq) const {
        EPI_LOOP_BEGIN
            const f32x4 bv = *(const f32x4*)(bias + u.c0 + lc);
            const u32x2 yw = *(const u32x2*)(A + ((size_t)(u.r0 + lr) * DS + u.c0 + lc) * 2);
            const float y0 = bflo(yw.x), y1 = bfhi(yw.x), y2 = bflo(yw.y), y3 = bfhi(yw.y);
            u32x2 w; w.x = cvt_pk_bf16(y0 * sigmoidf_(v[0] + bv[0]), y1 * sigmoidf_(v[1] + bv[1])); w.y = cvt_pk_bf16(y2 * sigmoidf_(v[2] + bv[2]), y3 * sigmoidf_(v[3] + bv[3]));
            *(u32x2*)(O + (size_t)(u.r0 + lr) * D + DP + u.c0 + lc) = w;
        EPI_LOOP_END
    }
};
struct DescOut {
    const char* A; const char* Bt; float* O; const float* X; int K, ldb;
    __device__ bool get(int i, Unit& u) const { int pm, pn; if (i >= 512 * ((3) == PROBE_GEMM ? PROBE_REP : 1)) return false; i %= 512; if (!static_order(i, T / 256, D / 256, pm, pn)) return false; u.r0 = pm * 256; u.c0 = pn * 256; u.e = 0; u.pad = 0; return true; }
    __device__ unsigned a_off(const Unit& u, int r) const { return (unsigned)(u.r0 + r) * (unsigned)(D * 2); }
    __device__ const char* b_ptr(const Unit& u) const { return Bt + (size_t)u.c0 * D * 2; }
    __device__ void epi(const f32x4 (&acc)[2][2][4][2], const Unit& u, int wr, int wc, int fr, int fq) const {
        EPI_LOOP_BEGIN
            const size_t o = (size_t)(u.r0 + lr) * D + u.c0 + lc;
            const f32x4 xv = *(const f32x4*)(X + o);
            *(f32x4*)(O + o) = xv * ALPHA + v;
        EPI_LOOP_END
    }
};
struct MoeTab { const int* tstart; };
__device__ __forceinline__ int moe_expert_of_tile(const int* tstart, int tile) { int e = 0;
#pragma unroll 1
    for (int j = 1; j < NE; ++j) e += (tile >= tstart[j]) ? 1 : 0;
    return e; }
struct DescGU {
    const char* A; const char* Bt; bf16_t* O; const int* slot_tok; const int* tstart; int K, ldb;
    __device__ bool get(int i, Unit& u) const { const int nt = tstart[NE]; if (i >= nt * 4 * ((4) == PROBE_GEMM ? PROBE_REP : 1)) return false; i %= nt * 4; const int tile = i >> 2; u.r0 = tile * 256; u.c0 = (i & 3) * 256; u.e = moe_expert_of_tile(tstart, tile); u.pad = 0; return true; }
    __device__ unsigned a_off(const Unit& u, int r) const { int t = slot_tok[u.r0 + r]; t = t < 0 ? 0 : t; return (unsigned)t * (unsigned)(D * 2); }
    __device__ const char* b_ptr(const Unit& u) const { return Bt + ((size_t)u.e * 1024 + u.c0) * D * 2; }
    __device__ void epi(const f32x4 (&acc)[2][2][4][2], const Unit& u, int wr, int wc, int fr, int fq) const {
#pragma unroll
        for (int ai = 0; ai < 2; ++ai)
#pragma unroll
            for (int m = 0; m < 4; ++m) { const int lr = 128 * ai + 64 * wr + 16 * m + fr;
#pragma unroll
                for (int n = 0; n < 2; ++n) { const int lc = 32 * wc + 16 * n + 4 * fq; const f32x4 g = acc[ai][0][m][n], up = acc[ai][1][m][n];
                    f32x4 h;
#pragma unroll
                    for (int j = 0; j < 4; ++j) h[j] = g[j] * sigmoidf_(g[j]) * up[j];
                    u32x2 w; w.x = cvt_pk_bf16(h[0], h[1]); w.y = cvt_pk_bf16(h[2], h[3]);
                    *(u32x2*)(O + (size_t)(u.r0 + lr) * DE + (u.c0 >> 1) + lc) = w; } }
    }
};
struct DescDown {
    const char* A; const char* Bt; bf16_t* O; const float* slot_gate; const int* tstart; int K, ldb;
    __device__ bool get(int i, Unit& u) const { const int nt = tstart[NE]; if (i >= nt * 8 * ((5) == PROBE_GEMM ? PROBE_REP : 1)) return false; i %= nt * 8; const int tile = i >> 3; u.r0 = tile * 256; u.c0 = (i & 7) * 256; u.e = moe_expert_of_tile(tstart, tile); u.pad = 0; return true; }
    __device__ unsigned a_off(const Unit& u, int r) const { return (unsigned)(u.r0 + r) * (unsigned)(DE * 2); }
    __device__ const char* b_ptr(const Unit& u) const { return Bt + ((size_t)u.e * D + u.c0) * DE * 2; }
    __device__ void epi(const f32x4 (&acc)[2][2][4][2], const Unit& u, int wr, int wc, int fr, int fq) const {
#pragma unroll
        for (int ai = 0; ai < 2; ++ai)
#pragma unroll
            for (int m = 0; m < 4; ++m) { const int lr = 128 * ai + 64 * wr + 16 * m + fr; const float gt = slot_gate[u.r0 + lr];
#pragma unroll
                for (int bj = 0; bj < 2; ++bj)
#pragma unroll
                    for (int n = 0; n < 2; ++n) { const int lc = 128 * bj + 32 * wc + 16 * n + 4 * fq; const f32x4 v = acc[ai][bj][m][n] * gt;
                        u32x2 w; w.x = cvt_pk_bf16(v[0], v[1]); w.y = cvt_pk_bf16(v[2], v[3]);
                        *(u32x2*)(O + (size_t)(u.r0 + lr) * D + u.c0 + lc) = w; } }
    }
};

__device__ __forceinline__ void tr_job(const Args& a, int j, const float*& src, int& lds_, bf16_t*& dst, int& ldd) {
    unsigned char* ws = a.ws;
    if (j < 1024) { const int kt = j >> 5, nt = j & 31; src = a.in[1] + (size_t)kt * 64 * D + nt * 64; lds_ = D; dst = (bf16_t*)(ws + WS_WIN) + (size_t)nt * 64 * D + kt * 64; ldd = D; return; }
    j -= 1024;
    if (j < 1024) { const int kt = j >> 5, nt = j & 31; src = a.in[14] + (size_t)kt * 64 * D + nt * 64; lds_ = D; dst = (bf16_t*)(ws + WS_WOUT) + (size_t)nt * 64 * D + kt * 64; ldd = D; return; }
    j -= 1024;
    if (j < 256) { const int kt = j >> 4, nt = j & 15; src = a.in[12] + (size_t)kt * 64 * DS + nt * 64; lds_ = DS; dst = (bf16_t*)(ws + WS_GLU) + (size_t)nt * 64 * DS + kt * 64; ldd = DS; return; }
    j -= 256;
    if (j < 64) { const int g = j >> 4, r = j & 15, kt = r >> 2, nt = r & 3; src = a.in[2] + (size_t)g * 65536 + kt * 64 * 256 + nt * 64; lds_ = 256; dst = (bf16_t*)(ws + WS_POOLW) + (size_t)g * 65536 + nt * 64 * 256 + kt * 64; ldd = 256; return; }
    j -= 64;
    if (j < 16384) { const int up = j >= 8192; if (up) j -= 8192; const int e = j >> 8, r = j & 255, kt = r >> 3, nt = r & 7, n0 = nt * 64;
        src = (up ? a.in[22] : a.in[21]) + (size_t)e * D * DE + (size_t)kt * 64 * DE + n0; lds_ = DE;
        const int drow = (n0 >> 7) * 256 + (n0 & 127) + (up ? 128 : 0);
        dst = (bf16_t*)(ws + WS_WGU) + ((size_t)e * 1024 + drow) * D + kt * 64; ldd = D; return; }
    j -= 16384;
    { const int e = j >> 8, r = j & 255, kt = r >> 5, nt = r & 31; src = a.in[23] + (size_t)e * DE * D + (size_t)kt * 64 * D + nt * 64; lds_ = D;
      dst = (bf16_t*)(ws + WS_WD) + ((size_t)e * D + nt * 64) * DE + kt * 64; ldd = DE; }
}
constexpr int TR_JOBS = 1024 + 1024 + 256 + 64 + 16384 + 8192;

__device__ void p0_prepass(const Args& a, unsigned char* lds) {
    const int tid = threadIdx.x, G = gridDim.x, bid = blockIdx.x;
    unsigned char* ws = a.ws;
    {
        const f32x4* x4 = (const f32x4*)a.in[0]; u32x4* xb = (u32x4*)(ws + WS_XB);
        const size_t n8 = (size_t)T * D / 8, stride = (size_t)G * 512;
        for (size_t i = (size_t)bid * 512 + tid; i < n8; i += 4 * stride) {
            f32x4 v[8];
#pragma unroll
            for (int q = 0; q < 4; ++q) { const size_t ii = i + q * stride; if (ii < n8) { v[2 * q] = x4[2 * ii]; v[2 * q + 1] = x4[2 * ii + 1]; } }
#pragma unroll
            for (int q = 0; q < 4; ++q) { const size_t ii = i + q * stride; if (ii < n8) { u32x4 o; o.x = cvt_pk_bf16(v[2 * q][0], v[2 * q][1]); o.y = cvt_pk_bf16(v[2 * q][2], v[2 * q][3]);
                o.z = cvt_pk_bf16(v[2 * q + 1][0], v[2 * q + 1][1]); o.w = cvt_pk_bf16(v[2 * q + 1][2], v[2 * q + 1][3]); xb[ii] = o; } }
        }
    }
    {
        float* tl = (float*)lds;
        const int lr = tid >> 4, lc4 = (tid & 15) * 4;
        const int on = tid >> 3, okg = (tid & 7) * 8;
        for (int jg = bid * 4; jg < TR_JOBS; jg += G * 4) {
            f32x4 v[4][2]; bf16_t* dst[4]; int ldd[4];
#pragma unroll
            for (int q = 0; q < 4; ++q) { const float* src; int ls; tr_job(a, jg + q, src, ls, dst[q], ldd[q]);
                v[q][0] = *(const f32x4*)(src + (size_t)lr * ls + lc4); v[q][1] = *(const f32x4*)(src + (size_t)(lr + 32) * ls + lc4); }
            __syncthreads();
#pragma unroll
            for (int q = 0; q < 4; ++q) { float* t0 = tl + q * 64 * 65;
#pragma unroll
                for (int e = 0; e < 4; ++e) { t0[lr * 65 + lc4 + e] = v[q][0][e]; t0[(lr + 32) * 65 + lc4 + e] = v[q][1][e]; } }
            __syncthreads();
#pragma unroll
            for (int q = 0; q < 4; ++q) { const float* t0 = tl + q * 64 * 65; float f[8];
#pragma unroll
                for (int e = 0; e < 8; ++e) f[e] = t0[(okg + e) * 65 + on];
                u32x4 o; o.x = cvt_pk_bf16(f[0], f[1]); o.y = cvt_pk_bf16(f[2], f[3]); o.z = cvt_pk_bf16(f[4], f[5]); o.w = cvt_pk_bf16(f[6], f[7]);
                *(u32x4*)(dst[q] + (size_t)on * ldd[q] + okg) = o; }
        }
        __syncthreads();
    }
    {
        f32x2* pw = (f32x2*)lds;
        f32x2* Bb = (f32x2*)(lds + 17408);
        f32x2* Cc = (f32x2*)(lds + 17408 + 16384);
        float* KT = (float*)(lds + 17408 + 32768);
        for (int job = bid; job < 2 * NG; job += G) {
            const int g = job >> 1, half = job & 1;
            __syncthreads();
            for (int i = tid; i < 2 * 17 * 64; i += 512) { const int dr = i / (17 * 64), l = (i >> 6) % 17, p = i & 63, ix = (dr * NG + g) * NP + p;
                const float lre = a.in[4][ix], lim = a.in[5][ix], dt = expf(a.in[6][dr * NG + g]);
                const float mg = expf(lre * dt * (float)l); float sn, cs; sincosf(lim * dt * (float)l, &sn, &cs); pw[i] = (f32x2){mg * cs, mg * sn}; }
            for (int i = tid; i < 2 * 64; i += 512) { const int dr = i >> 6, p = i & 63, ix = (dr * NG + g) * NP + p;
                const float lre = a.in[4][ix], lim = a.in[5][ix], dt = expf(a.in[6][dr * NG + g]);
                const float mg = expf(lre * dt), ar = mg * cosf(lim * dt), ai = mg * sinf(lim * dt), den = lre * lre + lim * lim;
                const float zr = ((ar - 1.0f) * lre + ai * lim) / den, zi = (ai * lre - (ar - 1.0f) * lim) / den;
#pragma unroll
                for (int c = 0; c < GC; ++c) { const float br = a.in[7][(size_t)ix * GC + c], bi = a.in[8][(size_t)ix * GC + c]; Bb[i * GC + c] = (f32x2){zr * br - zi * bi, zr * bi + zi * br}; } }
            for (int i = tid; i < 2 * GC * NP; i += 512) { const int dr = i >> 10, r = i & 1023; const size_t o = ((size_t)(dr * NG + g) * GC) * NP + r; Cc[i] = (f32x2){a.in[9][o], a.in[10][o]}; }
            __syncthreads();
            { const int dr = tid >> 8, l = (tid >> 4) & 15, co = tid & 15; float ac[16];
#pragma unroll
              for (int c = 0; c < 16; ++c) ac[c] = 0.f;
              for (int p = 0; p < NP; ++p) { const f32x2 cv = Cc[(dr * 16 + co) * 64 + p], wv = pw[(dr * 17 + l) * 64 + p]; const float cr = cv.x * wv.x - cv.y * wv.y, ci = cv.x * wv.y + cv.y * wv.x;
#pragma unroll
                  for (int c = 0; c < 16; ++c) { const f32x2 bv = Bb[(dr * 64 + p) * 16 + c]; ac[c] += cr * bv.x - ci * bv.y; } }
#pragma unroll
              for (int c = 0; c < 16; ++c) KT[((dr * 16 + l) * 16 + co) * 16 + c] = ac[c]; }
            __syncthreads();
            bf16_t* w2 = (bf16_t*)(ws + WS_W2T) + (size_t)g * 256 * 512;
            for (int it = tid; it < 128 * 64; it += 512) { const int rr = it >> 6, kg = it & 63, n = half * 128 + rr, j = n >> 4, co = n & 15; float f[8];
                if (kg < 32) { const int i = kg >> 1, ci0 = (kg & 1) * 8;
#pragma unroll
                    for (int e = 0; e < 8; ++e) { const int ci = ci0 + e; float v = 0.f;
                        if (i <= j) v += KT[((0 * 16 + (j - i)) * 16 + co) * 16 + ci];
                        if (i >= j) v += KT[((1 * 16 + (i - j)) * 16 + co) * 16 + ci];
                        if (i == j && ci == co) v += a.in[11][g * GC + co];
                        f[e] = v; } }
                else { const int kk = (kg - 32) * 8, dr = kk >> 7, ri = (kk >> 6) & 1, p0 = kk & 63, ex = dr == 0 ? j + 1 : 16 - j;
#pragma unroll
                    for (int e = 0; e < 8; ++e) { const f32x2 cv = Cc[(dr * 16 + co) * 64 + p0 + e], wv = pw[(dr * 17 + ex) * 64 + p0 + e];
                        f[e] = ri == 0 ? (cv.x * wv.x - cv.y * wv.y) : -(cv.x * wv.y + cv.y * wv.x); } }
                u32x4 o; o.x = cvt_pk_bf16(f[0], f[1]); o.y = cvt_pk_bf16(f[2], f[3]); o.z = cvt_pk_bf16(f[4], f[5]); o.w = cvt_pk_bf16(f[6], f[7]);
                *(u32x4*)(w2 + (size_t)n * 512 + kg * 8) = o; }
            bf16_t* w1 = (bf16_t*)(ws + WS_W1T) + (size_t)g * 256 * 256;
            for (int it = tid; it < 128 * 32; it += 512) { const int rr = it >> 5, kg = it & 31, dr = half, ri = rr >> 6, p = rr & 63, i = kg >> 1, ci0 = (kg & 1) * 8, ex = dr == 0 ? 15 - i : i;
                const f32x2 wv = pw[(dr * 17 + ex) * 64 + p]; float f[8];
#pragma unroll
                for (int e = 0; e < 8; ++e) { const f32x2 bv = Bb[(dr * 64 + p) * 16 + ci0 + e]; f[e] = ri == 0 ? (wv.x * bv.x - wv.y * bv.y) : (wv.x * bv.y + wv.y * bv.x); }
                u32x4 o; o.x = cvt_pk_bf16(f[0], f[1]); o.y = cvt_pk_bf16(f[2], f[3]); o.z = cvt_pk_bf16(f[4], f[5]); o.w = cvt_pk_bf16(f[6], f[7]);
                *(u32x4*)(w1 + (size_t)(half * 128 + rr) * 256 + kg * 8) = o; }
            if (tid < 64) ((f32x2*)(ws + WS_SSMP + SSMP_A16))[(half * NG + g) * NP + tid] = pw[(half * 17 + 16) * 64 + tid];
        }
        __syncthreads();
    }
    {
        u32x4* rwf = (u32x4*)(ws + WS_RW);
        for (int i = bid * 512 + tid; i < 8 * 8 * 3 * 64; i += G * 512) {
            const int lane_ = i & 63, f = i >> 6, nt = f % 3, ks = (f / 3) & 7, w = f / 24, n = lane_ & 15, fq = lane_ >> 4, j = nt * 16 + n;
            float wv[8];
#pragma unroll
            for (int e = 0; e < 8; ++e) { const int k = w * 256 + ks * 32 + fq * 8 + e; wv[e] = j < 4 ? a.in[17][k * 4 + j] : (j < NR ? a.in[19][k * NE + (j - 4)] : 0.f); }
            u32x4 hi; hi.x = cvt_pk_bf16(wv[0], wv[1]); hi.y = cvt_pk_bf16(wv[2], wv[3]); hi.z = cvt_pk_bf16(wv[4], wv[5]); hi.w = cvt_pk_bf16(wv[6], wv[7]);
            u32x4 lo; lo.x = cvt_pk_bf16(wv[0] - bflo(hi.x), wv[1] - bfhi(hi.x)); lo.y = cvt_pk_bf16(wv[2] - bflo(hi.y), wv[3] - bfhi(hi.y));
            lo.z = cvt_pk_bf16(wv[4] - bflo(hi.z), wv[5] - bfhi(hi.z)); lo.w = cvt_pk_bf16(wv[6] - bflo(hi.w), wv[7] - bfhi(hi.w));
            rwf[(size_t)(f * 2 + 0) * 64 + lane_] = hi; rwf[(size_t)(f * 2 + 1) * 64 + lane_] = lo;
        }
    }
}

template <int W>
__device__ __forceinline__ void pooldiff_item(const bf16_t* proj, bf16_t* dp, int t, int c8) {
    const int s = t & (S - 1);
    const bf16_t* base = proj + (size_t)t * D + c8;
    float sum[8];
#pragma unroll
    for (int e = 0; e < 8; ++e) sum[e] = 0.f;
    u32x4 self;
#pragma unroll
    for (int q = -W / 2; q < W / 2; ++q) { const bool ok = (s + q >= 0) && (s + q < S);
        u32x4 v = (u32x4){0u, 0u, 0u, 0u}; if (ok) v = *(const u32x4*)(base + (ptrdiff_t)q * D);
        if (q == 0) self = v;
#pragma unroll
        for (int e = 0; e < 4; ++e) { sum[2 * e] += bflo(v[e]); sum[2 * e + 1] += bfhi(v[e]); } }
    int lo = s - W / 2, hi = s + W / 2; lo = lo < 0 ? 0 : lo; hi = hi > S ? S : hi;
    const float inv = 1.0f / (float)(hi - lo);
    u32x4 o;
#pragma unroll
    for (int e = 0; e < 4; ++e) o[e] = cvt_pk_bf16(sum[2 * e] * inv - bflo(self[e]), sum[2 * e + 1] * inv - bfhi(self[e]));
    *(u32x4*)(dp + (size_t)t * DP + c8) = o;
}
__device__ void p2_pooldiff(const Args& a) {
    const bf16_t* proj = (const bf16_t*)(a.ws + WS_PROJ); bf16_t* dp = (bf16_t*)(a.ws + WS_DPOOL);
    const int n = T * (DP / 8);
    for (int i = blockIdx.x * 512 + threadIdx.x; i < n; i += gridDim.x * 512) {
        const int lane = i & 63, g = (i >> 6) & 3, t = (i >> 8) * 2 + (lane >> 5), c8 = (g * 32 + (lane & 31)) * 8;
        if (g == 0) pooldiff_item<2>(proj, dp, t, c8); else if (g == 1) pooldiff_item<4>(proj, dp, t, c8); else if (g == 2) pooldiff_item<8>(proj, dp, t, c8); else pooldiff_item<16>(proj, dp, t, c8);
    }
}

__device__ void p3_scan(const Args& a, unsigned char* lds) {
    const int tid = threadIdx.x, wid = tid >> 6, lane = tid & 63;
    unsigned char* ws = a.ws;
    const float* Sb = (const float*)(ws + WS_XB); bf16_t* A2 = (bf16_t*)(ws + WS_A2); const f32x2* a16 = (const f32x2*)(ws + WS_SSMP + SSMP_A16);
    f32x2* F = (f32x2*)lds;
    for (int job = blockIdx.x; job < 256; job += gridDim.x) {
        const int g = job >> 2, b = (job >> 1) & 1, dr = job & 1, p = lane;
        const f32x2 A = a16[(dr * NG + g) * NP + p];
        float pr = A.x, pi = A.y;
#pragma unroll
        for (int q = 0; q < 6; ++q) { const float nr = pr * pr - pi * pi, ni = 2.0f * pr * pi; pr = nr; pi = ni; }
        const float* sp = Sb + ((size_t)(g * 1024 + b * 512 + wid * 64)) * 256 + dr * 128 + p;
        float xr = 0.f, xi = 0.f;
#pragma unroll 8
        for (int q = 0; q < 64; ++q) { const int c = dr == 0 ? q : 63 - q; const float sr = sp[c * 256], si = sp[c * 256 + 64];
            const float nr = A.x * xr - A.y * xi + sr, ni = A.x * xi + A.y * xr + si; xr = nr; xi = ni; }
        __syncthreads();
        F[wid * 64 + p] = (f32x2){xr, xi};
        __syncthreads();
        float cr = 0.f, ci = 0.f;
        if (dr == 0) { for (int v = 0; v < wid; ++v) { const f32x2 f = F[v * 64 + p]; const float nr = pr * cr - pi * ci + f.x, ni = pr * ci + pi * cr + f.y; cr = nr; ci = ni; } }
        else { for (int v = 7; v > wid; --v) { const f32x2 f = F[v * 64 + p]; const float nr = pr * cr - pi * ci + f.x, ni = pr * ci + pi * cr + f.y; cr = nr; ci = ni; } }
        xr = cr; xi = ci;
        bf16_t* op = A2 + ((size_t)(g * 1024 + b * 512 + wid * 64)) * 512 + 256 + dr * 128 + p;
#pragma unroll 8
        for (int q = 0; q < 64; ++q) { const int c = dr == 0 ? q : 63 - q; const float sr = sp[c * 256], si = sp[c * 256 + 64];
            op[c * 512] = (bf16_t)(cvt_pk_bf16(xr, xr) & 0xffffu); op[c * 512 + 64] = (bf16_t)(cvt_pk_bf16(xi, xi) & 0xffffu);
            const float nr = A.x * xr - A.y * xi + sr, ni = A.x * xi + A.y * xr + si; xr = nr; xi = ni; }
    }
}

__device__ void p5_ln1_router(const Args& a, unsigned char* lds) {
    const int tid = threadIdx.x, wid = tid >> 6, lane = tid & 63, m = lane & 15, fq = lane >> 4;
    unsigned char* ws = a.ws;
    float* out = a.out; bf16_t* h1b = (bf16_t*)(ws + WS_PROJ); const u32x4* rwf = (const u32x4*)(ws + WS_RW);
    const float* g1 = a.in[15]; const float* b1 = a.in[16];
    unsigned* cnt = (unsigned*)(ws + WS_CTL);
    int* tok_e = (int*)(ws + WS_ROUTE + RT_E); int* tok_rank = (int*)(ws + WS_ROUTE + RT_RANK); float* tok_gate = (float*)(ws + WS_ROUTE + RT_GATE);
    float* PS = (float*)lds;
    float* PL = (float*)(lds + 1024);
    float* LG = (float*)(lds + 1024 + 24576);
    for (int grp = blockIdx.x; grp < T / 16; grp += gridDim.x) {
        const int t = grp * 16 + m; const size_t ro = (size_t)t * D + wid * 256 + fq * 8;
        f32x4 v[8][2];
#pragma unroll
        for (int ks = 0; ks < 8; ++ks) { v[ks][0] = *(const f32x4*)(out + ro + ks * 32); v[ks][1] = *(const f32x4*)(out + ro + ks * 32 + 4); }
        float s = 0.f, ss = 0.f;
#pragma unroll
        for (int ks = 0; ks < 8; ++ks)
#pragma unroll
            for (int h = 0; h < 2; ++h)
#pragma unroll
                for (int e = 0; e < 4; ++e) { const float x = v[ks][h][e]; s += x; ss += x * x; }
        s += __shfl_xor(s, 16); s += __shfl_xor(s, 32); ss += __shfl_xor(ss, 16); ss += __shfl_xor(ss, 32);
        if (fq == 0) { PS[(wid * 16 + m) * 2] = s; PS[(wid * 16 + m) * 2 + 1] = ss; }
        __syncthreads();
        float ts = 0.f, tss = 0.f;
#pragma unroll
        for (int w = 0; w < 8; ++w) { ts += PS[(w * 16 + m) * 2]; tss += PS[(w * 16 + m) * 2 + 1]; }
        const float mu = ts * (1.0f / D); const float rstd = rsqrtf(fmaxf(tss * (1.0f / D) - mu * mu, 0.f) + LN_EPS);
        f32x4 acc[3];
#pragma unroll
        for (int nt = 0; nt < 3; ++nt) acc[nt] = (f32x4){0.f, 0.f, 0.f, 0.f};
#pragma unroll
        for (int ks = 0; ks < 8; ++ks) {
            const int kk = wid * 256 + ks * 32 + fq * 8;
            const f32x4 ga = *(const f32x4*)(g1 + kk), gb = *(const f32x4*)(g1 + kk + 4), ba = *(const f32x4*)(b1 + kk), bb = *(const f32x4*)(b1 + kk + 4);
            const f32x4 h0 = (v[ks][0] - mu) * rstd * ga + ba, h1 = (v[ks][1] - mu) * rstd * gb + bb;
            *(f32x4*)(out + ro + ks * 32) = h0 * ALPHA; *(f32x4*)(out + ro + ks * 32 + 4) = h1 * ALPHA;
            u32x4 hi; hi.x = cvt_pk_bf16(h0[0], h0[1]); hi.y = cvt_pk_bf16(h0[2], h0[3]); hi.z = cvt_pk_bf16(h1[0], h1[1]); hi.w = cvt_pk_bf16(h1[2], h1[3]);
            *(u32x4*)(h1b + ro + ks * 32) = hi;
            u32x4 lo; lo.x = cvt_pk_bf16(h0[0] - bflo(hi.x), h0[1] - bfhi(hi.x)); lo.y = cvt_pk_bf16(h0[2] - bflo(hi.y), h0[3] - bfhi(hi.y));
            lo.z = cvt_pk_bf16(h1[0] - bflo(hi.z), h1[1] - bfhi(hi.z)); lo.w = cvt_pk_bf16(h1[2] - bflo(hi.w), h1[3] - bfhi(hi.w));
            const bf16x8 ahi = __builtin_bit_cast(bf16x8, hi), alo = __builtin_bit_cast(bf16x8, lo);
#pragma unroll
            for (int nt = 0; nt < 3; ++nt) { const size_t fo = (size_t)(((wid * 8 + ks) * 3 + nt) * 2) * 64 + lane;
                const bf16x8 whi = __builtin_bit_cast(bf16x8, rwf[fo]), wlo = __builtin_bit_cast(bf16x8, rwf[fo + 64]);
                acc[nt] = __builtin_amdgcn_mfma_f32_16x16x32_bf16(whi, ahi, acc[nt], 0, 0, 0);
                acc[nt] = __builtin_amdgcn_mfma_f32_16x16x32_bf16(whi, alo, acc[nt], 0, 0, 0);
                acc[nt] = __builtin_amdgcn_mfma_f32_16x16x32_bf16(wlo, ahi, acc[nt], 0, 0, 0); }
        }
#pragma unroll
        for (int nt = 0; nt < 3; ++nt) *(f32x4*)(PL + (wid * 16 + m) * 48 + nt * 16 + fq * 4) = acc[nt];
        __syncthreads();
        for (int i = tid; i < 16 * 48; i += 512) { const int mm = i / 48, j = i - mm * 48; float sm = 0.f;
#pragma unroll
            for (int w = 0; w < 8; ++w) sm += PL[(w * 16 + mm) * 48 + j];
            LG[i] = sm + (j < 4 ? a.in[18][j] : (j < NR ? a.in[20][j - 4] : 0.f)); }
        __syncthreads();
        if (tid < 16) {
            const float* l = LG + tid * 48;
            const float g0 = l[0], g1v = l[1], g2 = l[2], g3 = l[3];
            int gsel = 0; float gm = g0; if (g1v > gm) { gm = g1v; gsel = 1; } if (g2 > gm) { gm = g2; gsel = 2; } if (g3 > gm) { gm = g3; gsel = 3; }
            const float pg = 1.0f / (expf(g0 - gm) + expf(g1v - gm) + expf(g2 - gm) + expf(g3 - gm));
            float el[8];
#pragma unroll
            for (int i = 0; i < 8; ++i) el[i] = l[4 + gsel * 8 + i];
            int i1 = 0; float m1 = el[0];
#pragma unroll
            for (int i = 1; i < 8; ++i) if (el[i] > m1) { m1 = el[i]; i1 = i; }
            int i2 = -1; float m2 = -3.0e38f;
#pragma unroll
            for (int i = 0; i < 8; ++i) if (i != i1 && el[i] > m2) { m2 = el[i]; i2 = i; }
            const float e2 = expf(m2 - m1), inv = 1.0f / (1.0f + e2);
            const int tt = grp * 16 + tid; const int ea = gsel * 8 + i1, eb = gsel * 8 + i2;
            const unsigned ra = atomicAdd(cnt + ea, 1u), rb = atomicAdd(cnt + eb, 1u);
            tok_e[tt * 2] = ea; tok_e[tt * 2 + 1] = eb; tok_rank[tt * 2] = (int)ra; tok_rank[tt * 2 + 1] = (int)rb; tok_gate[tt * 2] = pg * inv; tok_gate[tt * 2 + 1] = pg * e2 * inv;
        }
    }
    __syncthreads();
}

__device__ __forceinline__ void moe_build_tab(const Args& a, int* tstart) {
    if (threadIdx.x == 0) { const unsigned* cnt = (const unsigned*)(a.ws + WS_CTL); int acc = 0;
        for (int e = 0; e < NE; ++e) { tstart[e] = acc; acc += ((int)__hip_atomic_load(cnt + e, __ATOMIC_RELAXED, __HIP_MEMORY_SCOPE_AGENT) + 255) >> 8; }
        tstart[NE] = acc; }
    __syncthreads();
}

__device__ void p6_slots(const Args& a, int* tstart) {
    unsigned char* ws = a.ws;
    const unsigned* cnt = (const unsigned*)(ws + WS_CTL);
    const int* tok_e = (const int*)(ws + WS_ROUTE + RT_E); const int* tok_rank = (const int*)(ws + WS_ROUTE + RT_RANK); const float* tok_gate = (const float*)(ws + WS_ROUTE + RT_GATE);
    int* slot_tok = (int*)(ws + WS_ROUTE + RT_STOK); float* slot_gate = (float*)(ws + WS_ROUTE + RT_SGATE);
    for (int i = blockIdx.x * 512 + threadIdx.x; i < T * 2; i += gridDim.x * 512) {
        const int e = tok_e[i], s = tstart[e] * 256 + tok_rank[i]; slot_tok[s] = i >> 1; slot_gate[s] = tok_gate[i]; }
    const int ns = tstart[NE] * 256;
    for (int s = blockIdx.x * 512 + threadIdx.x; s < ns; s += gridDim.x * 512) {
        const int e = moe_expert_of_tile(tstart, s >> 8); const int r = s - tstart[e] * 256;
        if (r >= (int)cnt[e]) { slot_tok[s] = -1; slot_gate[s] = 0.f; } }
}

__device__ void p9_ln2(const Args& a, const int* tstart) {
    const int tid = threadIdx.x, wid = tid >> 6, lane = tid & 63;
    const float* g2 = a.in[24]; const float* b2 = a.in[25];
    const bf16_t* ys = (const bf16_t*)(a.ws + WS_YS);
    const int* tok_e = (const int*)(a.ws + WS_ROUTE + RT_E); const int* tok_rank = (const int*)(a.ws + WS_ROUTE + RT_RANK);
    const int nw = gridDim.x * 8;
    for (int t = blockIdx.x * 8 + wid; t < T; t += nw) {
        float* row = a.out + (size_t)t * D;
        const size_t sa = (size_t)(tstart[tok_e[t * 2]] * 256 + tok_rank[t * 2]) * D, sb = (size_t)(tstart[tok_e[t * 2 + 1]] * 256 + tok_rank[t * 2 + 1]) * D;
        f32x4 h[8]; float s = 0.f;
#pragma unroll
        for (int i = 0; i < 8; ++i) { h[i] = *(const f32x4*)(row + i * 256 + lane * 4);
            const u32x2 ya = *(const u32x2*)(ys + sa + i * 256 + lane * 4), yb = *(const u32x2*)(ys + sb + i * 256 + lane * 4);
            h[i][0] += bflo(ya.x) + bflo(yb.x); h[i][1] += bfhi(ya.x) + bfhi(yb.x); h[i][2] += bflo(ya.y) + bflo(yb.y); h[i][3] += bfhi(ya.y) + bfhi(yb.y);
            s += (h[i][0] + h[i][1]) + (h[i][2] + h[i][3]); }
        const float mu = wave_sum(s) * (1.0f / D); float vq = 0.f;
#pragma unroll
        for (int i = 0; i < 8; ++i) { const f32x4 d = h[i] - mu; vq += (d[0] * d[0] + d[1] * d[1]) + (d[2] * d[2] + d[3] * d[3]); }
        const float rstd = rsqrtf(wave_sum(vq) * (1.0f / D) + LN_EPS);
#pragma unroll
        for (int i = 0; i < 8; ++i) { const f32x4 gv = *(const f32x4*)(g2 + i * 256 + lane * 4), bv = *(const f32x4*)(b2 + i * 256 + lane * 4);
            *(f32x4*)(row + i * 256 + lane * 4) = (h[i] - mu) * rstd * gv + bv; }
    }
}

constexpr int NPHASE = 12;
__global__ void __launch_bounds__(512, 2) fwd(Args a) {
    extern __shared__ __attribute__((aligned(16))) unsigned char lds[];
    cg::grid_group grid = cg::this_grid();
    unsigned char* ws = a.ws;
    int* tstart = (int*)(lds + MISC_OFF);
    volatile LAS unsigned* bst = (volatile LAS unsigned*)((LAS unsigned char*)lds + MISC_OFF + 256);
    if (threadIdx.x < 4) bst[threadIdx.x] = 0u;
    __syncthreads();
    XcdBarrier xbar = xcd_barrier_post((unsigned*)(ws + WS_BAR), bst);
    if (a.ph_hi > 1000) grid.sync();
#define IN(k) (a.ph_lo <= (k) && (k) < a.ph_hi)
#define SEAM(k) do { if (IN(k) && IN((k) + 1)) xcd_barrier(xbar); } while (0)
    for (int q = 0; q < PROBE_SYNC; ++q) xcd_barrier(xbar);
    if (IN(0)) for (int rep = 0; rep < (0 == PROBE_PHASE ? PROBE_REP : 1); ++rep) p0_prepass(a, lds);
    SEAM(0);
    if (IN(1)) { DescProj d{(const char*)(ws + WS_XB), (const char*)(ws + WS_WIN), (bf16_t*)(ws + WS_PROJ), (bf16_t*)(ws + WS_A2), D, D}; gemm_run<0>(lds, d); }
    SEAM(1);
    if (IN(2)) { for (int rep = 0; rep < (2 == PROBE_PHASE ? PROBE_REP : 1); ++rep) p2_pooldiff(a);
        DescS1 d{(const char*)(ws + WS_A2), (const char*)(ws + WS_W1T), (float*)(ws + WS_XB), 256, 256}; gemm_run<6>(lds, d); }
    SEAM(2);
    if (IN(3)) for (int rep = 0; rep < (3 == PROBE_PHASE ? PROBE_REP : 1); ++rep) p3_scan(a, lds);
    SEAM(3);
    if (IN(4)) {
        { DescS2 d{(const char*)(ws + WS_A2), (const char*)(ws + WS_W2T), (bf16_t*)(ws + WS_YSSM), 512, 512}; gemm_run<7>(lds, d); }
        { DescPool d{(const char*)(ws + WS_DPOOL), (const char*)(ws + WS_POOLW), (bf16_t*)(ws + WS_XB), a.in[3], 256, 256}; gemm_run<1>(lds, d); }
    }
    SEAM(4);
    if (IN(5)) { DescGlu d{(const char*)(ws + WS_YSSM), (const char*)(ws + WS_GLU), (bf16_t*)(ws + WS_XB), a.in[13], DS, DS}; gemm_run<2>(lds, d); }
    SEAM(5);
    if (IN(6)) { DescOut d{(const char*)(ws + WS_XB), (const char*)(ws + WS_WOUT), a.out, a.in[0], D, D}; gemm_run<3>(lds, d); }
    SEAM(6);
    if (IN(7)) p5_ln1_router(a, lds);
    SEAM(7);
    if (IN(8)) { moe_build_tab(a, tstart); for (int rep = 0; rep < (8 == PROBE_PHASE ? PROBE_REP : 1); ++rep) p6_slots(a, tstart); }
    SEAM(8);
    if (IN(9)) { moe_build_tab(a, tstart);
        DescGU d{(const char*)(ws + WS_PROJ), (const char*)(ws + WS_WGU), (bf16_t*)(ws + WS_DPOOL), (const int*)(ws + WS_ROUTE + RT_STOK), tstart, D, D}; gemm_run<4>(lds, d); }
    SEAM(9);
    if (IN(10)) { moe_build_tab(a, tstart);
        DescDown d{(const char*)(ws + WS_DPOOL), (const char*)(ws + WS_WD), (bf16_t*)(ws + WS_YS), (const float*)(ws + WS_ROUTE + RT_SGATE), tstart, DE, DE}; gemm_run<5>(lds, d); }
    SEAM(10);
    if (IN(11)) { moe_build_tab(a, tstart); p9_ln2(a, tstart); }
#undef IN
#undef SEAM
}

extern "C" void kernel_launch(void* const* d_in, const int* in_sizes, int n_in, void* d_out, int out_size, void* d_ws, size_t ws_size, hipStream_t stream) {
    static int grid = 0;
    if (grid == 0) {
        if (n_in != 26 || out_size != T * D || ws_size < WS_END) { fprintf(stderr, "kernel_launch: unexpected shapes (n_in %d out %d ws %zu)\n", n_in, out_size, ws_size); grid = -1; return; }
        int dev = 0, cus = 0, per_cu = 0;
        (void)hipGetDevice(&dev); (void)hipDeviceGetAttribute(&cus, hipDeviceAttributeMultiprocessorCount, dev);
        (void)hipFuncSetAttribute((const void*)fwd, hipFuncAttributeMaxDynamicSharedMemorySize, LDS_BYTES);
        (void)hipOccupancyMaxActiveBlocksPerMultiprocessor(&per_cu, (const void*)fwd, 512, LDS_BYTES);
        if (per_cu < 1) { fprintf(stderr, "kernel_launch: occupancy query says %d blocks/CU\n", per_cu); per_cu = 1; }
        grid = cus;
    }
    if (grid < 0) return;
    (void)hipMemsetAsync((char*)d_ws + WS_CTL, 0, CTL_ZERO_BYTES, stream);
    Args a{};
    for (int i = 0; i < 26; ++i) a.in[i] = (const float*)d_in[i];
    a.out = (float*)d_out; a.ws = (unsigned char*)d_ws;
#if N_LAUNCH_MODE == 0
    a.ph_lo = 0; a.ph_hi = NPHASE;
    void* args[] = {&a};
    hipError_t e = hipLaunchCooperativeKernel((const void*)fwd, dim3(grid), dim3(512), args, LDS_BYTES, stream);
    if (e != hipSuccess) fprintf(stderr, "cooperative launch failed: %s (grid %d)\n", hipGetErrorString(e), grid);
#else
    for (int p = 0; p < NPHASE; ++p) { a.ph_lo = p; a.ph_hi = p + 1; hipLaunchKernelGGL(fwd, dim3(grid), dim3(512), LDS_BYTES, stream, a); }
#endif
}
```

```cpp
#include <hip/hip_runtime.h>
#include <hip/hip_cooperative_groups.h>
#include <cstdio>
namespace cg = cooperative_groups;

#ifndef N_LAUNCH_MODE
#define N_LAUNCH_MODE 0
#endif
#ifndef PROBE_PHASE
#define PROBE_PHASE -1
#endif
#ifndef PROBE_REP
#define PROBE_REP 1
#endif
#ifndef PROBE_SYNC
#define PROBE_SYNC 0
#endif
#ifndef PROBE_TS_A
#define PROBE_TS_A -1
#endif
#ifndef PROBE_TS_B
#define PROBE_TS_B -1
#endif
#ifndef PROBE_GEMM
#define PROBE_GEMM -1
#endif
#ifndef NAIVE_MASK
#define NAIVE_MASK 0x00
#endif

typedef unsigned short bf16_t;
typedef short bf16x8 __attribute__((ext_vector_type(8)));
typedef float f32x4 __attribute__((ext_vector_type(4)));
typedef float f32x2 __attribute__((ext_vector_type(2)));
typedef unsigned u32x4 __attribute__((ext_vector_type(4)));
typedef unsigned u32x2 __attribute__((ext_vector_type(2)));

constexpr int T = 16384, D = 2048, S = 8192, NB = 2;
constexpr int DP = 1024, DS = 1024, NG = 64, GC = 16, NP = 64;
constexpr int NE = 32, DE = 512, NR = 36;
constexpr int MAXTILES = 161;
constexpr float LN_EPS = 1e-5f;
constexpr float ALPHA = 1.189207115002721f;

constexpr size_t MB = 1u << 20;
constexpr size_t WS_CTL = 0;
constexpr size_t WS_BAR = 65536;
constexpr size_t CTL_ZERO_BYTES = 131072;
constexpr size_t WS_YS = 281 * MB;
constexpr size_t WS_H1B = 217 * MB;
constexpr size_t WS_V1B = 281 * MB;
constexpr size_t WS_ST = 484 * MB;
constexpr size_t WS_HH = 442 * MB;
constexpr size_t WS_SSMP = 1 * MB;
constexpr size_t WS_RW = 3 * MB;
constexpr size_t WS_ROUTE = 4 * MB;
constexpr size_t WS_WIN = 6 * MB;
constexpr size_t WS_WOUT = 14 * MB;
constexpr size_t WS_GLU = 22 * MB;
constexpr size_t WS_POOLW = 24 * MB;
constexpr size_t WS_WGU = 25 * MB;
constexpr size_t WS_WD = 153 * MB;
constexpr size_t WS_XB = 217 * MB;
constexpr size_t WS_PROJ = 281 * MB;
constexpr size_t WS_DPOOL = 409 * MB;
constexpr size_t WS_YSSM = 441 * MB;
constexpr size_t WS_A2 = 345 * MB;
constexpr size_t WS_W1T = 484 * MB;
constexpr size_t WS_W2T = 492 * MB;
constexpr size_t WS_END = 508 * MB;
constexpr size_t SSMP_A16 = 1536 * 1024;

constexpr size_t WS_GC = 5 * MB + 512 * 1024;
constexpr size_t RT_E = 0, RT_RANK = (size_t)T * 2 * 4, RT_GATE = (size_t)T * 4 * 4, RT_STOK = (size_t)T * 6 * 4, RT_SGATE = RT_STOK + (size_t)MAXTILES * 256 * 4;

constexpr int LDS_BYTES = 128 * 1024 + 4096;
constexpr int MISC_OFF = 128 * 1024;

struct Args { const float* in[26]; float* out; unsigned char* ws; int ph_lo, ph_hi; };

__device__ __forceinline__ float bf2f(bf16_t b) { return __uint_as_float(((unsigned)b) << 16); }
__device__ __forceinline__ float bflo(unsigned w) { return __uint_as_float(w << 16); }
__device__ __forceinline__ float bfhi(unsigned w) { return __uint_as_float(w & 0xffff0000u); }
__device__ __forceinline__ unsigned cvt_pk_bf16(float lo, float hi) { unsigned r; asm("v_cvt_pk_bf16_f32 %0, %1, %2" : "=v"(r) : "v"(lo), "v"(hi)); return r; }
__device__ __forceinline__ float wave_sum(float v) {
#pragma unroll
    for (int o = 32; o >= 1; o >>= 1) v += __shfl_xor(v, o);
    return v;
}
__device__ __forceinline__ float gelu_tanh(float x) {
    const float u = 0.7978845608028654f * (x + 0.044715f * x * x * x);
    const float e = __expf(-2.0f * fabsf(u));
    float t = (1.0f - e) / (1.0f + e); t = u < 0.f ? -t : t;
    return 0.5f * x * (1.0f + t);
}
__device__ __forceinline__ float sigmoidf_(float z) { return 1.0f / (1.0f + __expf(-z)); }

#define LAS __attribute__((address_space(3)))
#define XB_TMO      128
#define XB_XCNT(j)  (256  + 64 * (j))
#define XB_XSUB(j)  (1280 + 64 * (j))
#define XB_XGEN(j)  (2304 + 64 * (j))
#define XB_TOP      3328
#define XB_TOPGEN   3392
#define XCD_BAR_WORDS 3456
#define XB_SPIN_CAP (1u << 18)
__device__ __forceinline__ unsigned xb_ld(unsigned* p)              { return __hip_atomic_load(p, __ATOMIC_RELAXED, __HIP_MEMORY_SCOPE_AGENT); }
__device__ __forceinline__ unsigned xb_add(unsigned* p, unsigned v) { return __hip_atomic_fetch_add(p, v, __ATOMIC_RELAXED, __HIP_MEMORY_SCOPE_AGENT); }
__device__ __forceinline__ unsigned xb_xcc_id() { return (unsigned)__builtin_amdgcn_s_getreg((3 << 11) | 20) & 0xFu; }
#define XB_SPIN(cond, bar) do { unsigned _sp = 0; while (cond) { __builtin_amdgcn_s_sleep(1); \
    if ((++_sp & 255u) == 0u) { if (xb_ld(&(bar)[XB_TMO])) break; if (_sp > XB_SPIN_CAP) { atomicAdd(&(bar)[XB_TMO], 1u); break; } } } } while (0)
struct XcdBarrier { unsigned* bar; unsigned x; volatile LAS unsigned* st; };
__device__ __forceinline__ XcdBarrier xcd_barrier_post(unsigned* bar, volatile LAS unsigned* st) {
    XcdBarrier b; b.bar = bar; b.x = xb_xcc_id(); b.st = st;
    if (threadIdx.x == 0) (void)xb_add(&bar[XB_XCNT(b.x)], 1u);
    return b;
}
__device__ __forceinline__ void xcd_barrier_complete(unsigned* bar, unsigned x, unsigned& nloc, unsigned& nx) {
    const unsigned G = gridDim.x * gridDim.y * gridDim.z;
    unsigned sum, cnt, mine, sp = 0u;
    for (;;) {
        sum = 0u; cnt = 0u; mine = 0u;
#pragma unroll
        for (unsigned j = 0; j < 16; ++j) { const unsigned c = xb_ld(&bar[XB_XCNT(j)]); sum += c; cnt += (c > 0u) ? 1u : 0u; mine = (j == x) ? c : mine; }
        if (sum == G) break;
        __builtin_amdgcn_s_sleep(1);
        if ((++sp & 255u) == 0u) { if (xb_ld(&bar[XB_TMO])) break; if (sp > XB_SPIN_CAP) { atomicAdd(&bar[XB_TMO], 1u); break; } }
    }
    nloc = mine > 0u ? mine : 1u; nx = cnt > 0u ? cnt : 1u;
}
__device__ __forceinline__ void xcd_barrier(const XcdBarrier& b) {
    asm volatile("s_waitcnt vmcnt(0)" ::: "memory");
    __syncthreads();
    if (threadIdx.x == 0) {
        unsigned* bar = b.bar;
        __builtin_amdgcn_s_waitcnt(0);
        unsigned nloc = b.st[0], nx = b.st[1];
        if (nloc == 0u) { xcd_barrier_complete(bar, b.x, nloc, nx); b.st[0] = nloc; b.st[1] = nx; }
        const unsigned old = xb_add(&bar[XB_XSUB(b.x)], 1u);
        const unsigned gen = old / nloc;
        if (old + 1u == (gen + 1u) * nloc) {
            __builtin_amdgcn_fence(__ATOMIC_RELEASE, "agent");
            asm volatile("s_waitcnt vmcnt(0)" ::: "memory");
            const unsigned og = xb_add(&bar[XB_TOP], 1u);
            const unsigned tg = og / nx;
            if (og + 1u == (tg + 1u) * nx) xb_add(&bar[XB_TOPGEN], 1u);
            else XB_SPIN(xb_ld(&bar[XB_TOPGEN]) == tg, bar);
            __builtin_amdgcn_fence(__ATOMIC_ACQUIRE, "agent");
            xb_add(&bar[XB_XGEN(b.x)], 1u);
            asm volatile("s_waitcnt vmcnt(0)" ::: "memory");
        } else {
            XB_SPIN(xb_ld(&bar[XB_XGEN(b.x)]) == gen, bar);
            __builtin_amdgcn_fence(__ATOMIC_ACQUIRE, "agent");
            asm volatile("s_waitcnt vmcnt(0)" ::: "memory");
        }
    }
    __syncthreads();
}

struct Unit { int r0, c0, e, pad; };

template <class DS_>
__device__ void gemm_naive(const DS_& d) {
    const int tid = threadIdx.x, wid = tid >> 6, lane = tid & 63, wr = wid >> 2, wc = wid & 3, fr = lane & 15, fq = lane >> 4;
    const int K = d.K; const size_t ldb2 = (size_t)d.ldb * 2;
    for (int ui = blockIdx.x;; ui += gridDim.x) {
        Unit u; if (!d.get(ui, u)) break;
        f32x4 acc[2][2][4][2];
        const char* Bp = d.b_ptr(u);
#pragma unroll
        for (int ai = 0; ai < 2; ++ai)
#pragma unroll
            for (int m = 0; m < 4; ++m) {
                const int r = 128 * ai + 64 * wr + 16 * m + fr;
                const char* ap = d.A + d.a_off(u, r);
#pragma unroll
                for (int bj = 0; bj < 2; ++bj)
#pragma unroll
                    for (int n = 0; n < 2; ++n) {
                        const int c = 128 * bj + 32 * wc + 16 * n + 4 * fq;
                        const char* bp = Bp + (size_t)c * ldb2;
                        float s0 = 0.f, s1 = 0.f, s2 = 0.f, s3 = 0.f;
                        for (int k = 0; k < K; k += 8) {
                            const u32x4 av = *(const u32x4*)(ap + k * 2);
                            const u32x4 b0 = *(const u32x4*)(bp + k * 2), b1 = *(const u32x4*)(bp + ldb2 + k * 2), b2 = *(const u32x4*)(bp + 2 * ldb2 + k * 2), b3 = *(const u32x4*)(bp + 3 * ldb2 + k * 2);
#pragma unroll
                            for (int j = 0; j < 4; ++j) {
                                const float al = bflo(av[j]), ah = bfhi(av[j]);
                                s0 += al * bflo(b0[j]); s0 += ah * bfhi(b0[j]);
                                s1 += al * bflo(b1[j]); s1 += ah * bfhi(b1[j]);
                                s2 += al * bflo(b2[j]); s2 += ah * bfhi(b2[j]);
                                s3 += al * bflo(b3[j]); s3 += ah * bfhi(b3[j]);
                            }
                        }
                        acc[ai][bj][m][n] = (f32x4){s0, s1, s2, s3};
                    }
            }
        d.epi(acc, u, wr, wc, fr, fq);
    }
}

constexpr int BK = 64, HALF = 128, HTB = HALF * BK * 2;
__device__ __forceinline__ int lds_byte(int r, int c) { const int st = (r >> 4) * 2 + (c >> 5), rr = r & 15, cc = c & 31, ob = rr * 64 + cc * 2; return st * 1024 + (ob ^ (((ob >> 9) & 1) << 5)); }
__device__ __forceinline__ void stage_rc(int b, int& R, int& C) { const int st = b / 1024, sb = b % 1024, swz = sb ^ (((sb >> 9) & 1) << 5); R = (st >> 1) * 16 + swz / 64; C = (st & 1) * 32 + (swz % 64) / 2; }

template <class DS_>
__device__ __forceinline__ void gemm_fast(LAS unsigned char* lds, const DS_& d) {
    const int tid = threadIdx.x, wid = __builtin_amdgcn_readfirstlane(tid >> 6), lane = tid & 63, wr = wid >> 2, wc = wid & 3, fr = lane & 15, fq = lane >> 4;
    const int K = d.K, nt = K / BK;
    int Rr[2], Cc[2]; unsigned voffB[2];
#pragma unroll
    for (int i = 0; i < 2; ++i) { stage_rc(tid * 16 + i * 8192, Rr[i], Cc[i]); voffB[i] = (unsigned)(Rr[i] * d.ldb + Cc[i]) * 2u; }
    const size_t kstep = (size_t)(BK * 2);
    const size_t hstepB = (size_t)HALF * d.ldb * 2;
    const unsigned ldsw = (unsigned)wid * 1024u;
    const int aoff = lds_byte(wr * 64 + fr, fq * 8), boff = lds_byte(wc * 32 + fr, fq * 8);
#define G_SA(b, h) (((b) * 2 + (h)) * HTB)
#define G_SB(b, h) ((4 + (b) * 2 + (h)) * HTB)
#define G_STAGE(bufoff, gbase, voff) do { _Pragma("unroll") for (int _i = 0; _i < 2; ++_i) \
        __builtin_amdgcn_global_load_lds((const unsigned*)((const char*)(gbase) + (voff)[_i]), (LAS unsigned*)(lds + (bufoff) + ldsw + _i * 8192), 16, 0, 0); } while (0)
#define G_LDA(dst, b, h) do { _Pragma("unroll") for (int m = 0; m < 4; ++m) _Pragma("unroll") for (int k = 0; k < 2; ++k) dst[m][k] = *(const LAS bf16x8*)(lds + G_SA(b, h) + aoff + m * 2048 + k * 1024); } while (0)
#define G_LDB(dst, b, h) do { _Pragma("unroll") for (int n = 0; n < 2; ++n) _Pragma("unroll") for (int k = 0; k < 2; ++k) dst[n][k] = *(const LAS bf16x8*)(lds + G_SB(b, h) + boff + n * 2048 + k * 1024); } while (0)
#define G_MMA(ai, bj, At, Bt) do { __builtin_amdgcn_s_setprio(1); _Pragma("unroll") for (int m = 0; m < 4; ++m) _Pragma("unroll") for (int n = 0; n < 2; ++n) _Pragma("unroll") for (int k = 0; k < 2; ++k) \
        acc[ai][bj][m][n] = __builtin_amdgcn_mfma_f32_16x16x32_bf16(Bt[n][k], At[m][k], acc[ai][bj][m][n], 0, 0, 0); __builtin_amdgcn_s_setprio(0); } while (0)
#define G_WAIT_V(n) asm volatile("s_waitcnt vmcnt(" #n ")" ::: "memory")
#define G_WAIT_L(n) asm volatile("s_waitcnt lgkmcnt(" #n ")" ::: "memory")
#define G_BAR __builtin_amdgcn_s_barrier()
#define G_SCHED __builtin_amdgcn_sched_barrier(0)
    Unit cur, nxt; int ui = blockIdx.x;
    if (!d.get(ui, cur)) return;
    f32x4 acc[2][2][4][2];
#pragma unroll
    for (int a_ = 0; a_ < 2; ++a_)
#pragma unroll
        for (int b_ = 0; b_ < 2; ++b_)
#pragma unroll
            for (int m = 0; m < 4; ++m)
#pragma unroll
                for (int n = 0; n < 2; ++n) acc[a_][b_][m][n] = (f32x4){0.f, 0.f, 0.f, 0.f};
    bf16x8 At[4][2], B0[2][2], B1[2][2];
    unsigned vA[2][2], nvA[2][2];
#pragma unroll
    for (int h = 0; h < 2; ++h)
#pragma unroll
        for (int i = 0; i < 2; ++i) vA[h][i] = d.a_off(cur, h * HALF + Rr[i]) + (unsigned)Cc[i] * 2u;
    const char* const Ab = d.A;
    const char* cB = d.b_ptr(cur);
    G_STAGE(G_SB(0, 0), cB, voffB); G_STAGE(G_SA(0, 0), Ab, vA[0]); G_STAGE(G_SB(0, 1), cB + hstepB, voffB); G_STAGE(G_SA(0, 1), Ab, vA[1]);
    if (wr == 1) G_BAR;
    G_WAIT_V(4); G_BAR;
    G_STAGE(G_SB(1, 0), cB + kstep, voffB); G_STAGE(G_SA(1, 0), Ab + kstep, vA[0]); G_STAGE(G_SB(1, 1), cB + hstepB + kstep, voffB);
    G_WAIT_V(6); G_BAR;
    for (;;) {
        const bool has_next = d.get(ui + (int)gridDim.x, nxt);
        const char* nB = has_next ? d.b_ptr(nxt) : cB;
#pragma unroll
        for (int h = 0; h < 2; ++h)
#pragma unroll
            for (int i = 0; i < 2; ++i) nvA[h][i] = has_next ? (d.a_off(nxt, h * HALF + Rr[i]) + (unsigned)Cc[i] * 2u) : vA[h][i];
        for (int t = 0; t < nt; t += 2) {
            const bool last = (t == nt - 2);
            const char* a1 = Ab + (size_t)(t + 1) * kstep;
            const char* a2 = last ? Ab : Ab + (size_t)(t + 2) * kstep; const char* b2 = last ? nB : cB + (size_t)(t + 2) * kstep;
            const char* a3 = a2 + kstep; const char* b3 = b2 + kstep;
            unsigned va2[2][2];
#pragma unroll
            for (int h = 0; h < 2; ++h)
#pragma unroll
                for (int i = 0; i < 2; ++i) va2[h][i] = last ? nvA[h][i] : vA[h][i];
            G_LDB(B0, 0, 0); G_SCHED; G_LDA(At, 0, 0); G_STAGE(G_SA(1, 1), a1, vA[1]);
            G_WAIT_L(8); G_BAR; G_WAIT_L(0); G_MMA(0, 0, At, B0); G_BAR; G_SCHED;
            G_LDB(B1, 0, 1); G_STAGE(G_SB(0, 0), b2, voffB);
            G_BAR; G_WAIT_L(0); G_MMA(0, 1, At, B1); G_BAR;
            G_LDA(At, 0, 1); G_STAGE(G_SA(0, 0), a2, va2[0]);
            G_BAR; G_WAIT_L(0); G_MMA(1, 0, At, B0); G_BAR; G_SCHED;
            G_STAGE(G_SB(0, 1), b2 + hstepB, voffB);
            G_WAIT_V(6); G_BAR; G_MMA(1, 1, At, B1); G_BAR;
            G_LDB(B0, 1, 0); G_SCHED; G_LDA(At, 1, 0); G_STAGE(G_SA(0, 1), a2, va2[1]);
            G_WAIT_L(8); G_BAR; G_WAIT_L(0); G_MMA(0, 0, At, B0); G_BAR; G_SCHED;
            G_LDB(B1, 1, 1); G_STAGE(G_SB(1, 0), b3, voffB);
            G_BAR; G_WAIT_L(0); G_MMA(0, 1, At, B1); G_BAR;
            G_LDA(At, 1, 1); G_STAGE(G_SA(1, 0), a3, va2[0]);
            G_BAR; G_WAIT_L(0); G_MMA(1, 0, At, B0); G_BAR; G_SCHED;
            G_STAGE(G_SB(1, 1), b3 + hstepB, voffB);
            G_WAIT_V(6); G_BAR; G_MMA(1, 1, At, B1); G_BAR;
        }
        d.epi(acc, cur, wr, wc, fr, fq);
        if (!has_next) break;
#pragma unroll
        for (int a_ = 0; a_ < 2; ++a_)
#pragma unroll
            for (int b_ = 0; b_ < 2; ++b_)
#pragma unroll
                for (int m = 0; m < 4; ++m)
#pragma unroll
                    for (int n = 0; n < 2; ++n) acc[a_][b_][m][n] = (f32x4){0.f, 0.f, 0.f, 0.f};
        cur = nxt; cB = nB; ui += (int)gridDim.x;
#pragma unroll
        for (int h = 0; h < 2; ++h)
#pragma unroll
            for (int i = 0; i < 2; ++i) vA[h][i] = nvA[h][i];
    }
    G_WAIT_V(0);
    if (wr == 0) G_BAR;
    G_BAR;
#undef G_SA
#undef G_SB
#undef G_STAGE
#undef G_LDA
#undef G_LDB
#undef G_MMA
#undef G_WAIT_V
#undef G_WAIT_L
#undef G_BAR
#undef G_SCHED
}
template <int BIT, class DS_>
__device__ __forceinline__ void gemm_run(unsigned char* lds, const DS_& d) {
    if constexpr ((NAIVE_MASK >> BIT) & 1) gemm_naive(d); else gemm_fast((LAS unsigned char*)lds, d);
}

__device__ __forceinline__ bool static_order(int L, int nM, int nN, int& pm, int& pn) {
    const int nwg = nM * nN; if (L >= nwg) return false;
    int wgid = L; { const int q = nwg / 8, r = nwg % 8, xcd = wgid % 8, off = wgid / 8; wgid = (xcd < r ? xcd * (q + 1) : r * (q + 1) + (xcd - r) * q) + off; }
    const int nig = 8 * nN, gid = wgid / nig, fm = gid * 8, gsz = (nM - fm) < 8 ? (nM - fm) : 8;
    pm = fm + ((wgid % nig) % gsz); pn = (wgid % nig) / gsz; return true;
}

#define EPI_LOOP_BEGIN _Pragma("unroll") for (int ai = 0; ai < 2; ++ai) _Pragma("unroll") for (int m = 0; m < 4; ++m) { const int lr = 128 * ai + 64 * wr + 16 * m + fr; \
    _Pragma("unroll") for (int bj = 0; bj < 2; ++bj) _Pragma("unroll") for (int n = 0; n < 2; ++n) { const int lc = 128 * bj + 32 * wc + 16 * n + 4 * fq; const f32x4 v = acc[ai][bj][m][n];
#define EPI_LOOP_END } }

struct DescProj {
    const char* A; const char* Bt; bf16_t* O; bf16_t* A2; int K, ldb;
    __device__ bool get(int i, Unit& u) const { int pm, pn; if (i >= 512 * ((0) == PROBE_GEMM ? PROBE_REP : 1)) return false; i %= 512; if (!static_order(i, T / 256, D / 256, pm, pn)) return false; u.r0 = pm * 256; u.c0 = pn * 256; u.e = 0; u.pad = 0; return true; }
    __device__ unsigned a_off(const Unit& u, int r) const { return (unsigned)(u.r0 + r) * (unsigned)(D * 2); }
    __device__ const char* b_ptr(const Unit& u) const { return Bt + (size_t)u.c0 * D * 2; }
    __device__ void epi(const f32x4 (&acc)[2][2][4][2], const Unit& u, int wr, int wc, int fr, int fq) const {
        EPI_LOOP_BEGIN
            u32x2 w; w.x = cvt_pk_bf16(v[0], v[1]); w.y = cvt_pk_bf16(v[2], v[3]);
            const int t = u.r0 + lr, nn = u.c0 + lc;
            if (u.c0 < DP) *(u32x2*)(O + (size_t)t * D + nn) = w;
            else { const int g = (nn - DP) >> 4, co = (nn - DP) & 15; *(u32x2*)(A2 + ((size_t)(g * 1024 + (t >> 4))) * 512 + (t & 15) * 16 + co) = w; }
        EPI_LOOP_END
    }
};
struct DescS1 {
    const char* A; const char* Bt; float* O; int K, ldb;
    __device__ bool get(int i, Unit& u) const { if (i >= 256 * ((6) == PROBE_GEMM ? PROBE_REP : 1)) return false; i &= 255; u.e = i >> 2; u.r0 = (i & 3) * 256; u.c0 = 0; u.pad = 0; return true; }
    __device__ unsigned a_off(const Unit& u, int r) const { return (unsigned)(u.e * 1024 + u.r0 + r) * 1024u; }
    __device__ const char* b_ptr(const Unit& u) const { return Bt + (size_t)u.e * 256 * 256 * 2; }
    __device__ void epi(const f32x4 (&acc)[2][2][4][2], const Unit& u, int wr, int wc, int fr, int fq) const {
        EPI_LOOP_BEGIN
            *(f32x4*)(O + ((size_t)(u.e * 1024 + u.r0 + lr)) * 256 + lc) = v;
        EPI_LOOP_END
    }
};
struct DescS2 {
    const char* A; const char* Bt; bf16_t* O; int K, ldb;
    __device__ bool get(int i, Unit& u) const { if (i >= 256 * ((7) == PROBE_GEMM ? PROBE_REP : 1)) return false; i &= 255; u.e = i >> 2; u.r0 = (i & 3) * 256; u.c0 = 0; u.pad = 0; return true; }
    __device__ unsigned a_off(const Unit& u, int r) const { return (unsigned)(u.e * 1024 + u.r0 + r) * 1024u; }
    __device__ const char* b_ptr(const Unit& u) const { return Bt + (size_t)u.e * 256 * 512 * 2; }
    __device__ void epi(const f32x4 (&acc)[2][2][4][2], const Unit& u, int wr, int wc, int fr, int fq) const {
        EPI_LOOP_BEGIN
            const int t = (u.r0 + lr) * 16 + (lc >> 4), co = lc & 15;
            u32x2 w; w.x = cvt_pk_bf16(gelu_tanh(v[0]), gelu_tanh(v[1])); w.y = cvt_pk_bf16(gelu_tanh(v[2]), gelu_tanh(v[3]));
            *(u32x2*)(O + (size_t)t * DS + u.e * 16 + co) = w;
        EPI_LOOP_END
    }
};
struct DescPool {
    const char* A; const char* Bt; bf16_t* O; const float* scale; int K, ldb;
    __device__ bool get(int i, Unit& u) const { if (i >= 256 * ((1) == PROBE_GEMM ? PROBE_REP : 1)) return false; i &= 255; u.e = i & 3; u.r0 = (i >> 2) * 256; u.c0 = u.e * 256; u.pad = 0; return true; }
    __device__ unsigned a_off(const Unit& u, int r) const { return ((unsigned)(u.r0 + r) * (unsigned)DP + (unsigned)u.e * 256u) * 2u; }
    __device__ const char* b_ptr(const Unit& u) const { return Bt + (size_t)u.e * 256 * 256 * 2; }
    __device__ void epi(const f32x4 (&acc)[2][2][4][2], const Unit& u, int wr, int wc, int fr, int fq) const {
        f32x4 scv[2][2];
#pragma unroll
        for (int bj = 0; bj < 2; ++bj)
#pragma unroll
            for (int n = 0; n < 2; ++n) scv[bj][n] = *(const f32x4*)(scale + u.c0 + 128 * bj + 32 * wc + 16 * n + 4 * fq);
        EPI_LOOP_BEGIN
            const f32x4 sc = scv[bj][n];
            u32x2 w; w.x = cvt_pk_bf16(v[0] * sc[0], v[1] * sc[1]); w.y = cvt_pk_bf16(v[2] * sc[2], v[3] * sc[3]);
            *(u32x2*)(O + (size_t)(u.r0 + lr) * D + u.c0 + lc) = w;
        EPI_LOOP_END
    }
};
struct DescGlu {
    const char* A; const char* Bt; bf16_t* O; const float* bias; int K, ldb;
    __device__ bool get(int i, Unit& u) const { int pm, pn; if (i >= 256 * ((2) == PROBE_GEMM ? PROBE_REP : 1)) return false; i %= 256; if (!static_order(i, T / 256, DS / 256, pm, pn)) return false; u.r0 = pm * 256; u.c0 = pn * 256; u.e = 0; u.pad = 0; return true; }
    __device__ unsigned a_off(const Unit& u, int r) const { return (unsigned)(u.r0 + r) * (unsigned)(DS * 2); }
    __device__ const char* b_ptr(const Unit& u) const { return Bt + (size_t)u.c0 * DS * 2; }
    __device__ void epi(const f32x4 (&acc)[2][2][4][2], const Unit& u, int wr, int wc, int fr, int fq) const {
        f32x4 bvv[2][2];
#pragma unroll
        for (int bj = 0; bj < 2; ++bj)
#pragma unroll
            for (int n = 0; n < 2; ++n) bvv[bj][n] = *(const f32x4*)(bias + u.c0 + 128 * bj + 32 * wc + 16 * n + 4 * fq);
        const char* __restrict__ Yp = A + ((size_t)(u.r0 + 64 * wr + fr) * DS + u.c0 + 32 * wc + 4 * fq) * 2;
        u32x2 yc[4], yn[4];
#pragma unroll
        for (int q = 0; q < 4; ++q) yc[q] = *(const u32x2*)(Yp + ((q >> 1) * 128 + (q & 1) * 16) * 2);
#pragma unroll
        for (int rg = 0; rg < 8; ++rg) { const int ai = rg >> 2, m = rg & 3; const int lr = 128 * ai + 64 * wr + 16 * m + fr;
            if (rg < 7) { const int ai2 = (rg + 1) >> 2, m2 = (rg + 1) & 3;
#pragma unroll
                for (int q = 0; q < 4; ++q) yn[q] = *(const u32x2*)(Yp + ((size_t)(128 * ai2 + 16 * m2) * DS + (q >> 1) * 128 + (q & 1) * 16) * 2); }
#pragma unroll
            for (int bj = 0; bj < 2; ++bj)
#pragma unroll
                for (int n = 0; n < 2; ++n) { const int lc = 128 * bj + 32 * wc + 16 * n + 4 * fq; const f32x4 v = acc[ai][bj][m][n]; const f32x4 bv = bvv[bj][n]; const u32x2 yw = yc[bj * 2 + n];
                    const float y0 = bflo(yw.x), y1 = bfhi(yw.x), y2 = bflo(yw.y), y3 = bfhi(yw.y);
                    u32x2 w; w.x = cvt_pk_bf16(y0 * sigmoidf_(v[0] + bv[0]), y1 * sigmoidf_(v[1] + bv[1])); w.y = cvt_pk_bf16(y2 * sigmoidf_(v[2] + bv[2]), y3 * sigmoidf_(v[3] + bv[3]));
                    *(u32x2*)(O + (size_t)(u.r0 + lr) * D + DP + u.c0 + lc) = w; }
#pragma unroll
            for (int q = 0; q < 4; ++q) yc[q] = yn[q]; }
    }
};
struct DescOut {
    const char* A; const char* Bt; bf16_t* O; const float* X; float* ST; int K, ldb;
    __device__ bool get(int i, Unit& u) const { int pm, pn; if (i >= 512 * ((3) == PROBE_GEMM ? PROBE_REP : 1)) return false; i %= 512; if (!static_order(i, T / 256, D / 256, pm, pn)) return false; u.r0 = pm * 256; u.c0 = pn * 256; u.e = 0; u.pad = 0; return true; }
    __device__ unsigned a_off(const Unit& u, int r) const { return (unsigned)(u.r0 + r) * (unsigned)(D * 2); }
    __device__ const char* b_ptr(const Unit& u) const { return Bt + (size_t)u.c0 * D * 2; }
    __device__ void epi(const f32x4 (&acc)[2][2][4][2], const Unit& u, int wr, int wc, int fr, int fq) const {
        const float* __restrict__ Xp = X + (size_t)(u.r0 + 64 * wr + fr) * D + u.c0 + 32 * wc + 4 * fq;
        f32x4 xc[4], xn[4];
#pragma unroll
        for (int q = 0; q < 4; ++q) xc[q] = *(const f32x4*)(Xp + (q >> 1) * 128 + (q & 1) * 16);
#pragma unroll
        for (int rg = 0; rg < 8; ++rg) { const int ai = rg >> 2, m = rg & 3; const int lr = 128 * ai + 64 * wr + 16 * m + fr; float s = 0.f, ss = 0.f;
            if (rg < 7) { const int ai2 = (rg + 1) >> 2, m2 = (rg + 1) & 3;
#pragma unroll
                for (int q = 0; q < 4; ++q) xn[q] = *(const f32x4*)(Xp + (size_t)(128 * ai2 + 16 * m2) * D + (q >> 1) * 128 + (q & 1) * 16); }
#pragma unroll
            for (int bj = 0; bj < 2; ++bj)
#pragma unroll
                for (int n = 0; n < 2; ++n) { const int lc = 128 * bj + 32 * wc + 16 * n + 4 * fq; const size_t o = (size_t)(u.r0 + lr) * D + u.c0 + lc;
                    const f32x4 v = xc[bj * 2 + n] * ALPHA + acc[ai][bj][m][n];
                    s += (v[0] + v[1]) + (v[2] + v[3]); ss += (v[0] * v[0] + v[1] * v[1]) + (v[2] * v[2] + v[3] * v[3]);
                    u32x2 w; w.x = cvt_pk_bf16(v[0], v[1]); w.y = cvt_pk_bf16(v[2], v[3]);
                    *(u32x2*)(O + o) = w; }
            s += __shfl_xor(s, 16); s += __shfl_xor(s, 32); ss += __shfl_xor(ss, 16); ss += __shfl_xor(ss, 32);
            if (fq == 0) *(f32x2*)(ST + ((size_t)(u.r0 + lr) * 32 + (u.c0 >> 8) * 4 + wc) * 2) = (f32x2){s, ss};
#pragma unroll
            for (int q = 0; q < 4; ++q) xc[q] = xn[q]; }
    }
};
struct MoeTab { const int* tstart; };
__device__ __forceinline__ int moe_expert_of_tile(const int* tstart, int tile) { int e = 0;
#pragma unroll 1
    for (int j = 1; j < NE; ++j) e += (tile >= tstart[j]) ? 1 : 0;
    return e; }
__device__ __forceinline__ bool moe_order(int nt, int npn, int i, int& tile, int& pn) {
    const int G = (int)gridDim.x, r = i / G, b = i - r * G, per = G >> 3, x = b & 7, j = b >> 3;
    const int lo = (x * nt) >> 3, hi = ((x + 1) * nt) >> 3, u = j + per * r;
    if (j >= per || u >= (hi - lo) * npn) return false;
    tile = lo + u / npn; pn = u - (u / npn) * npn; return true;
}
struct DescGU {
    const char* A; const char* Bt; bf16_t* O; const int* slot_tok; const int* tstart; int K, ldb;
    __device__ bool get(int i, Unit& u) const { int tile, pn; if (!moe_order(tstart[NE], 4, i, tile, pn)) return false; u.r0 = tile * 256; u.c0 = pn * 256; u.e = moe_expert_of_tile(tstart, tile); u.pad = 0; return true; }
    __device__ unsigned a_off(const Unit& u, int r) const { int t = slot_tok[u.r0 + r]; t = t < 0 ? 0 : t; return (unsigned)t * (unsigned)(D * 2); }
    __device__ const char* b_ptr(const Unit& u) const { return Bt + ((size_t)u.e * 1024 + u.c0) * D * 2; }
    __device__ void epi(const f32x4 (&acc)[2][2][4][2], const Unit& u, int wr, int wc, int fr, int fq) const {
#pragma unroll
        for (int ai = 0; ai < 2; ++ai)
#pragma unroll
            for (int m = 0; m < 4; ++m) { const int lr = 128 * ai + 64 * wr + 16 * m + fr;
#pragma unroll
                for (int n = 0; n < 2; ++n) { const int lc = 32 * wc + 16 * n + 4 * fq; const f32x4 g = acc[ai][0][m][n], up = acc[ai][1][m][n];
                    f32x4 h;
#pragma unroll
                    for (int j = 0; j < 4; ++j) h[j] = g[j] * sigmoidf_(g[j]) * up[j];
                    u32x2 w; w.x = cvt_pk_bf16(h[0], h[1]); w.y = cvt_pk_bf16(h[2], h[3]);
                    *(u32x2*)(O + (size_t)(u.r0 + lr) * DE + (u.c0 >> 1) + lc) = w; } }
    }
};
struct DescDown {
    const char* A; const char* Bt; bf16_t* O; const float* slot_gate; const int* tstart; int K, ldb;
    __device__ bool get(int i, Unit& u) const { int tile, pn; if (!moe_order(tstart[NE], 8, i, tile, pn)) return false; u.r0 = tile * 256; u.c0 = pn * 256; u.e = moe_expert_of_tile(tstart, tile); u.pad = 0; return true; }
    __device__ unsigned a_off(const Unit& u, int r) const { return (unsigned)(u.r0 + r) * (unsigned)(DE * 2); }
    __device__ const char* b_ptr(const Unit& u) const { return Bt + ((size_t)u.e * D + u.c0) * DE * 2; }
    __device__ void epi(const f32x4 (&acc)[2][2][4][2], const Unit& u, int wr, int wc, int fr, int fq) const {
        float gts[8];
#pragma unroll
        for (int rg = 0; rg < 8; ++rg) gts[rg] = slot_gate[u.r0 + 128 * (rg >> 2) + 64 * wr + 16 * (rg & 3) + fr];
#pragma unroll
        for (int ai = 0; ai < 2; ++ai)
#pragma unroll
            for (int m = 0; m < 4; ++m) { const int lr = 128 * ai + 64 * wr + 16 * m + fr; const float gt = gts[ai * 4 + m];
#pragma unroll
                for (int bj = 0; bj < 2; ++bj)
#pragma unroll
                    for (int n = 0; n < 2; ++n) { const int lc = 128 * bj + 32 * wc + 16 * n + 4 * fq; const f32x4 v = acc[ai][bj][m][n] * gt;
                        u32x2 w; w.x = cvt_pk_bf16(v[0], v[1]); w.y = cvt_pk_bf16(v[2], v[3]);
                        *(u32x2*)(O + (size_t)(u.r0 + lr) * D + u.c0 + lc) = w; } }
    }
};

__device__ __forceinline__ void tr_job(const Args& a, int j, const float*& src, int& lds_, bf16_t*& dst, int& ldd) {
    unsigned char* ws = a.ws;
    if (j < 1024) { const int kt = j >> 5, nt = j & 31; src = a.in[1] + (size_t)kt * 64 * D + nt * 64; lds_ = D; dst = (bf16_t*)(ws + WS_WIN) + (size_t)nt * 64 * D + kt * 64; ldd = D; return; }
    j -= 1024;
    if (j < 1024) { const int kt = j >> 5, nt = j & 31; src = a.in[14] + (size_t)kt * 64 * D + nt * 64; lds_ = D; dst = (bf16_t*)(ws + WS_WOUT) + (size_t)nt * 64 * D + kt * 64; ldd = D; return; }
    j -= 1024;
    if (j < 256) { const int kt = j >> 4, nt = j & 15; src = a.in[12] + (size_t)kt * 64 * DS + nt * 64; lds_ = DS; dst = (bf16_t*)(ws + WS_GLU) + (size_t)nt * 64 * DS + kt * 64; ldd = DS; return; }
    j -= 256;
    if (j < 64) { const int g = j >> 4, r = j & 15, kt = r >> 2, nt = r & 3; src = a.in[2] + (size_t)g * 65536 + kt * 64 * 256 + nt * 64; lds_ = 256; dst = (bf16_t*)(ws + WS_POOLW) + (size_t)g * 65536 + nt * 64 * 256 + kt * 64; ldd = 256; return; }
    j -= 64;
    if (j < 16384) { const int up = j >= 8192; if (up) j -= 8192; const int e = j >> 8, r = j & 255, kt = r >> 3, nt = r & 7, n0 = nt * 64;
        src = (up ? a.in[22] : a.in[21]) + (size_t)e * D * DE + (size_t)kt * 64 * DE + n0; lds_ = DE;
        const int drow = (n0 >> 7) * 256 + (n0 & 127) + (up ? 128 : 0);
        dst = (bf16_t*)(ws + WS_WGU) + ((size_t)e * 1024 + drow) * D + kt * 64; ldd = D; return; }
    j -= 16384;
    { const int e = j >> 8, r = j & 255, kt = r >> 5, nt = r & 31; src = a.in[23] + (size_t)e * DE * D + (size_t)kt * 64 * D + nt * 64; lds_ = D;
      dst = (bf16_t*)(ws + WS_WD) + ((size_t)e * D + nt * 64) * DE + kt * 64; ldd = DE; }
}
constexpr int TR_JOBS = 1024 + 1024 + 256 + 64 + 16384 + 8192;

__device__ void p0_prepass(const Args& a, unsigned char* lds) {
    const int tid = threadIdx.x, G = gridDim.x, bid = blockIdx.x;
    unsigned char* ws = a.ws;
    {
        const f32x4* x4 = (const f32x4*)a.in[0]; u32x4* xb = (u32x4*)(ws + WS_XB);
        const size_t n8 = (size_t)T * D / 8, stride = (size_t)G * 512;
        for (size_t i = (size_t)bid * 512 + tid; i < n8; i += 4 * stride) {
            f32x4 v[8];
#pragma unroll
            for (int q = 0; q < 4; ++q) { const size_t ii = i + q * stride; if (ii < n8) { v[2 * q] = x4[2 * ii]; v[2 * q + 1] = x4[2 * ii + 1]; } }
#pragma unroll
            for (int q = 0; q < 4; ++q) { const size_t ii = i + q * stride; if (ii < n8) { u32x4 o; o.x = cvt_pk_bf16(v[2 * q][0], v[2 * q][1]); o.y = cvt_pk_bf16(v[2 * q][2], v[2 * q][3]);
                o.z = cvt_pk_bf16(v[2 * q + 1][0], v[2 * q + 1][1]); o.w = cvt_pk_bf16(v[2 * q + 1][2], v[2 * q + 1][3]); xb[ii] = o; } }
        }
    }
    {
        float* tl = (float*)lds;
        const int lr = tid >> 4, lc4 = (tid & 15) * 4;
        const int on = tid >> 3, okg = (tid & 7) * 8;
        for (int jg = bid * 4; jg < TR_JOBS; jg += G * 4) {
            f32x4 v[4][2]; bf16_t* dst[4]; int ldd[4];
#pragma unroll
            for (int q = 0; q < 4; ++q) { const float* src; int ls; tr_job(a, jg + q, src, ls, dst[q], ldd[q]);
                v[q][0] = *(const f32x4*)(src + (size_t)lr * ls + lc4); v[q][1] = *(const f32x4*)(src + (size_t)(lr + 32) * ls + lc4); }
            __syncthreads();
#pragma unroll
            for (int q = 0; q < 4; ++q) { float* t0 = tl + q * 64 * 65;
#pragma unroll
                for (int e = 0; e < 4; ++e) { t0[lr * 65 + lc4 + e] = v[q][0][e]; t0[(lr + 32) * 65 + lc4 + e] = v[q][1][e]; } }
            __syncthreads();
#pragma unroll
            for (int q = 0; q < 4; ++q) { const float* t0 = tl + q * 64 * 65; float f[8];
#pragma unroll
                for (int e = 0; e < 8; ++e) f[e] = t0[(okg + e) * 65 + on];
                u32x4 o; o.x = cvt_pk_bf16(f[0], f[1]); o.y = cvt_pk_bf16(f[2], f[3]); o.z = cvt_pk_bf16(f[4], f[5]); o.w = cvt_pk_bf16(f[6], f[7]);
                *(u32x4*)(dst[q] + (size_t)on * ldd[q] + okg) = o; }
        }
        __syncthreads();
    }
    {
        f32x2* pw = (f32x2*)lds;
        f32x2* Bb = (f32x2*)(lds + 17408);
        f32x2* Cc = (f32x2*)(lds + 17408 + 16384);
        float* KT = (float*)(lds + 17408 + 32768);
        for (int job = bid; job < 2 * NG; job += G) {
            const int g = job >> 1, half = job & 1;
            __syncthreads();
            for (int i = tid; i < 2 * 17 * 64; i += 512) { const int dr = i / (17 * 64), l = (i >> 6) % 17, p = i & 63, ix = (dr * NG + g) * NP + p;
                const float lre = a.in[4][ix], lim = a.in[5][ix], dt = expf(a.in[6][dr * NG + g]);
                const float mg = expf(lre * dt * (float)l); float sn, cs; sincosf(lim * dt * (float)l, &sn, &cs); pw[i] = (f32x2){mg * cs, mg * sn}; }
            for (int i = tid; i < 2 * 64; i += 512) { const int dr = i >> 6, p = i & 63, ix = (dr * NG + g) * NP + p;
                const float lre = a.in[4][ix], lim = a.in[5][ix], dt = expf(a.in[6][dr * NG + g]);
                const float mg = expf(lre * dt), ar = mg * cosf(lim * dt), ai = mg * sinf(lim * dt), den = lre * lre + lim * lim;
                const float zr = ((ar - 1.0f) * lre + ai * lim) / den, zi = (ai * lre - (ar - 1.0f) * lim) / den;
#pragma unroll
                for (int c = 0; c < GC; ++c) { const float br = a.in[7][(size_t)ix * GC + c], bi = a.in[8][(size_t)ix * GC + c]; Bb[i * GC + c] = (f32x2){zr * br - zi * bi, zr * bi + zi * br}; } }
            for (int i = tid; i < 2 * GC * NP; i += 512) { const int dr = i >> 10, r = i & 1023; const size_t o = ((size_t)(dr * NG + g) * GC) * NP + r; Cc[i] = (f32x2){a.in[9][o], a.in[10][o]}; }
            __syncthreads();
            { const int dr = tid >> 8, l = (tid >> 4) & 15, co = tid & 15; float ac[16];
#pragma unroll
              for (int c = 0; c < 16; ++c) ac[c] = 0.f;
              for (int p = 0; p < NP; ++p) { const f32x2 cv = Cc[(dr * 16 + co) * 64 + p], wv = pw[(dr * 17 + l) * 64 + p]; const float cr = cv.x * wv.x - cv.y * wv.y, ci = cv.x * wv.y + cv.y * wv.x;
#pragma unroll
                  for (int c = 0; c < 16; ++c) { const f32x2 bv = Bb[(dr * 64 + p) * 16 + c]; ac[c] += cr * bv.x - ci * bv.y; } }
#pragma unroll
              for (int c = 0; c < 16; ++c) KT[((dr * 16 + l) * 16 + co) * 16 + c] = ac[c]; }
            __syncthreads();
            bf16_t* w2 = (bf16_t*)(ws + WS_W2T) + (size_t)g * 256 * 512;
            for (int it = tid; it < 128 * 64; it += 512) { const int rr = it >> 6, kg = it & 63, n = half * 128 + rr, j = n >> 4, co = n & 15; float f[8];
                if (kg < 32) { const int i = kg >> 1, ci0 = (kg & 1) * 8;
#pragma unroll
                    for (int e = 0; e < 8; ++e) { const int ci = ci0 + e; float v = 0.f;
                        if (i <= j) v += KT[((0 * 16 + (j - i)) * 16 + co) * 16 + ci];
                        if (i >= j) v += KT[((1 * 16 + (i - j)) * 16 + co) * 16 + ci];
                        if (i == j && ci == co) v += a.in[11][g * GC + co];
                        f[e] = v; } }
                else { const int kk = (kg - 32) * 8, dr = kk >> 7, ri = (kk >> 6) & 1, p0 = kk & 63, ex = dr == 0 ? j + 1 : 16 - j;
#pragma unroll
                    for (int e = 0; e < 8; ++e) { const f32x2 cv = Cc[(dr * 16 + co) * 64 + p0 + e], wv = pw[(dr * 17 + ex) * 64 + p0 + e];
                        f[e] = ri == 0 ? (cv.x * wv.x - cv.y * wv.y) : -(cv.x * wv.y + cv.y * wv.x); } }
                u32x4 o; o.x = cvt_pk_bf16(f[0], f[1]); o.y = cvt_pk_bf16(f[2], f[3]); o.z = cvt_pk_bf16(f[4], f[5]); o.w = cvt_pk_bf16(f[6], f[7]);
                *(u32x4*)(w2 + (size_t)n * 512 + kg * 8) = o; }
            bf16_t* w1 = (bf16_t*)(ws + WS_W1T) + (size_t)g * 256 * 256;
            for (int it = tid; it < 128 * 32; it += 512) { const int rr = it >> 5, kg = it & 31, dr = half, ri = rr >> 6, p = rr & 63, i = kg >> 1, ci0 = (kg & 1) * 8, ex = dr == 0 ? 15 - i : i;
                const f32x2 wv = pw[(dr * 17 + ex) * 64 + p]; float f[8];
#pragma unroll
                for (int e = 0; e < 8; ++e) { const f32x2 bv = Bb[(dr * 64 + p) * 16 + ci0 + e]; f[e] = ri == 0 ? (wv.x * bv.x - wv.y * bv.y) : (wv.x * bv.y + wv.y * bv.x); }
                u32x4 o; o.x = cvt_pk_bf16(f[0], f[1]); o.y = cvt_pk_bf16(f[2], f[3]); o.z = cvt_pk_bf16(f[4], f[5]); o.w = cvt_pk_bf16(f[6], f[7]);
                *(u32x4*)(w1 + (size_t)(half * 128 + rr) * 256 + kg * 8) = o; }
            if (tid < 64) ((f32x2*)(ws + WS_SSMP + SSMP_A16))[(half * NG + g) * NP + tid] = pw[(half * 17 + 16) * 64 + tid];
        }
        __syncthreads();
    }
    {
        u32x4* rwf = (u32x4*)(ws + WS_RW);
        for (int i = bid * 512 + tid; i < 8 * 8 * 3 * 64; i += G * 512) {
            const int lane_ = i & 63, f = i >> 6, nt = f % 3, ks = (f / 3) & 7, w = f / 24, n = lane_ & 15, fq = lane_ >> 4, j = nt * 16 + n;
            float wv[8];
#pragma unroll
            for (int e = 0; e < 8; ++e) { const int k = w * 256 + ks * 32 + fq * 8 + e; wv[e] = j < 4 ? a.in[17][k * 4 + j] : (j < NR ? a.in[19][k * NE + (j - 4)] : 0.f); }
            u32x4 hi; hi.x = cvt_pk_bf16(wv[0], wv[1]); hi.y = cvt_pk_bf16(wv[2], wv[3]); hi.z = cvt_pk_bf16(wv[4], wv[5]); hi.w = cvt_pk_bf16(wv[6], wv[7]);
            u32x4 lo; lo.x = cvt_pk_bf16(wv[0] - bflo(hi.x), wv[1] - bfhi(hi.x)); lo.y = cvt_pk_bf16(wv[2] - bflo(hi.y), wv[3] - bfhi(hi.y));
            lo.z = cvt_pk_bf16(wv[4] - bflo(hi.z), wv[5] - bfhi(hi.z)); lo.w = cvt_pk_bf16(wv[6] - bflo(hi.w), wv[7] - bfhi(hi.w));
            rwf[(size_t)(f * 2 + 0) * 64 + lane_] = hi; rwf[(size_t)(f * 2 + 1) * 64 + lane_] = lo;
        }
    }
}

template <int W>
__device__ __forceinline__ void pooldiff_item(const bf16_t* proj, bf16_t* dp, int t, int c8) {
    const int s = t & (S - 1);
    const bf16_t* base = proj + (size_t)t * D + c8;
    float sum[8];
#pragma unroll
    for (int e = 0; e < 8; ++e) sum[e] = 0.f;
    u32x4 self;
#pragma unroll
    for (int q = -W / 2; q < W / 2; ++q) { const bool ok = (s + q >= 0) && (s + q < S);
        u32x4 v = (u32x4){0u, 0u, 0u, 0u}; if (ok) v = *(const u32x4*)(base + (ptrdiff_t)q * D);
        if (q == 0) self = v;
#pragma unroll
        for (int e = 0; e < 4; ++e) { sum[2 * e] += bflo(v[e]); sum[2 * e + 1] += bfhi(v[e]); } }
    int lo = s - W / 2, hi = s + W / 2; lo = lo < 0 ? 0 : lo; hi = hi > S ? S : hi;
    const float inv = 1.0f / (float)(hi - lo);
    u32x4 o;
#pragma unroll
    for (int e = 0; e < 4; ++e) o[e] = cvt_pk_bf16(sum[2 * e] * inv - bflo(self[e]), sum[2 * e + 1] * inv - bfhi(self[e]));
    *(u32x4*)(dp + (size_t)t * DP + c8) = o;
}
__device__ void p2_pooldiff(const Args& a) {
    const bf16_t* proj = (const bf16_t*)(a.ws + WS_PROJ); bf16_t* dp = (bf16_t*)(a.ws + WS_DPOOL);
    const int n = T * (DP / 8);
    for (int i = blockIdx.x * 512 + threadIdx.x; i < n; i += gridDim.x * 512) {
        const int lane = i & 63, g = (i >> 6) & 3, t = (i >> 8) * 2 + (lane >> 5), c8 = (g * 32 + (lane & 31)) * 8;
        if (g == 0) pooldiff_item<2>(proj, dp, t, c8); else if (g == 1) pooldiff_item<4>(proj, dp, t, c8); else if (g == 2) pooldiff_item<8>(proj, dp, t, c8); else pooldiff_item<16>(proj, dp, t, c8);
    }
}

__device__ void p3_scan(const Args& a, unsigned char* lds) {
    const int tid = threadIdx.x, wid = tid >> 6, lane = tid & 63;
    unsigned char* ws = a.ws;
    const float* Sb = (const float*)(ws + WS_XB); bf16_t* A2 = (bf16_t*)(ws + WS_A2); const f32x2* a16 = (const f32x2*)(ws + WS_SSMP + SSMP_A16);
    f32x2* F = (f32x2*)lds;
    for (int job = blockIdx.x; job < 256; job += gridDim.x) {
        const int g = job >> 2, b = (job >> 1) & 1, dr = job & 1, p = lane;
        const f32x2 A = a16[(dr * NG + g) * NP + p];
        float pr = A.x, pi = A.y;
#pragma unroll
        for (int q = 0; q < 6; ++q) { const float nr = pr * pr - pi * pi, ni = 2.0f * pr * pi; pr = nr; pi = ni; }
        const float* sp = Sb + ((size_t)(g * 1024 + b * 512 + wid * 64)) * 256 + dr * 128 + p;
        float xr = 0.f, xi = 0.f;
#pragma unroll 8
        for (int q = 0; q < 64; ++q) { const int c = dr == 0 ? q : 63 - q; const float sr = sp[c * 256], si = sp[c * 256 + 64];
            const float nr = A.x * xr - A.y * xi + sr, ni = A.x * xi + A.y * xr + si; xr = nr; xi = ni; }
        __syncthreads();
        F[wid * 64 + p] = (f32x2){xr, xi};
        __syncthreads();
        float cr = 0.f, ci = 0.f;
        if (dr == 0) { for (int v = 0; v < wid; ++v) { const f32x2 f = F[v * 64 + p]; const float nr = pr * cr - pi * ci + f.x, ni = pr * ci + pi * cr + f.y; cr = nr; ci = ni; } }
        else { for (int v = 7; v > wid; --v) { const f32x2 f = F[v * 64 + p]; const float nr = pr * cr - pi * ci + f.x, ni = pr * ci + pi * cr + f.y; cr = nr; ci = ni; } }
        xr = cr; xi = ci;
        bf16_t* op = A2 + ((size_t)(g * 1024 + b * 512 + wid * 64)) * 512 + 256 + dr * 128 + p;
#pragma unroll 8
        for (int q = 0; q < 64; ++q) { const int c = dr == 0 ? q : 63 - q; const float sr = sp[c * 256], si = sp[c * 256 + 64];
            op[c * 512] = (bf16_t)(cvt_pk_bf16(xr, xr) & 0xffffu); op[c * 512 + 64] = (bf16_t)(cvt_pk_bf16(xi, xi) & 0xffffu);
            const float nr = A.x * xr - A.y * xi + sr, ni = A.x * xi + A.y * xr + si; xr = nr; xi = ni; }
    }
}

__device__ void p5_ln1_router(const Args& a, unsigned char* lds, int rep) {
    const int tid = threadIdx.x, wid = tid >> 6, lane = tid & 63, m = lane & 15, fq = lane >> 4;
    unsigned char* ws = a.ws;
    const bf16_t* __restrict__ v1b = (const bf16_t*)(ws + WS_V1B); const float* __restrict__ stt = (const float*)(ws + WS_ST); bf16_t* __restrict__ h1b = (bf16_t*)(ws + WS_H1B); const u32x4* __restrict__ rwf = (const u32x4*)(ws + WS_RW);
    if (rep) h1b = (bf16_t*)(ws + 345 * MB);
    const float* g1 = a.in[15]; const float* b1 = a.in[16];
    int* tok_e = (int*)(ws + WS_ROUTE + RT_E); int* tok_rank = (int*)(ws + WS_ROUTE + RT_RANK); float* tok_gate = (float*)(ws + WS_ROUTE + RT_GATE);
    float* PL = (float*)(lds + 1024);
    float* LG = (float*)(lds + 1024 + 24576);
    float* GB = (float*)(lds + 32768);
    int* EL = (int*)(lds + 512);
    unsigned char* gc = (unsigned char*)(ws + WS_GC);
    __syncthreads();
    for (int i = tid; i < D; i += 512) { GB[i] = g1[i]; GB[D + i] = b1[i]; }
    __syncthreads();
    u32x4 vn[8]; f32x4 qn[4];
    { const int grp = blockIdx.x; if (grp < T / 16) { const size_t ro = (size_t)(grp * 16 + m) * D + wid * 256 + fq * 8;
#pragma unroll
        for (int ks = 0; ks < 8; ++ks) vn[ks] = *(const u32x4*)(v1b + ro + ks * 32);
#pragma unroll
        for (int q = 0; q < 4; ++q) qn[q] = *(const f32x4*)(stt + ((size_t)(grp * 16 + m) * 32 + fq * 8) * 2 + q * 4); } }
    for (int grp = blockIdx.x; grp < T / 16; grp += gridDim.x) {
        const int t = grp * 16 + m; const size_t ro = (size_t)t * D + wid * 256 + fq * 8;
        u32x4 v[8]; f32x4 qv[4];
#pragma unroll
        for (int ks = 0; ks < 8; ++ks) v[ks] = vn[ks];
#pragma unroll
        for (int q = 0; q < 4; ++q) qv[q] = qn[q];
        float s = (qv[0][0] + qv[0][2]) + (qv[1][0] + qv[1][2]) + (qv[2][0] + qv[2][2]) + (qv[3][0] + qv[3][2]);
        float ss = (qv[0][1] + qv[0][3]) + (qv[1][1] + qv[1][3]) + (qv[2][1] + qv[2][3]) + (qv[3][1] + qv[3][3]);
        s += __shfl_xor(s, 16); s += __shfl_xor(s, 32); ss += __shfl_xor(ss, 16); ss += __shfl_xor(ss, 32);
        const float mu = s * (1.0f / D); const float rstd = rsqrtf(fmaxf(ss * (1.0f / D) - mu * mu, 0.f) + LN_EPS);
        f32x4 acc[3];
#pragma unroll
        for (int nt = 0; nt < 3; ++nt) acc[nt] = (f32x4){0.f, 0.f, 0.f, 0.f};
        u32x4 wc_[6], wn_[6];
#pragma unroll
        for (int q = 0; q < 6; ++q) wc_[q] = rwf[(size_t)((wid * 8 + 0) * 6 + q) * 64 + lane];
#pragma unroll
        for (int ks = 0; ks < 8; ++ks) {
            if (ks < 7) {
#pragma unroll
                for (int q = 0; q < 6; ++q) wn_[q] = rwf[(size_t)((wid * 8 + ks + 1) * 6 + q) * 64 + lane]; }
            const int kk = wid * 256 + ks * 32 + fq * 8;
            const f32x4 ga = *(const f32x4*)(GB + kk), gb = *(const f32x4*)(GB + kk + 4), ba = *(const f32x4*)(GB + D + kk), bb = *(const f32x4*)(GB + D + kk + 4);
            const f32x4 va = (f32x4){bflo(v[ks].x), bfhi(v[ks].x), bflo(v[ks].y), bfhi(v[ks].y)}, vb = (f32x4){bflo(v[ks].z), bfhi(v[ks].z), bflo(v[ks].w), bfhi(v[ks].w)};
            const f32x4 h0 = (va - mu) * rstd * ga + ba, h1 = (vb - mu) * rstd * gb + bb;
            u32x4 hi; hi.x = cvt_pk_bf16(h0[0], h0[1]); hi.y = cvt_pk_bf16(h0[2], h0[3]); hi.z = cvt_pk_bf16(h1[0], h1[1]); hi.w = cvt_pk_bf16(h1[2], h1[3]);
            *(u32x4*)(h1b + ro + ks * 32) = hi;
            u32x4 lo; lo.x = cvt_pk_bf16(h0[0] - bflo(hi.x), h0[1] - bfhi(hi.x)); lo.y = cvt_pk_bf16(h0[2] - bflo(hi.y), h0[3] - bfhi(hi.y));
            lo.z = cvt_pk_bf16(h1[0] - bflo(hi.z), h1[1] - bfhi(hi.z)); lo.w = cvt_pk_bf16(h1[2] - bflo(hi.w), h1[3] - bfhi(hi.w));
            const bf16x8 ahi = __builtin_bit_cast(bf16x8, hi), alo = __builtin_bit_cast(bf16x8, lo);
#pragma unroll
            for (int nt = 0; nt < 3; ++nt) {
                const bf16x8 whi = __builtin_bit_cast(bf16x8, wc_[nt * 2]), wlo = __builtin_bit_cast(bf16x8, wc_[nt * 2 + 1]);
                acc[nt] = __builtin_amdgcn_mfma_f32_16x16x32_bf16(whi, ahi, acc[nt], 0, 0, 0);
                acc[nt] = __builtin_amdgcn_mfma_f32_16x16x32_bf16(whi, alo, acc[nt], 0, 0, 0);
                acc[nt] = __builtin_amdgcn_mfma_f32_16x16x32_bf16(wlo, ahi, acc[nt], 0, 0, 0); }
#pragma unroll
            for (int q = 0; q < 6; ++q) wc_[q] = wn_[q];
        }
        { const int gn = grp + gridDim.x; if (gn < T / 16) { const size_t rn = (size_t)(gn * 16 + m) * D + wid * 256 + fq * 8;
#pragma unroll
            for (int ks = 0; ks < 8; ++ks) vn[ks] = *(const u32x4*)(v1b + rn + ks * 32);
#pragma unroll
            for (int q = 0; q < 4; ++q) qn[q] = *(const f32x4*)(stt + ((size_t)(gn * 16 + m) * 32 + fq * 8) * 2 + q * 4); } }
#pragma unroll
        for (int nt = 0; nt < 3; ++nt) *(f32x4*)(PL + (wid * 16 + m) * 48 + nt * 16 + fq * 4) = acc[nt];
        __syncthreads();
        for (int i = tid; i < 16 * 48; i += 512) { const int mm = i / 48, j = i - mm * 48; float sm = 0.f;
#pragma unroll
            for (int w = 0; w < 8; ++w) sm += PL[(w * 16 + mm) * 48 + j];
            LG[i] = sm + (j < 4 ? a.in[18][j] : (j < NR ? a.in[20][j - 4] : 0.f)); }
        __syncthreads();
        if (tid < 16 && rep == 0) {
            const float* l = LG + tid * 48;
            const float g0 = l[0], g1v = l[1], g2 = l[2], g3 = l[3];
            int gsel = 0; float gm = g0; if (g1v > gm) { gm = g1v; gsel = 1; } if (g2 > gm) { gm = g2; gsel = 2; } if (g3 > gm) { gm = g3; gsel = 3; }
            const float pg = 1.0f / (expf(g0 - gm) + expf(g1v - gm) + expf(g2 - gm) + expf(g3 - gm));
            float el[8];
#pragma unroll
            for (int i = 0; i < 8; ++i) el[i] = l[4 + gsel * 8 + i];
            int i1 = 0; float m1 = el[0];
#pragma unroll
            for (int i = 1; i < 8; ++i) if (el[i] > m1) { m1 = el[i]; i1 = i; }
            int i2 = -1; float m2 = -3.0e38f;
#pragma unroll
            for (int i = 0; i < 8; ++i) if (i != i1 && el[i] > m2) { m2 = el[i]; i2 = i; }
            const float e2 = expf(m2 - m1), inv = 1.0f / (1.0f + e2);
            const int tt = grp * 16 + tid; const int ea = gsel * 8 + i1, eb = gsel * 8 + i2;
            EL[tid * 2] = ea; EL[tid * 2 + 1] = eb;
            tok_e[tt * 2] = ea; tok_e[tt * 2 + 1] = eb; tok_gate[tt * 2] = pg * inv; tok_gate[tt * 2 + 1] = pg * e2 * inv;
        }
        __syncthreads();
        if (tid < 32 && rep == 0) { const int me = EL[tid]; int r = 0;
            for (int q = 0; q < tid; ++q) r += (EL[q] == me) ? 1 : 0;
            tok_rank[(grp * 16) * 2 + tid] = r; }
        else if (tid >= 32 && tid < 64 && rep == 0) { const int e = tid - 32; int c = 0;
#pragma unroll
            for (int q = 0; q < 32; ++q) c += (EL[q] == e) ? 1 : 0;
            gc[grp * 32 + e] = (unsigned char)c; }
    }
    __syncthreads();
}

__device__ __forceinline__ void moe_build_tab(const Args& a, int* tstart) {
    if (threadIdx.x == 0) { const unsigned* cnt = (const unsigned*)(a.ws + WS_CTL); int acc = 0;
        for (int e = 0; e < NE; ++e) { tstart[e] = acc; acc += ((int)__hip_atomic_load(cnt + e, __ATOMIC_RELAXED, __HIP_MEMORY_SCOPE_AGENT) + 255) >> 8; }
        tstart[NE] = acc; }
    __syncthreads();
}

__device__ void p6_slots(const Args& a, unsigned char* lds, int* tstart) {
    const int tid = threadIdx.x;
    unsigned char* ws = a.ws;
    const int* tok_e = (const int*)(ws + WS_ROUTE + RT_E); const int* tok_rank = (const int*)(ws + WS_ROUTE + RT_RANK); const float* tok_gate = (const float*)(ws + WS_ROUTE + RT_GATE);
    int* slot_tok = (int*)(ws + WS_ROUTE + RT_STOK); float* slot_gate = (float*)(ws + WS_ROUTE + RT_SGATE); int* tok_slot = (int*)(ws + WS_ROUTE + RT_SGATE + (size_t)MAXTILES * 256 * 4);
    unsigned char* GC = lds;
    unsigned short* BASE = (unsigned short*)(lds + 32768);
    int* CS = (int*)(lds + 98304);
    int* CNT = (int*)(lds + 98304 + 2048);
    __syncthreads();
    { const u32x4* src = (const u32x4*)(ws + WS_GC); u32x4* dst = (u32x4*)GC;
#pragma unroll
      for (int q = 0; q < 4; ++q) dst[tid + q * 512] = src[tid + q * 512]; }
    __syncthreads();
    const int e = tid & 31, c = tid >> 5;
    { int sm = 0; for (int g = c * 64; g < c * 64 + 64; ++g) sm += GC[g * 32 + e]; CS[e * 16 + c] = sm; }
    __syncthreads();
    if (tid < 32) { int run = 0; for (int q = 0; q < 16; ++q) { const int tmp = CS[tid * 16 + q]; CS[tid * 16 + q] = run; run += tmp; } CNT[tid] = run; }
    __syncthreads();
    if (tid == 0) { int acc = 0; for (int q = 0; q < NE; ++q) { tstart[q] = acc; acc += (CNT[q] + 255) >> 8; } tstart[NE] = acc; }
    if (blockIdx.x == 0 && tid < 32) ((unsigned*)(ws + WS_CTL))[tid] = (unsigned)CNT[tid];
    { int run = CS[e * 16 + c]; for (int g = c * 64; g < c * 64 + 64; ++g) { BASE[g * 32 + e] = (unsigned short)run; run += GC[g * 32 + e]; } }
    __syncthreads();
    for (int i = blockIdx.x * 512 + tid; i < T * 2; i += gridDim.x * 512) {
        const int ee = tok_e[i], s = tstart[ee] * 256 + (int)BASE[(i >> 5) * 32 + ee] + tok_rank[i]; slot_tok[s] = i >> 1; slot_gate[s] = tok_gate[i]; tok_slot[i] = s; }
    const int ns = tstart[NE] * 256;
    for (int s = blockIdx.x * 512 + tid; s < ns; s += gridDim.x * 512) {
        const int ee = moe_expert_of_tile(tstart, s >> 8); const int r = s - tstart[ee] * 256;
        if (r >= CNT[ee]) { slot_tok[s] = -1; slot_gate[s] = 0.f; } }
    __syncthreads();
}

__device__ void p9_ln2(const Args& a, const int* tstart, int rep) {
    const int tid = threadIdx.x, wid = tid >> 6, lane = tid & 63;
    const float* g2 = a.in[24]; const float* b2 = a.in[25];
    const bf16_t* ys = (const bf16_t*)(a.ws + WS_YS); const bf16_t* h1b = (const bf16_t*)(a.ws + WS_H1B);
    const int* tok_slot = (const int*)(a.ws + WS_ROUTE + RT_SGATE + (size_t)MAXTILES * 256 * 4);
    const int nw = gridDim.x * 8;
    for (int t = blockIdx.x * 8 + wid; t < T; t += nw) {
        float* roww = rep == 0 ? a.out + (size_t)t * D : (float*)(a.ws + 25 * MB) + (size_t)(t & 8191) * D;
        const size_t sa = (size_t)tok_slot[t * 2] * D, sb = (size_t)tok_slot[t * 2 + 1] * D;
        f32x4 h[8]; float s = 0.f;
#pragma unroll
        for (int i = 0; i < 8; ++i) { const u32x2 hv = *(const u32x2*)(h1b + (size_t)t * D + i * 256 + lane * 4);
            const u32x2 ya = *(const u32x2*)(ys + sa + i * 256 + lane * 4), yb = *(const u32x2*)(ys + sb + i * 256 + lane * 4);
            h[i][0] = ALPHA * bflo(hv.x) + (bflo(ya.x) + bflo(yb.x)); h[i][1] = ALPHA * bfhi(hv.x) + (bfhi(ya.x) + bfhi(yb.x));
            h[i][2] = ALPHA * bflo(hv.y) + (bflo(ya.y) + bflo(yb.y)); h[i][3] = ALPHA * bfhi(hv.y) + (bfhi(ya.y) + bfhi(yb.y));
            s += (h[i][0] + h[i][1]) + (h[i][2] + h[i][3]); }
        const float mu = wave_sum(s) * (1.0f / D); float vq = 0.f;
#pragma unroll
        for (int i = 0; i < 8; ++i) { const f32x4 d = h[i] - mu; vq += (d[0] * d[0] + d[1] * d[1]) + (d[2] * d[2] + d[3] * d[3]); }
        const float rstd = rsqrtf(wave_sum(vq) * (1.0f / D) + LN_EPS);
#pragma unroll
        for (int i = 0; i < 8; ++i) { const f32x4 gv = *(const f32x4*)(g2 + i * 256 + lane * 4), bv = *(const f32x4*)(b2 + i * 256 + lane * 4);
            *(f32x4*)(roww + i * 256 + lane * 4) = (h[i] - mu) * rstd * gv + bv; }
    }
}

constexpr int NPHASE = 12;
__global__ void __launch_bounds__(512, 2) fwd(Args a) {
    extern __shared__ __attribute__((aligned(16))) unsigned char lds[];
    cg::grid_group grid = cg::this_grid();
    unsigned char* ws = a.ws;
    int* tstart = (int*)(lds + MISC_OFF);
    volatile LAS unsigned* bst = (volatile LAS unsigned*)((LAS unsigned char*)lds + MISC_OFF + 256);
    if (threadIdx.x < 4) bst[threadIdx.x] = 0u;
    __syncthreads();
    XcdBarrier xbar = xcd_barrier_post((unsigned*)(ws + WS_BAR), bst);
    if (a.ph_hi > 1000) grid.sync();
#define IN(k) (a.ph_lo <= (k) && (k) < a.ph_hi)
    volatile unsigned long long* tsv = (volatile unsigned long long*)(lds + MISC_OFF + 512);
#define TS_START(k) do { if ((k) == PROBE_TS_A && blockIdx.x == 0 && threadIdx.x == 0) tsv[0] = __builtin_amdgcn_s_memrealtime(); } while (0)
#define TS_END(k) do { if ((k) == PROBE_TS_B && blockIdx.x == 0 && threadIdx.x == 0) tsv[1] = __builtin_amdgcn_s_memrealtime(); } while (0)
#define SEAM(k) do { if (IN(k) && IN((k) + 1)) xcd_barrier(xbar); } while (0)
    for (int q = 0; q < PROBE_SYNC; ++q) xcd_barrier(xbar);
    TS_START(0);
    if (IN(0)) for (int rep = 0; rep < (0 == PROBE_PHASE ? PROBE_REP : 1); ++rep) p0_prepass(a, lds);
    SEAM(0); TS_END(0);
    TS_START(1);
    if (IN(1)) { DescProj d{(const char*)(ws + WS_XB), (const char*)(ws + WS_WIN), (bf16_t*)(ws + WS_PROJ), (bf16_t*)(ws + WS_A2), D, D}; gemm_run<0>(lds, d); }
    SEAM(1); TS_END(1);
    TS_START(2);
    if (IN(2)) { for (int rep = 0; rep < (2 == PROBE_PHASE ? PROBE_REP : 1); ++rep) p2_pooldiff(a);
        DescS1 d{(const char*)(ws + WS_A2), (const char*)(ws + WS_W1T), (float*)(ws + WS_XB), 256, 256}; gemm_run<6>(lds, d); }
    SEAM(2); TS_END(2);
    TS_START(3);
    if (IN(3)) for (int rep = 0; rep < (3 == PROBE_PHASE ? PROBE_REP : 1); ++rep) p3_scan(a, lds);
    SEAM(3); TS_END(3);
    TS_START(4);
    if (IN(4)) {
        { DescS2 d{(const char*)(ws + WS_A2), (const char*)(ws + WS_W2T), (bf16_t*)(ws + WS_YSSM), 512, 512}; gemm_run<7>(lds, d); }
        { DescPool d{(const char*)(ws + WS_DPOOL), (const char*)(ws + WS_POOLW), (bf16_t*)(ws + WS_XB), a.in[3], 256, 256}; gemm_run<1>(lds, d); }
    }
    SEAM(4); TS_END(4);
    TS_START(5);
    if (IN(5)) { DescGlu d{(const char*)(ws + WS_YSSM), (const char*)(ws + WS_GLU), (bf16_t*)(ws + WS_XB), a.in[13], DS, DS}; gemm_run<2>(lds, d); }
    SEAM(5); TS_END(5);
    TS_START(6);
    if (IN(6)) { DescOut d{(const char*)(ws + WS_XB), (const char*)(ws + WS_WOUT), (bf16_t*)(ws + WS_V1B), a.in[0], (float*)(ws + WS_ST), D, D}; gemm_run<3>(lds, d); }
    SEAM(6); TS_END(6);
    TS_START(7);
    if (IN(7)) for (int rep = 0; rep < (7 == PROBE_PHASE ? PROBE_REP : 1); ++rep) p5_ln1_router(a, lds, rep);
    SEAM(7); TS_END(7);
    TS_START(8);
    if (IN(8)) { for (int rep = 0; rep < (8 == PROBE_PHASE ? PROBE_REP : 1); ++rep) p6_slots(a, lds, tstart); }
    SEAM(8); TS_END(8);
    TS_START(9);
    if (IN(9)) { moe_build_tab(a, tstart);
        DescGU d{(const char*)(ws + WS_H1B), (const char*)(ws + WS_WGU), (bf16_t*)(ws + WS_HH), (const int*)(ws + WS_ROUTE + RT_STOK), tstart, D, D}; gemm_run<4>(lds, d); }
    SEAM(9); TS_END(9);
    TS_START(10);
    if (IN(10)) { moe_build_tab(a, tstart);
        DescDown d{(const char*)(ws + WS_HH), (const char*)(ws + WS_WD), (bf16_t*)(ws + WS_YS), (const float*)(ws + WS_ROUTE + RT_SGATE), tstart, DE, DE}; gemm_run<5>(lds, d); }
    SEAM(10); TS_END(10);
    TS_START(11);
    if (IN(11)) { moe_build_tab(a, tstart); for (int rep = 0; rep < (11 == PROBE_PHASE ? PROBE_REP : 1); ++rep) p9_ln2(a, tstart, rep); }
    TS_END(11);
    if (PROBE_TS_A >= 0 && blockIdx.x == 0 && threadIdx.x == 0) { const unsigned long long dt = tsv[1] - tsv[0], te = __builtin_amdgcn_s_memrealtime(); while (__builtin_amdgcn_s_memrealtime() - te < 4ull * dt) __builtin_amdgcn_s_sleep(32); }
#undef IN
#undef SEAM
}

extern "C" void kernel_launch(void* const* d_in, const int* in_sizes, int n_in, void* d_out, int out_size, void* d_ws, size_t ws_size, hipStream_t stream) {
    static int grid = 0;
    if (grid == 0) {
        if (n_in != 26 || out_size != T * D || ws_size < WS_END) { fprintf(stderr, "kernel_launch: unexpected shapes (n_in %d out %d ws %zu)\n", n_in, out_size, ws_size); grid = -1; return; }
        int dev = 0, cus = 0, per_cu = 0;
        (void)hipGetDevice(&dev); (void)hipDeviceGetAttribute(&cus, hipDeviceAttributeMultiprocessorCount, dev);
        (void)hipFuncSetAttribute((const void*)fwd, hipFuncAttributeMaxDynamicSharedMemorySize, LDS_BYTES);
        (void)hipOccupancyMaxActiveBlocksPerMultiprocessor(&per_cu, (const void*)fwd, 512, LDS_BYTES);
        if (per_cu < 1) { fprintf(stderr, "kernel_launch: occupancy query says %d blocks/CU\n", per_cu); per_cu = 1; }
        grid = cus;
    }
    if (grid < 0) return;
    (void)hipMemsetAsync((char*)d_ws + WS_CTL, 0, CTL_ZERO_BYTES, stream);
    Args a{};
    for (int i = 0; i < 26; ++i) a.in[i] = (const float*)d_in[i];
    a.out = (float*)d_out; a.ws = (unsigned char*)d_ws;
#if N_LAUNCH_MODE == 0
    a.ph_lo = 0; a.ph_hi = NPHASE;
    void* args[] = {&a};
    hipError_t e = hipLaunchCooperativeKernel((const void*)fwd, dim3(grid), dim3(512), args, LDS_BYTES, stream);
    if (e != hipSuccess) fprintf(stderr, "cooperative launch failed: %s (grid %d)\n", hipGetErrorString(e), grid);
#else
    for (int p = 0; p < NPHASE; ++p) { a.ph_lo = p; a.ph_hi = p + 1; hipLaunchKernelGGL(fwd, dim3(grid), dim3(512), LDS_BYTES, stream, a); }
#endif
}
```

```cpp
#include <hip/hip_runtime.h>
#include <hip/hip_cooperative_groups.h>
#include <cstdio>
namespace cg = cooperative_groups;

#ifndef N_LAUNCH_MODE
#define N_LAUNCH_MODE 0
#endif
#ifndef PROBE_PHASE
#define PROBE_PHASE -1
#endif
#ifndef PROBE_REP
#define PROBE_REP 1
#endif
#ifndef PROBE_SYNC
#define PROBE_SYNC 0
#endif
#ifndef PROBE_TS_A
#define PROBE_TS_A -1
#endif
#ifndef PROBE_TS_B
#define PROBE_TS_B -1
#endif
#ifndef PROBE_NOSTORE
#define PROBE_NOSTORE 0
#endif
#ifndef PROBE_P0PART
#define PROBE_P0PART 0
#endif
#ifndef PROBE_GEMM
#define PROBE_GEMM -1
#endif
#ifndef NAIVE_MASK
#define NAIVE_MASK 0x00
#endif

typedef unsigned short bf16_t;
typedef short bf16x8 __attribute__((ext_vector_type(8)));
typedef float f32x4 __attribute__((ext_vector_type(4)));
typedef float f32x2 __attribute__((ext_vector_type(2)));
typedef unsigned u32x4 __attribute__((ext_vector_type(4)));
typedef unsigned u32x2 __attribute__((ext_vector_type(2)));

constexpr int T = 16384, D = 2048, S = 8192, NB = 2;
constexpr int DP = 1024, DS = 1024, NG = 64, GC = 16, NP = 64;
constexpr int NE = 32, DE = 512, NR = 36;
constexpr int MAXTILES = 161;
constexpr float LN_EPS = 1e-5f;
constexpr float ALPHA = 1.189207115002721f;

constexpr size_t MB = 1u << 20;
constexpr size_t WS_CTL = 0;
constexpr size_t WS_BAR = 65536;
constexpr size_t CTL_ZERO_BYTES = 131072;
constexpr size_t WS_YS = 281 * MB;
constexpr size_t WS_H1B = 217 * MB;
constexpr size_t WS_V1B = 281 * MB;
constexpr size_t WS_ST = 484 * MB;
constexpr size_t WS_HH = 442 * MB;
constexpr size_t WS_SSMP = 1 * MB;
constexpr size_t WS_RW = 3 * MB;
constexpr size_t WS_ROUTE = 4 * MB;
constexpr size_t WS_WIN = 6 * MB;
constexpr size_t WS_WOUT = 14 * MB;
constexpr size_t WS_GLU = 22 * MB;
constexpr size_t WS_POOLW = 24 * MB;
constexpr size_t WS_WGU = 25 * MB;
constexpr size_t WS_WD = 153 * MB;
constexpr size_t WS_XB = 217 * MB;
constexpr size_t WS_PROJ = 281 * MB;
constexpr size_t WS_DPOOL = 409 * MB;
constexpr size_t WS_YSSM = 441 * MB;
constexpr size_t WS_A2 = 345 * MB;
constexpr size_t WS_W1T = 484 * MB;
constexpr size_t WS_W2T = 492 * MB;
constexpr size_t WS_END = 508 * MB;
constexpr size_t SSMP_A16 = 1536 * 1024;

constexpr size_t WS_GC = 5 * MB + 512 * 1024;
constexpr size_t RT_E = 0, RT_RANK = (size_t)T * 2 * 4, RT_GATE = (size_t)T * 4 * 4, RT_STOK = (size_t)T * 6 * 4, RT_SGATE = RT_STOK + (size_t)MAXTILES * 256 * 4;

constexpr int LDS_BYTES = 128 * 1024 + 4096;
constexpr int MISC_OFF = 128 * 1024;

struct Args { const float* in[26]; float* out; unsigned char* ws; int ph_lo, ph_hi; };

__device__ __forceinline__ float bf2f(bf16_t b) { return __uint_as_float(((unsigned)b) << 16); }
__device__ __forceinline__ float bflo(unsigned w) { return __uint_as_float(w << 16); }
__device__ __forceinline__ float bfhi(unsigned w) { return __uint_as_float(w & 0xffff0000u); }
__device__ __forceinline__ unsigned cvt_pk_bf16(float lo, float hi) { unsigned r; asm("v_cvt_pk_bf16_f32 %0, %1, %2" : "=v"(r) : "v"(lo), "v"(hi)); return r; }
__device__ __forceinline__ float wave_sum(float v) {
#pragma unroll
    for (int o = 32; o >= 1; o >>= 1) v += __shfl_xor(v, o);
    return v;
}
__device__ __forceinline__ float gelu_tanh(float x) {
    const float u = 0.7978845608028654f * (x + 0.044715f * x * x * x);
    const float e = __expf(-2.0f * fabsf(u));
    float t = (1.0f - e) / (1.0f + e); t = u < 0.f ? -t : t;
    return 0.5f * x * (1.0f + t);
}
__device__ __forceinline__ float sigmoidf_(float z) { return 1.0f / (1.0f + __expf(-z)); }

#define LAS __attribute__((address_space(3)))
#define XB_TMO      128
#define XB_XCNT(j)  (256  + 64 * (j))
#define XB_XSUB(j)  (1280 + 64 * (j))
#define XB_XGEN(j)  (2304 + 64 * (j))
#define XB_TOP      3328
#define XB_TOPGEN   3392
#define XCD_BAR_WORDS 3456
#define XB_SPIN_CAP (1u << 18)
__device__ __forceinline__ unsigned xb_ld(unsigned* p)              { return __hip_atomic_load(p, __ATOMIC_RELAXED, __HIP_MEMORY_SCOPE_AGENT); }
__device__ __forceinline__ unsigned xb_add(unsigned* p, unsigned v) { return __hip_atomic_fetch_add(p, v, __ATOMIC_RELAXED, __HIP_MEMORY_SCOPE_AGENT); }
__device__ __forceinline__ unsigned xb_xcc_id() { return (unsigned)__builtin_amdgcn_s_getreg((3 << 11) | 20) & 0xFu; }
#define XB_SPIN(cond, bar) do { unsigned _sp = 0; while (cond) { __builtin_amdgcn_s_sleep(1); \
    if ((++_sp & 255u) == 0u) { if (xb_ld(&(bar)[XB_TMO])) break; if (_sp > XB_SPIN_CAP) { atomicAdd(&(bar)[XB_TMO], 1u); break; } } } } while (0)
struct XcdBarrier { unsigned* bar; unsigned x; volatile LAS unsigned* st; };
__device__ __forceinline__ XcdBarrier xcd_barrier_post(unsigned* bar, volatile LAS unsigned* st) {
    XcdBarrier b; b.bar = bar; b.x = xb_xcc_id(); b.st = st;
    if (threadIdx.x == 0) (void)xb_add(&bar[XB_XCNT(b.x)], 1u);
    return b;
}
__device__ __forceinline__ void xcd_barrier_complete(unsigned* bar, unsigned x, unsigned& nloc, unsigned& nx) {
    const unsigned G = gridDim.x * gridDim.y * gridDim.z;
    unsigned sum, cnt, mine, sp = 0u;
    for (;;) {
        sum = 0u; cnt = 0u; mine = 0u;
#pragma unroll
        for (unsigned j = 0; j < 16; ++j) { const unsigned c = xb_ld(&bar[XB_XCNT(j)]); sum += c; cnt += (c > 0u) ? 1u : 0u; mine = (j == x) ? c : mine; }
        if (sum == G) break;
        __builtin_amdgcn_s_sleep(1);
        if ((++sp & 255u) == 0u) { if (xb_ld(&bar[XB_TMO])) break; if (sp > XB_SPIN_CAP) { atomicAdd(&bar[XB_TMO], 1u); break; } }
    }
    nloc = mine > 0u ? mine : 1u; nx = cnt > 0u ? cnt : 1u;
}
__device__ __forceinline__ void xcd_barrier(const XcdBarrier& b) {
    asm volatile("s_waitcnt vmcnt(0)" ::: "memory");
    __syncthreads();
    if (threadIdx.x == 0) {
        unsigned* bar = b.bar;
        __builtin_amdgcn_s_waitcnt(0);
        unsigned nloc = b.st[0], nx = b.st[1];
        if (nloc == 0u) { xcd_barrier_complete(bar, b.x, nloc, nx); b.st[0] = nloc; b.st[1] = nx; }
        const unsigned old = xb_add(&bar[XB_XSUB(b.x)], 1u);
        const unsigned gen = old / nloc;
        if (old + 1u == (gen + 1u) * nloc) {
            __builtin_amdgcn_fence(__ATOMIC_RELEASE, "agent");
            asm volatile("s_waitcnt vmcnt(0)" ::: "memory");
            const unsigned og = xb_add(&bar[XB_TOP], 1u);
            const unsigned tg = og / nx;
            if (og + 1u == (tg + 1u) * nx) xb_add(&bar[XB_TOPGEN], 1u);
            else XB_SPIN(xb_ld(&bar[XB_TOPGEN]) == tg, bar);
            __builtin_amdgcn_fence(__ATOMIC_ACQUIRE, "agent");
            xb_add(&bar[XB_XGEN(b.x)], 1u);
            asm volatile("s_waitcnt vmcnt(0)" ::: "memory");
        } else {
            XB_SPIN(xb_ld(&bar[XB_XGEN(b.x)]) == gen, bar);
            __builtin_amdgcn_fence(__ATOMIC_ACQUIRE, "agent");
            asm volatile("s_waitcnt vmcnt(0)" ::: "memory");
        }
    }
    __syncthreads();
}

struct Unit { int r0, c0, e, pad; };

template <class DS_>
__device__ void gemm_naive(const DS_& d) {
    const int tid = threadIdx.x, wid = tid >> 6, lane = tid & 63, wr = wid >> 2, wc = wid & 3, fr = lane & 15, fq = lane >> 4;
    const int K = d.K; const size_t ldb2 = (size_t)d.ldb * 2;
    for (int ui = blockIdx.x;; ui += gridDim.x) {
        Unit u; if (!d.get(ui, u)) break;
        f32x4 acc[2][2][4][2];
        const char* Bp = d.b_ptr(u);
#pragma unroll
        for (int ai = 0; ai < 2; ++ai)
#pragma unroll
            for (int m = 0; m < 4; ++m) {
                const int r = 128 * ai + 64 * wr + 16 * m + fr;
                const char* ap = d.A + d.a_off(u, r);
#pragma unroll
                for (int bj = 0; bj < 2; ++bj)
#pragma unroll
                    for (int n = 0; n < 2; ++n) {
                        const int c = 128 * bj + 32 * wc + 8 * fq + 4 * n;
                        const char* bp = Bp + (size_t)c * ldb2;
                        float s0 = 0.f, s1 = 0.f, s2 = 0.f, s3 = 0.f;
                        for (int k = 0; k < K; k += 8) {
                            const u32x4 av = *(const u32x4*)(ap + k * 2);
                            const u32x4 b0 = *(const u32x4*)(bp + k * 2), b1 = *(const u32x4*)(bp + ldb2 + k * 2), b2 = *(const u32x4*)(bp + 2 * ldb2 + k * 2), b3 = *(const u32x4*)(bp + 3 * ldb2 + k * 2);
#pragma unroll
                            for (int j = 0; j < 4; ++j) {
                                const float al = bflo(av[j]), ah = bfhi(av[j]);
                                s0 += al * bflo(b0[j]); s0 += ah * bfhi(b0[j]);
                                s1 += al * bflo(b1[j]); s1 += ah * bfhi(b1[j]);
                                s2 += al * bflo(b2[j]); s2 += ah * bfhi(b2[j]);
                                s3 += al * bflo(b3[j]); s3 += ah * bfhi(b3[j]);
                            }
                        }
                        acc[ai][bj][m][n] = (f32x4){s0, s1, s2, s3};
                    }
            }
        d.epi(acc, u, wr, wc, fr, fq);
    }
}

constexpr int BK = 64, HALF = 128, HTB = HALF * BK * 2;
__device__ __forceinline__ int lds_byte(int r, int c) { const int st = (r >> 4) * 2 + (c >> 5), rr = r & 15, cc = c & 31, ob = rr * 64 + cc * 2; return st * 1024 + (ob ^ (((ob >> 9) & 1) << 5)); }
__device__ __forceinline__ int perm32(int rho) { const int n = rho >> 4, i = rho & 15; return 8 * (i >> 2) + 4 * n + (i & 3); }
__device__ __forceinline__ void stage_rc(int b, int& R, int& C) { const int st = b / 1024, sb = b % 1024, swz = sb ^ (((sb >> 9) & 1) << 5); R = (st >> 1) * 16 + swz / 64; C = (st & 1) * 32 + (swz % 64) / 2; }

template <class DS_>
__device__ __forceinline__ void gemm_fast(LAS unsigned char* lds, const DS_& d) {
    const int tid = threadIdx.x, wid = __builtin_amdgcn_readfirstlane(tid >> 6), lane = tid & 63, wr = wid >> 2, wc = wid & 3, fr = lane & 15, fq = lane >> 4;
    const int K = d.K, nt = K / BK;
    int Rr[2], Cc[2]; unsigned voffB[2];
#pragma unroll
    for (int i = 0; i < 2; ++i) { stage_rc(tid * 16 + i * 8192, Rr[i], Cc[i]); const int Rb = (Rr[i] & ~31) + perm32(Rr[i] & 31); voffB[i] = (unsigned)(Rb * d.ldb + Cc[i]) * 2u; }
    const size_t kstep = (size_t)(BK * 2);
    const size_t hstepB = (size_t)HALF * d.ldb * 2;
    const unsigned ldsw = (unsigned)wid * 1024u;
    const int aoff = lds_byte(wr * 64 + fr, fq * 8), boff = lds_byte(wc * 32 + fr, fq * 8);
#define G_SA(b, h) (((b) * 2 + (h)) * HTB)
#define G_SB(b, h) ((4 + (b) * 2 + (h)) * HTB)
#define G_STAGE(bufoff, gbase, voff) do { _Pragma("unroll") for (int _i = 0; _i < 2; ++_i) \
        __builtin_amdgcn_global_load_lds((const unsigned*)((const char*)(gbase) + (voff)[_i]), (LAS unsigned*)(lds + (bufoff) + ldsw + _i * 8192), 16, 0, 0); } while (0)
#define G_LDA(dst, b, h) do { _Pragma("unroll") for (int m = 0; m < 4; ++m) _Pragma("unroll") for (int k = 0; k < 2; ++k) dst[m][k] = *(const LAS bf16x8*)(lds + G_SA(b, h) + aoff + m * 2048 + k * 1024); } while (0)
#define G_LDB(dst, b, h) do { _Pragma("unroll") for (int n = 0; n < 2; ++n) _Pragma("unroll") for (int k = 0; k < 2; ++k) dst[n][k] = *(const LAS bf16x8*)(lds + G_SB(b, h) + boff + n * 2048 + k * 1024); } while (0)
#define G_MMA(ai, bj, At, Bt) do { __builtin_amdgcn_s_setprio(1); _Pragma("unroll") for (int m = 0; m < 4; ++m) _Pragma("unroll") for (int n = 0; n < 2; ++n) _Pragma("unroll") for (int k = 0; k < 2; ++k) \
        acc[ai][bj][m][n] = __builtin_amdgcn_mfma_f32_16x16x32_bf16(Bt[n][k], At[m][k], acc[ai][bj][m][n], 0, 0, 0); __builtin_amdgcn_s_setprio(0); } while (0)
#define G_WAIT_V(n) asm volatile("s_waitcnt vmcnt(" #n ")" ::: "memory")
#define G_WAIT_L(n) asm volatile("s_waitcnt lgkmcnt(" #n ")" ::: "memory")
#define G_BAR __builtin_amdgcn_s_barrier()
#define G_SCHED __builtin_amdgcn_sched_barrier(0)
    Unit cur, nxt; int ui = blockIdx.x;
    if (!d.get(ui, cur)) return;
    f32x4 acc[2][2][4][2];
#pragma unroll
    for (int a_ = 0; a_ < 2; ++a_)
#pragma unroll
        for (int b_ = 0; b_ < 2; ++b_)
#pragma unroll
            for (int m = 0; m < 4; ++m)
#pragma unroll
                for (int n = 0; n < 2; ++n) acc[a_][b_][m][n] = (f32x4){0.f, 0.f, 0.f, 0.f};
    bf16x8 At[4][2], B0[2][2], B1[2][2];
    unsigned vA[2][2], nvA[2][2];
#pragma unroll
    for (int h = 0; h < 2; ++h)
#pragma unroll
        for (int i = 0; i < 2; ++i) vA[h][i] = d.a_off(cur, h * HALF + Rr[i]) + (unsigned)Cc[i] * 2u;
    const char* const Ab = d.A;
    const char* cB = d.b_ptr(cur);
    G_STAGE(G_SB(0, 0), cB, voffB); G_STAGE(G_SA(0, 0), Ab, vA[0]); G_STAGE(G_SB(0, 1), cB + hstepB, voffB); G_STAGE(G_SA(0, 1), Ab, vA[1]);
    if (wr == 1) G_BAR;
    G_WAIT_V(4); G_BAR;
    G_STAGE(G_SB(1, 0), cB + kstep, voffB); G_STAGE(G_SA(1, 0), Ab + kstep, vA[0]); G_STAGE(G_SB(1, 1), cB + hstepB + kstep, voffB);
    G_WAIT_V(6); G_BAR;
    for (;;) {
        const bool has_next = d.get(ui + (int)gridDim.x, nxt);
        const char* nB = has_next ? d.b_ptr(nxt) : cB;
#pragma unroll
        for (int h = 0; h < 2; ++h)
#pragma unroll
            for (int i = 0; i < 2; ++i) nvA[h][i] = has_next ? (d.a_off(nxt, h * HALF + Rr[i]) + (unsigned)Cc[i] * 2u) : vA[h][i];
        for (int t = 0; t < nt; t += 2) {
            const bool last = (t == nt - 2);
            const char* a1 = Ab + (size_t)(t + 1) * kstep;
            const char* a2 = last ? Ab : Ab + (size_t)(t + 2) * kstep; const char* b2 = last ? nB : cB + (size_t)(t + 2) * kstep;
            const char* a3 = a2 + kstep; const char* b3 = b2 + kstep;
            unsigned va2[2][2];
#pragma unroll
            for (int h = 0; h < 2; ++h)
#pragma unroll
                for (int i = 0; i < 2; ++i) va2[h][i] = last ? nvA[h][i] : vA[h][i];
            G_LDB(B0, 0, 0); G_SCHED; G_LDA(At, 0, 0); G_STAGE(G_SA(1, 1), a1, vA[1]);
            G_WAIT_L(8); G_BAR; G_WAIT_L(0); G_MMA(0, 0, At, B0); G_BAR; G_SCHED;
            G_LDB(B1, 0, 1); G_STAGE(G_SB(0, 0), b2, voffB);
            G_BAR; G_WAIT_L(0); G_MMA(0, 1, At, B1); G_BAR;
            G_LDA(At, 0, 1); G_STAGE(G_SA(0, 0), a2, va2[0]);
            G_BAR; G_WAIT_L(0); G_MMA(1, 0, At, B0); G_BAR; G_SCHED;
            G_STAGE(G_SB(0, 1), b2 + hstepB, voffB);
            G_WAIT_V(6); G_BAR; G_MMA(1, 1, At, B1); G_BAR;
            G_LDB(B0, 1, 0); G_SCHED; G_LDA(At, 1, 0); G_STAGE(G_SA(0, 1), a2, va2[1]);
            G_WAIT_L(8); G_BAR; G_WAIT_L(0); G_MMA(0, 0, At, B0); G_BAR; G_SCHED;
            G_LDB(B1, 1, 1); G_STAGE(G_SB(1, 0), b3, voffB);
            G_BAR; G_WAIT_L(0); G_MMA(0, 1, At, B1); G_BAR;
            G_LDA(At, 1, 1); G_STAGE(G_SA(1, 0), a3, va2[0]);
            G_BAR; G_WAIT_L(0); G_MMA(1, 0, At, B0); G_BAR; G_SCHED;
            G_STAGE(G_SB(1, 1), b3 + hstepB, voffB);
            G_WAIT_V(6); G_BAR; G_MMA(1, 1, At, B1); G_BAR;
        }
        d.epi(acc, cur, wr, wc, fr, fq);
        if (!has_next) break;
#pragma unroll
        for (int a_ = 0; a_ < 2; ++a_)
#pragma unroll
            for (int b_ = 0; b_ < 2; ++b_)
#pragma unroll
                for (int m = 0; m < 4; ++m)
#pragma unroll
                    for (int n = 0; n < 2; ++n) acc[a_][b_][m][n] = (f32x4){0.f, 0.f, 0.f, 0.f};
        cur = nxt; cB = nB; ui += (int)gridDim.x;
#pragma unroll
        for (int h = 0; h < 2; ++h)
#pragma unroll
            for (int i = 0; i < 2; ++i) vA[h][i] = nvA[h][i];
    }
    G_WAIT_V(0);
    if (wr == 0) G_BAR;
    G_BAR;
#undef G_SA
#undef G_SB
#undef G_STAGE
#undef G_LDA
#undef G_LDB
#undef G_MMA
#undef G_WAIT_V
#undef G_WAIT_L
#undef G_BAR
#undef G_SCHED
}
template <int BIT, class DS_>
__device__ __forceinline__ void gemm_run(unsigned char* lds, const DS_& d) {
    if constexpr ((NAIVE_MASK >> BIT) & 1) gemm_naive(d); else gemm_fast((LAS unsigned char*)lds, d);
}

__device__ __forceinline__ bool static_order(int L, int nM, int nN, int& pm, int& pn) {
    const int nwg = nM * nN; if (L >= nwg) return false;
    int wgid = L; { const int q = nwg / 8, r = nwg % 8, xcd = wgid % 8, off = wgid / 8; wgid = (xcd < r ? xcd * (q + 1) : r * (q + 1) + (xcd - r) * q) + off; }
    const int nig = 8 * nN, gid = wgid / nig, fm = gid * 8, gsz = (nM - fm) < 8 ? (nM - fm) : 8;
    pm = fm + ((wgid % nig) % gsz); pn = (wgid % nig) / gsz; return true;
}

#define EPI_LOOP_BEGIN _Pragma("unroll") for (int ai = 0; ai < 2; ++ai) _Pragma("unroll") for (int m = 0; m < 4; ++m) { const int lr = 128 * ai + 64 * wr + 16 * m + fr; \
    _Pragma("unroll") for (int bj = 0; bj < 2; ++bj) { const int lc = 128 * bj + 32 * wc + 8 * fq; const f32x4 v0 = acc[ai][bj][m][0], v1 = acc[ai][bj][m][1];
#define EPI_LOOP_END } }
__device__ __forceinline__ u32x4 pack8(const f32x4 a, const f32x4 b) { u32x4 w; w.x = cvt_pk_bf16(a[0], a[1]); w.y = cvt_pk_bf16(a[2], a[3]); w.z = cvt_pk_bf16(b[0], b[1]); w.w = cvt_pk_bf16(b[2], b[3]); return w; }

struct DescProj {
    const char* A; const char* Bt; bf16_t* O; bf16_t* A2; int K, ldb;
    __device__ bool get(int i, Unit& u) const { int pm, pn; if (i >= 512 * ((0) == PROBE_GEMM ? PROBE_REP : 1)) return false; i %= 512; if (!static_order(i, T / 256, D / 256, pm, pn)) return false; u.r0 = pm * 256; u.c0 = pn * 256; u.e = 0; u.pad = 0; return true; }
    __device__ unsigned a_off(const Unit& u, int r) const { return (unsigned)(u.r0 + r) * (unsigned)(D * 2); }
    __device__ const char* b_ptr(const Unit& u) const { return Bt + (size_t)u.c0 * D * 2; }
    __device__ void epi(const f32x4 (&acc)[2][2][4][2], const Unit& u, int wr, int wc, int fr, int fq) const {
        EPI_LOOP_BEGIN
            const u32x4 w = pack8(v0, v1);
            const int t = u.r0 + lr, nn = u.c0 + lc;
            if (u.c0 < DP) *(u32x4*)(O + (size_t)t * D + nn) = w;
            else { const int g = (nn - DP) >> 4, co = (nn - DP) & 15; *(u32x4*)(A2 + ((size_t)(g * 1024 + (t >> 4))) * 512 + (t & 15) * 16 + co) = w; }
        EPI_LOOP_END
    }
};
struct DescS1 {
    const char* A; const char* Bt; float* O; int K, ldb;
    __device__ bool get(int i, Unit& u) const { if (i >= 256 * ((6) == PROBE_GEMM ? PROBE_REP : 1)) return false; i &= 255; u.e = i >> 2; u.r0 = (i & 3) * 256; u.c0 = 0; u.pad = 0; return true; }
    __device__ unsigned a_off(const Unit& u, int r) const { return (unsigned)(u.e * 1024 + u.r0 + r) * 1024u; }
    __device__ const char* b_ptr(const Unit& u) const { return Bt + (size_t)u.e * 256 * 256 * 2; }
    __device__ void epi(const f32x4 (&acc)[2][2][4][2], const Unit& u, int wr, int wc, int fr, int fq) const {
        EPI_LOOP_BEGIN
            float* p = O + ((size_t)(u.e * 1024 + u.r0 + lr)) * 256 + lc; *(f32x4*)p = v0; *(f32x4*)(p + 4) = v1;
        EPI_LOOP_END
    }
};
struct DescS2 {
    const char* A; const char* Bt; bf16_t* O; int K, ldb;
    __device__ bool get(int i, Unit& u) const { if (i >= 256 * ((7) == PROBE_GEMM ? PROBE_REP : 1)) return false; i &= 255; u.e = i >> 2; u.r0 = (i & 3) * 256; u.c0 = 0; u.pad = 0; return true; }
    __device__ unsigned a_off(const Unit& u, int r) const { return (unsigned)(u.e * 1024 + u.r0 + r) * 1024u; }
    __device__ const char* b_ptr(const Unit& u) const { return Bt + (size_t)u.e * 256 * 512 * 2; }
    __device__ void epi(const f32x4 (&acc)[2][2][4][2], const Unit& u, int wr, int wc, int fr, int fq) const {
        EPI_LOOP_BEGIN
            const int t = (u.r0 + lr) * 16 + (lc >> 4), co = lc & 15;
            const f32x4 g0 = (f32x4){gelu_tanh(v0[0]), gelu_tanh(v0[1]), gelu_tanh(v0[2]), gelu_tanh(v0[3])}, g1 = (f32x4){gelu_tanh(v1[0]), gelu_tanh(v1[1]), gelu_tanh(v1[2]), gelu_tanh(v1[3])};
            *(u32x4*)(O + (size_t)t * DS + u.e * 16 + co) = pack8(g0, g1);
        EPI_LOOP_END
    }
};
struct DescPool {
    const char* A; const char* Bt; bf16_t* O; const float* scale; int K, ldb;
    __device__ bool get(int i, Unit& u) const { if (i >= 256 * ((1) == PROBE_GEMM ? PROBE_REP : 1)) return false; i &= 255; u.e = i & 3; u.r0 = (i >> 2) * 256; u.c0 = u.e * 256; u.pad = 0; return true; }
    __device__ unsigned a_off(const Unit& u, int r) const { return ((unsigned)(u.r0 + r) * (unsigned)DP + (unsigned)u.e * 256u) * 2u; }
    __device__ const char* b_ptr(const Unit& u) const { return Bt + (size_t)u.e * 256 * 256 * 2; }
    __device__ void epi(const f32x4 (&acc)[2][2][4][2], const Unit& u, int wr, int wc, int fr, int fq) const {
        f32x4 scv[2][2];
#pragma unroll
        for (int bj = 0; bj < 2; ++bj)
#pragma unroll
            for (int n = 0; n < 2; ++n) scv[bj][n] = *(const f32x4*)(scale + u.c0 + 128 * bj + 32 * wc + 8 * fq + 4 * n);
        EPI_LOOP_BEGIN
            *(u32x4*)(O + (size_t)(u.r0 + lr) * D + u.c0 + lc) = pack8(v0 * scv[bj][0], v1 * scv[bj][1]);
        EPI_LOOP_END
    }
};
struct DescGlu {
    const char* A; const char* Bt; bf16_t* O; const float* bias; int K, ldb;
    __device__ bool get(int i, Unit& u) const { int pm, pn; if (i >= 256 * ((2) == PROBE_GEMM ? PROBE_REP : 1)) return false; i %= 256; if (!static_order(i, T / 256, DS / 256, pm, pn)) return false; u.r0 = pm * 256; u.c0 = pn * 256; u.e = 0; u.pad = 0; return true; }
    __device__ unsigned a_off(const Unit& u, int r) const { return (unsigned)(u.r0 + r) * (unsigned)(DS * 2); }
    __device__ const char* b_ptr(const Unit& u) const { return Bt + (size_t)u.c0 * DS * 2; }
    __device__ void epi(const f32x4 (&acc)[2][2][4][2], const Unit& u, int wr, int wc, int fr, int fq) const {
        f32x4 bvv[2][2];
#pragma unroll
        for (int bj = 0; bj < 2; ++bj)
#pragma unroll
            for (int n = 0; n < 2; ++n) bvv[bj][n] = *(const f32x4*)(bias + u.c0 + 128 * bj + 32 * wc + 8 * fq + 4 * n);
        const char* __restrict__ Yp = A + ((size_t)(u.r0 + 64 * wr + fr) * DS + u.c0 + 32 * wc + 8 * fq) * 2;
        u32x4 yq[4][2];
#pragma unroll
        for (int p = 0; p < 4; ++p)
#pragma unroll
            for (int q = 0; q < 2; ++q) yq[p][q] = *(const u32x4*)(Yp + ((size_t)(128 * (p >> 2) + 16 * (p & 3)) * DS) * 2 + q * 256);
#pragma unroll
        for (int rg = 0; rg < 8; ++rg) { const int ai = rg >> 2, m = rg & 3; const int lr = 128 * ai + 64 * wr + 16 * m + fr;
            u32x4 yc[2]; yc[0] = yq[rg & 3][0]; yc[1] = yq[rg & 3][1];
            if (rg < 4) { const int r2 = rg + 4;
#pragma unroll
                for (int q = 0; q < 2; ++q) yq[rg & 3][q] = *(const u32x4*)(Yp + ((size_t)(128 * (r2 >> 2) + 16 * (r2 & 3)) * DS) * 2 + q * 256); }
#pragma unroll
            for (int bj = 0; bj < 2; ++bj) { const int lc = 128 * bj + 32 * wc + 8 * fq; const f32x4 v0 = acc[ai][bj][m][0] + bvv[bj][0], v1 = acc[ai][bj][m][1] + bvv[bj][1]; const u32x4 yw = yc[bj];
                const f32x4 o0 = (f32x4){bflo(yw.x) * sigmoidf_(v0[0]), bfhi(yw.x) * sigmoidf_(v0[1]), bflo(yw.y) * sigmoidf_(v0[2]), bfhi(yw.y) * sigmoidf_(v0[3])};
                const f32x4 o1 = (f32x4){bflo(yw.z) * sigmoidf_(v1[0]), bfhi(yw.z) * sigmoidf_(v1[1]), bflo(yw.w) * sigmoidf_(v1[2]), bfhi(yw.w) * sigmoidf_(v1[3])};
                *(u32x4*)(O + (size_t)(u.r0 + lr) * D + DP + u.c0 + lc) = pack8(o0, o1); } }
    }
};
struct DescOut {
    const char* A; const char* Bt; bf16_t* O; const float* X; float* ST; int K, ldb;
    __device__ bool get(int i, Unit& u) const { int pm, pn; if (i >= 512 * ((3) == PROBE_GEMM ? PROBE_REP : 1)) return false; i %= 512; if (!static_order(i, T / 256, D / 256, pm, pn)) return false; u.r0 = pm * 256; u.c0 = pn * 256; u.e = 0; u.pad = 0; return true; }
    __device__ unsigned a_off(const Unit& u, int r) const { return (unsigned)(u.r0 + r) * (unsigned)(D * 2); }
    __device__ const char* b_ptr(const Unit& u) const { return Bt + (size_t)u.c0 * D * 2; }
    __device__ void epi(const f32x4 (&acc)[2][2][4][2], const Unit& u, int wr, int wc, int fr, int fq) const {
        const float* __restrict__ Xp = X + (size_t)(u.r0 + 64 * wr + fr) * D + u.c0 + 32 * wc + 8 * fq;
        f32x4 xq[3][4];
#pragma unroll
        for (int p = 0; p < 3; ++p)
#pragma unroll
            for (int q = 0; q < 4; ++q) xq[p][q] = *(const f32x4*)(Xp + (size_t)(128 * (p >> 2) + 16 * (p & 3)) * D + (q >> 1) * 128 + (q & 1) * 4);
#pragma unroll
        for (int rg = 0; rg < 8; ++rg) { const int ai = rg >> 2, m = rg & 3; const int lr = 128 * ai + 64 * wr + 16 * m + fr; float s = 0.f, ss = 0.f;
            f32x4 xc[4];
#pragma unroll
            for (int q = 0; q < 4; ++q) xc[q] = xq[rg % 3][q];
            if (rg < 5) { const int r2 = rg + 3;
#pragma unroll
                for (int q = 0; q < 4; ++q) xq[rg % 3][q] = *(const f32x4*)(Xp + (size_t)(128 * (r2 >> 2) + 16 * (r2 & 3)) * D + (q >> 1) * 128 + (q & 1) * 4); }
#pragma unroll
            for (int bj = 0; bj < 2; ++bj) { const int lc = 128 * bj + 32 * wc + 8 * fq; const size_t o = (size_t)(u.r0 + lr) * D + u.c0 + lc;
                const f32x4 v0 = xc[bj * 2] * ALPHA + acc[ai][bj][m][0], v1 = xc[bj * 2 + 1] * ALPHA + acc[ai][bj][m][1];
                s += ((v0[0] + v0[1]) + (v0[2] + v0[3])) + ((v1[0] + v1[1]) + (v1[2] + v1[3]));
                ss += ((v0[0] * v0[0] + v0[1] * v0[1]) + (v0[2] * v0[2] + v0[3] * v0[3])) + ((v1[0] * v1[0] + v1[1] * v1[1]) + (v1[2] * v1[2] + v1[3] * v1[3]));
                *(u32x4*)(O + o) = pack8(v0, v1); }
            s += __shfl_xor(s, 16); s += __shfl_xor(s, 32); ss += __shfl_xor(ss, 16); ss += __shfl_xor(ss, 32);
            if (fq == 0) *(f32x2*)(ST + ((size_t)(u.r0 + lr) * 32 + (u.c0 >> 8) * 4 + wc) * 2) = (f32x2){s, ss}; }
    }
};
struct MoeTab { const int* tstart; };
__device__ __forceinline__ int moe_expert_of_tile(const int* tstart, int tile) { int e = 0;
#pragma unroll 1
    for (int j = 1; j < NE; ++j) e += (tile >= tstart[j]) ? 1 : 0;
    return e; }
__device__ __forceinline__ bool moe_order(int nt, int npn, int i, int& tile, int& pn) {
    const int G = (int)gridDim.x, r = i / G, b = i - r * G, per = G >> 3, x = b & 7, j = b >> 3;
    const int lo = (x * nt) >> 3, hi = ((x + 1) * nt) >> 3, u = j + per * r;
    if (j >= per || u >= (hi - lo) * npn) return false;
    tile = lo + u / npn; pn = u - (u / npn) * npn; return true;
}
struct DescGU {
    const char* A; const char* Bt; bf16_t* O; const int* slot_tok; const int* tstart; int K, ldb;
    __device__ bool get(int i, Unit& u) const { int tile, pn; if (!moe_order(tstart[NE], 4, i, tile, pn)) return false; u.r0 = tile * 256; u.c0 = pn * 256; u.e = moe_expert_of_tile(tstart, tile); u.pad = 0; return true; }
    __device__ unsigned a_off(const Unit& u, int r) const { int t = slot_tok[u.r0 + r]; t = t < 0 ? 0 : t; return (unsigned)t * (unsigned)(D * 2); }
    __device__ const char* b_ptr(const Unit& u) const { return Bt + ((size_t)u.e * 1024 + u.c0) * D * 2; }
    __device__ void epi(const f32x4 (&acc)[2][2][4][2], const Unit& u, int wr, int wc, int fr, int fq) const {
#pragma unroll
        for (int ai = 0; ai < 2; ++ai)
#pragma unroll
            for (int m = 0; m < 4; ++m) { const int lr = 128 * ai + 64 * wr + 16 * m + fr; f32x4 h[2];
#pragma unroll
                for (int n = 0; n < 2; ++n) { const f32x4 g = acc[ai][0][m][n], up = acc[ai][1][m][n];
#pragma unroll
                    for (int j = 0; j < 4; ++j) h[n][j] = g[j] * sigmoidf_(g[j]) * up[j]; }
                *(u32x4*)(O + (size_t)(u.r0 + lr) * DE + (u.c0 >> 1) + 32 * wc + 8 * fq) = pack8(h[0], h[1]); }
    }
};
struct DescDown {
    const char* A; const char* Bt; bf16_t* O; const float* slot_gate; const int* tstart; int K, ldb;
    __device__ bool get(int i, Unit& u) const { int tile, pn; const int G_ = (int)gridDim.x; const int rr_ = i / G_; const int reps_ = ((5) == PROBE_GEMM ? PROBE_REP : 1); int rep_ = 0, ii_ = i; if (reps_ > 1) { rep_ = rr_ % reps_; ii_ = (rr_ / reps_) * G_ + (i - rr_ * G_); } if (!moe_order(tstart[NE], 8, ii_, tile, pn)) return false; u.r0 = tile * 256; u.c0 = pn * 256; u.pad = rep_; u.e = moe_expert_of_tile(tstart, tile); return true; }
    __device__ unsigned a_off(const Unit& u, int r) const { return (unsigned)(u.r0 + r) * (unsigned)(DE * 2); }
    __device__ const char* b_ptr(const Unit& u) const { return Bt + ((size_t)u.e * D + u.c0) * DE * 2; }
    __device__ void epi(const f32x4 (&acc)[2][2][4][2], const Unit& u, int wr, int wc, int fr, int fq) const {
        float gts[8];
#pragma unroll
        for (int rg = 0; rg < 8; ++rg) gts[rg] = slot_gate[u.r0 + 128 * (rg >> 2) + 64 * wr + 16 * (rg & 3) + fr];
#pragma unroll
        for (int ai = 0; ai < 2; ++ai)
#pragma unroll
            for (int m = 0; m < 4; ++m) { const int lr = 128 * ai + 64 * wr + 16 * m + fr; const float gt = gts[ai * 4 + m];
#pragma unroll
                for (int bj = 0; bj < 2; ++bj) { const int lc = 128 * bj + 32 * wc + 8 * fq;
                    if (!(PROBE_NOSTORE && u.pad > 0)) *(u32x4*)(O + (size_t)(u.r0 + lr) * D + u.c0 + lc) = pack8(acc[ai][bj][m][0] * gt, acc[ai][bj][m][1] * gt); } }
    }
};

__device__ __forceinline__ void tr_job(const Args& a, int j, const float*& src, int& lds_, bf16_t*& dst, int& ldd) {
    unsigned char* ws = a.ws;
    if (j < 1024) { const int kt = j >> 5, nt = j & 31; src = a.in[1] + (size_t)kt * 64 * D + nt * 64; lds_ = D; dst = (bf16_t*)(ws + WS_WIN) + (size_t)nt * 64 * D + kt * 64; ldd = D; return; }
    j -= 1024;
    if (j < 1024) { const int kt = j >> 5, nt = j & 31; src = a.in[14] + (size_t)kt * 64 * D + nt * 64; lds_ = D; dst = (bf16_t*)(ws + WS_WOUT) + (size_t)nt * 64 * D + kt * 64; ldd = D; return; }
    j -= 1024;
    if (j < 256) { const int kt = j >> 4, nt = j & 15; src = a.in[12] + (size_t)kt * 64 * DS + nt * 64; lds_ = DS; dst = (bf16_t*)(ws + WS_GLU) + (size_t)nt * 64 * DS + kt * 64; ldd = DS; return; }
    j -= 256;
    if (j < 64) { const int g = j >> 4, r = j & 15, kt = r >> 2, nt = r & 3; src = a.in[2] + (size_t)g * 65536 + kt * 64 * 256 + nt * 64; lds_ = 256; dst = (bf16_t*)(ws + WS_POOLW) + (size_t)g * 65536 + nt * 64 * 256 + kt * 64; ldd = 256; return; }
    j -= 64;
    if (j < 16384) { const int up = j >= 8192; if (up) j -= 8192; const int e = j >> 8, r = j & 255, kt = r >> 3, nt = r & 7, n0 = nt * 64;
        src = (up ? a.in[22] : a.in[21]) + (size_t)e * D * DE + (size_t)kt * 64 * DE + n0; lds_ = DE;
        const int drow = (n0 >> 7) * 256 + (n0 & 127) + (up ? 128 : 0);
        dst = (bf16_t*)(ws + WS_WGU) + ((size_t)e * 1024 + drow) * D + kt * 64; ldd = D; return; }
    j -= 16384;
    { const int e = j >> 8, r = j & 255, kt = r >> 5, nt = r & 31; src = a.in[23] + (size_t)e * DE * D + (size_t)kt * 64 * D + nt * 64; lds_ = D;
      dst = (bf16_t*)(ws + WS_WD) + ((size_t)e * D + nt * 64) * DE + kt * 64; ldd = DE; }
}
constexpr int TR_JOBS = 1024 + 1024 + 256 + 64 + 16384 + 8192;

__device__ void p0_prepass(const Args& a, unsigned char* lds, int rep) {
    const int tid = threadIdx.x, G = gridDim.x, bid = blockIdx.x;
    unsigned char* ws = a.ws;
    if (rep == 0 || PROBE_P0PART == 1) {
        const f32x4* x4 = (const f32x4*)a.in[0]; u32x4* xb = (u32x4*)(ws + WS_XB);
        const size_t n8 = (size_t)T * D / 8, stride = (size_t)G * 512;
        for (size_t i = (size_t)bid * 512 + tid; i < n8; i += 4 * stride) {
            f32x4 v[8];
#pragma unroll
            for (int q = 0; q < 4; ++q) { const size_t ii = i + q * stride; if (ii < n8) { v[2 * q] = x4[2 * ii]; v[2 * q + 1] = x4[2 * ii + 1]; } }
#pragma unroll
            for (int q = 0; q < 4; ++q) { const size_t ii = i + q * stride; if (ii < n8) { u32x4 o; o.x = cvt_pk_bf16(v[2 * q][0], v[2 * q][1]); o.y = cvt_pk_bf16(v[2 * q][2], v[2 * q][3]);
                o.z = cvt_pk_bf16(v[2 * q + 1][0], v[2 * q + 1][1]); o.w = cvt_pk_bf16(v[2 * q + 1][2], v[2 * q + 1][3]); xb[ii] = o; } }
        }
    }
    if (rep == 0 || PROBE_P0PART == 2) {
        bf16_t* tl = (bf16_t*)lds;
        const int lr = tid >> 4, lc4 = (tid & 15) * 4;
        const int on = tid >> 3, okg = (tid & 7) * 8;
        constexpr int NGRP = TR_JOBS / 8;
        int g_lo, g_hi, g_x = -1;
        if (G == 256) { constexpr int S1 = 11, S2 = 15, REM0 = 128 * S1 + 128 * S2;
            if (bid >= 128) { g_lo = (bid - 128) * S2; g_hi = g_lo + S2; if (REM0 + (bid - 128) < NGRP) g_x = REM0 + (bid - 128); }
            else { g_lo = 128 * S2 + bid * S1; g_hi = g_lo + S1; } }
        else { const int per = (NGRP + G - 1) / G; g_lo = bid * per; g_hi = g_lo + per; if (g_hi > NGRP) g_hi = NGRP; if (g_lo > NGRP) g_lo = NGRP; }
        for (int gi = g_lo; gi <= g_hi; ++gi) {
            int jg; if (gi < g_hi) jg = gi * 8; else { if (g_x < 0) break; jg = g_x * 8; }
            f32x4 v[8][2]; bf16_t* dst[8]; int ldd[8];
#pragma unroll
            for (int q = 0; q < 8; ++q) { const float* src; int ls; tr_job(a, jg + q, src, ls, dst[q], ldd[q]);
                v[q][0] = *(const f32x4*)(src + (size_t)lr * ls + lc4); v[q][1] = *(const f32x4*)(src + (size_t)(lr + 32) * ls + lc4); }
            __syncthreads();
#pragma unroll
            for (int q = 0; q < 8; ++q) { unsigned* t0 = (unsigned*)(tl + q * 64 * 66);
                t0[(lr * 66 + lc4) >> 1] = cvt_pk_bf16(v[q][0][0], v[q][0][1]); t0[((lr * 66 + lc4) >> 1) + 1] = cvt_pk_bf16(v[q][0][2], v[q][0][3]);
                t0[((lr + 32) * 66 + lc4) >> 1] = cvt_pk_bf16(v[q][1][0], v[q][1][1]); t0[(((lr + 32) * 66 + lc4) >> 1) + 1] = cvt_pk_bf16(v[q][1][2], v[q][1][3]); }
            __syncthreads();
#pragma unroll
            for (int q = 0; q < 8; ++q) { const bf16_t* t0 = tl + q * 64 * 66; unsigned f[8];
#pragma unroll
                for (int e = 0; e < 8; ++e) f[e] = t0[(okg + e) * 66 + on];
                u32x4 o; o.x = f[0] | (f[1] << 16); o.y = f[2] | (f[3] << 16); o.z = f[4] | (f[5] << 16); o.w = f[6] | (f[7] << 16);
                *(u32x4*)(dst[q] + (size_t)on * ldd[q] + okg) = o; }
        }
        __syncthreads();
    }
    if (rep == 0 || PROBE_P0PART == 3)
    {
        f32x2* pw = (f32x2*)lds;
        f32x2* Bb = (f32x2*)(lds + 17408);
        f32x2* Cc = (f32x2*)(lds + 17408 + 16384);
        float* KT = (float*)(lds + 17408 + 16384 + 16640);
        for (int job = bid; job < 2 * NG; job += G) {
            const int g = job >> 1, half = job & 1;
            __syncthreads();
            for (int i = tid; i < 2 * 17 * 64; i += 512) { const int dr = i / (17 * 64), l = (i >> 6) % 17, p = i & 63, ix = (dr * NG + g) * NP + p;
                const float lre = a.in[4][ix], lim = a.in[5][ix], dt = expf(a.in[6][dr * NG + g]);
                const float mg = expf(lre * dt * (float)l); float sn, cs; sincosf(lim * dt * (float)l, &sn, &cs); pw[i] = (f32x2){mg * cs, mg * sn}; }
            for (int i = tid; i < 2 * 64; i += 512) { const int dr = i >> 6, p = i & 63, ix = (dr * NG + g) * NP + p;
                const float lre = a.in[4][ix], lim = a.in[5][ix], dt = expf(a.in[6][dr * NG + g]);
                const float mg = expf(lre * dt), ar = mg * cosf(lim * dt), ai = mg * sinf(lim * dt), den = lre * lre + lim * lim;
                const float zr = ((ar - 1.0f) * lre + ai * lim) / den, zi = (ai * lre - (ar - 1.0f) * lim) / den;
#pragma unroll
                for (int c = 0; c < GC; ++c) { const float br = a.in[7][(size_t)ix * GC + c], bi = a.in[8][(size_t)ix * GC + c]; Bb[i * GC + c] = (f32x2){zr * br - zi * bi, zr * bi + zi * br}; } }
            for (int i = tid; i < 2 * GC * NP; i += 512) { const int dr = i >> 10, r = i & 1023; const size_t o = ((size_t)(dr * NG + g) * GC) * NP + r; Cc[(i >> 6) * 65 + (i & 63)] = (f32x2){a.in[9][o], a.in[10][o]}; }
            __syncthreads();
            { const int dr = tid >> 8, l = (tid >> 4) & 15, co = tid & 15; float ac[16];
#pragma unroll
              for (int c = 0; c < 16; ++c) ac[c] = 0.f;
              for (int p = 0; p < NP; ++p) { const f32x2 cv = Cc[(dr * 16 + co) * 65 + p], wv = pw[(dr * 17 + l) * 64 + p]; const float cr = cv.x * wv.x - cv.y * wv.y, ci = cv.x * wv.y + cv.y * wv.x;
                  const f32x4* bq = (const f32x4*)(Bb + (dr * 64 + p) * 16);
#pragma unroll
                  for (int c = 0; c < 8; ++c) { const f32x4 bv = bq[c]; ac[2 * c] += cr * bv[0] - ci * bv[1]; ac[2 * c + 1] += cr * bv[2] - ci * bv[3]; } }
#pragma unroll
              for (int c = 0; c < 16; ++c) KT[((dr * 16 + l) * 16 + co) * 16 + c] = ac[c]; }
            __syncthreads();
            bf16_t* w2 = (bf16_t*)(ws + WS_W2T) + (size_t)g * 256 * 512;
            for (int it = tid; it < 128 * 64; it += 512) { const int rr = it >> 6, kg = it & 63, n = half * 128 + rr, j = n >> 4, co = n & 15; float f[8];
                if (kg < 32) { const int i = kg >> 1, ci0 = (kg & 1) * 8;
#pragma unroll
                    for (int e = 0; e < 8; ++e) { const int ci = ci0 + e; float v = 0.f;
                        if (i <= j) v += KT[((0 * 16 + (j - i)) * 16 + co) * 16 + ci];
                        if (i >= j) v += KT[((1 * 16 + (i - j)) * 16 + co) * 16 + ci];
                        if (i == j && ci == co) v += a.in[11][g * GC + co];
                        f[e] = v; } }
                else { const int kk = (kg - 32) * 8, dr = kk >> 7, ri = (kk >> 6) & 1, p0 = kk & 63, ex = dr == 0 ? j + 1 : 16 - j;
#pragma unroll
                    for (int e = 0; e < 8; ++e) { const f32x2 cv = Cc[(dr * 16 + co) * 65 + p0 + e], wv = pw[(dr * 17 + ex) * 64 + p0 + e];
                        f[e] = ri == 0 ? (cv.x * wv.x - cv.y * wv.y) : -(cv.x * wv.y + cv.y * wv.x); } }
                u32x4 o; o.x = cvt_pk_bf16(f[0], f[1]); o.y = cvt_pk_bf16(f[2], f[3]); o.z = cvt_pk_bf16(f[4], f[5]); o.w = cvt_pk_bf16(f[6], f[7]);
                *(u32x4*)(w2 + (size_t)n * 512 + kg * 8) = o; }
            bf16_t* w1 = (bf16_t*)(ws + WS_W1T) + (size_t)g * 256 * 256;
            for (int it = tid; it < 128 * 32; it += 512) { const int rr = it >> 5, kg = it & 31, dr = half, ri = rr >> 6, p = rr & 63, i = kg >> 1, ci0 = (kg & 1) * 8, ex = dr == 0 ? 15 - i : i;
                const f32x2 wv = pw[(dr * 17 + ex) * 64 + p]; float f[8];
#pragma unroll
                for (int e = 0; e < 8; ++e) { const f32x2 bv = Bb[(dr * 64 + p) * 16 + ci0 + e]; f[e] = ri == 0 ? (wv.x * bv.x - wv.y * bv.y) : (wv.x * bv.y + wv.y * bv.x); }
                u32x4 o; o.x = cvt_pk_bf16(f[0], f[1]); o.y = cvt_pk_bf16(f[2], f[3]); o.z = cvt_pk_bf16(f[4], f[5]); o.w = cvt_pk_bf16(f[6], f[7]);
                *(u32x4*)(w1 + (size_t)(half * 128 + rr) * 256 + kg * 8) = o; }
            if (tid < 64) ((f32x2*)(ws + WS_SSMP + SSMP_A16))[(half * NG + g) * NP + tid] = pw[(half * 17 + 16) * 64 + tid];
        }
        __syncthreads();
    }
    {
        u32x4* rwf = (u32x4*)(ws + WS_RW);
        for (int i = bid * 512 + tid; i < 8 * 8 * 3 * 64; i += G * 512) {
            const int lane_ = i & 63, f = i >> 6, nt = f % 3, ks = (f / 3) & 7, w = f / 24, n = lane_ & 15, fq = lane_ >> 4, j = nt * 16 + n;
            float wv[8];
#pragma unroll
            for (int e = 0; e < 8; ++e) { const int k = w * 256 + ks * 32 + fq * 8 + e; wv[e] = j < 4 ? a.in[17][k * 4 + j] : (j < NR ? a.in[19][k * NE + (j - 4)] : 0.f); }
            u32x4 hi; hi.x = cvt_pk_bf16(wv[0], wv[1]); hi.y = cvt_pk_bf16(wv[2], wv[3]); hi.z = cvt_pk_bf16(wv[4], wv[5]); hi.w = cvt_pk_bf16(wv[6], wv[7]);
            u32x4 lo; lo.x = cvt_pk_bf16(wv[0] - bflo(hi.x), wv[1] - bfhi(hi.x)); lo.y = cvt_pk_bf16(wv[2] - bflo(hi.y), wv[3] - bfhi(hi.y));
            lo.z = cvt_pk_bf16(wv[4] - bflo(hi.z), wv[5] - bfhi(hi.z)); lo.w = cvt_pk_bf16(wv[6] - bflo(hi.w), wv[7] - bfhi(hi.w));
            rwf[(size_t)(f * 2 + 0) * 64 + lane_] = hi; rwf[(size_t)(f * 2 + 1) * 64 + lane_] = lo;
        }
    }
}

template <int W>
__device__ __forceinline__ void pooldiff_item(const bf16_t* proj, bf16_t* dp, int t, int c8) {
    const int s = t & (S - 1);
    const bf16_t* base = proj + (size_t)t * D + c8;
    float sum[8];
#pragma unroll
    for (int e = 0; e < 8; ++e) sum[e] = 0.f;
    u32x4 self;
#pragma unroll
    for (int q = -W / 2; q < W / 2; ++q) { const bool ok = (s + q >= 0) && (s + q < S);
        u32x4 v = (u32x4){0u, 0u, 0u, 0u}; if (ok) v = *(const u32x4*)(base + (ptrdiff_t)q * D);
        if (q == 0) self = v;
#pragma unroll
        for (int e = 0; e < 4; ++e) { sum[2 * e] += bflo(v[e]); sum[2 * e + 1] += bfhi(v[e]); } }
    int lo = s - W / 2, hi = s + W / 2; lo = lo < 0 ? 0 : lo; hi = hi > S ? S : hi;
    const float inv = 1.0f / (float)(hi - lo);
    u32x4 o;
#pragma unroll
    for (int e = 0; e < 4; ++e) o[e] = cvt_pk_bf16(sum[2 * e] * inv - bflo(self[e]), sum[2 * e + 1] * inv - bfhi(self[e]));
    *(u32x4*)(dp + (size_t)t * DP + c8) = o;
}
__device__ void p2_pooldiff(const Args& a) {
    const bf16_t* proj = (const bf16_t*)(a.ws + WS_PROJ); bf16_t* dp = (bf16_t*)(a.ws + WS_DPOOL);
    const int n = T * (DP / 8);
    for (int i = blockIdx.x * 512 + threadIdx.x; i < n; i += gridDim.x * 512) {
        const int lane = i & 63, g = (i >> 6) & 3, t = (i >> 8) * 2 + (lane >> 5), c8 = (g * 32 + (lane & 31)) * 8;
        if (g == 0) pooldiff_item<2>(proj, dp, t, c8); else if (g == 1) pooldiff_item<4>(proj, dp, t, c8); else if (g == 2) pooldiff_item<8>(proj, dp, t, c8); else pooldiff_item<16>(proj, dp, t, c8);
    }
}

__device__ void p3_scan(const Args& a, unsigned char* lds) {
    const int tid = threadIdx.x, wid = tid >> 6, lane = tid & 63;
    unsigned char* ws = a.ws;
    const float* Sb = (const float*)(ws + WS_XB); bf16_t* A2 = (bf16_t*)(ws + WS_A2); const f32x2* a16 = (const f32x2*)(ws + WS_SSMP + SSMP_A16);
    f32x2* F = (f32x2*)lds;
    for (int job = blockIdx.x; job < 256; job += gridDim.x) {
        const int g = job >> 2, b = (job >> 1) & 1, dr = job & 1, p = lane;
        const f32x2 A = a16[(dr * NG + g) * NP + p];
        float pr = A.x, pi = A.y;
#pragma unroll
        for (int q = 0; q < 6; ++q) { const float nr = pr * pr - pi * pi, ni = 2.0f * pr * pi; pr = nr; pi = ni; }
        const float* sp = Sb + ((size_t)(g * 1024 + b * 512 + wid * 64)) * 256 + dr * 128 + p;
        float xr = 0.f, xi = 0.f;
#pragma unroll 8
        for (int q = 0; q < 64; ++q) { const int c = dr == 0 ? q : 63 - q; const float sr = sp[c * 256], si = sp[c * 256 + 64];
            const float nr = A.x * xr - A.y * xi + sr, ni = A.x * xi + A.y * xr + si; xr = nr; xi = ni; }
        __syncthreads();
        F[wid * 64 + p] = (f32x2){xr, xi};
        __syncthreads();
        float cr = 0.f, ci = 0.f;
        if (dr == 0) { for (int v = 0; v < wid; ++v) { const f32x2 f = F[v * 64 + p]; const float nr = pr * cr - pi * ci + f.x, ni = pr * ci + pi * cr + f.y; cr = nr; ci = ni; } }
        else { for (int v = 7; v > wid; --v) { const f32x2 f = F[v * 64 + p]; const float nr = pr * cr - pi * ci + f.x, ni = pr * ci + pi * cr + f.y; cr = nr; ci = ni; } }
        xr = cr; xi = ci;
        bf16_t* op = A2 + ((size_t)(g * 1024 + b * 512 + wid * 64)) * 512 + 256 + dr * 128 + p;
#pragma unroll 8
        for (int q = 0; q < 64; ++q) { const int c = dr == 0 ? q : 63 - q; const float sr = sp[c * 256], si = sp[c * 256 + 64];
            op[c * 512] = (bf16_t)(cvt_pk_bf16(xr, xr) & 0xffffu); op[c * 512 + 64] = (bf16_t)(cvt_pk_bf16(xi, xi) & 0xffffu);
            const float nr = A.x * xr - A.y * xi + sr, ni = A.x * xi + A.y * xr + si; xr = nr; xi = ni; }
    }
}

__device__ void p5_ln1_router(const Args& a, unsigned char* lds, int rep) {
    const int tid = threadIdx.x, wid = tid >> 6, lane = tid & 63, m = lane & 15, fq = lane >> 4;
    unsigned char* ws = a.ws;
    const bf16_t* __restrict__ v1b = (const bf16_t*)(ws + WS_V1B); const float* __restrict__ stt = (const float*)(ws + WS_ST); bf16_t* __restrict__ h1b = (bf16_t*)(ws + WS_H1B); const u32x4* __restrict__ rwf = (const u32x4*)(ws + WS_RW);
    if (rep) h1b = (bf16_t*)(ws + 345 * MB);
    const float* g1 = a.in[15]; const float* b1 = a.in[16];
    int* tok_e = (int*)(ws + WS_ROUTE + RT_E); int* tok_rank = (int*)(ws + WS_ROUTE + RT_RANK); float* tok_gate = (float*)(ws + WS_ROUTE + RT_GATE);
    float* PL = (float*)(lds + 1024);
    float* LG = (float*)(lds + 1024 + 24576);
    float* GB = (float*)(lds + 32768);
    int* EL = (int*)(lds + 512);
    unsigned char* gc = (unsigned char*)(ws + WS_GC);
    __syncthreads();
    for (int i = tid; i < D; i += 512) { GB[i] = g1[i]; GB[D + i] = b1[i]; }
    __syncthreads();
    u32x4 vn[8]; f32x4 qn[4];
    { const int grp = blockIdx.x; if (grp < T / 16) { const size_t ro = (size_t)(grp * 16 + m) * D + wid * 256 + fq * 8;
#pragma unroll
        for (int ks = 0; ks < 8; ++ks) vn[ks] = *(const u32x4*)(v1b + ro + ks * 32);
#pragma unroll
        for (int q = 0; q < 4; ++q) qn[q] = *(const f32x4*)(stt + ((size_t)(grp * 16 + m) * 32 + fq * 8) * 2 + q * 4); } }
    for (int grp = blockIdx.x; grp < T / 16; grp += gridDim.x) {
        const int t = grp * 16 + m; const size_t ro = (size_t)t * D + wid * 256 + fq * 8;
        u32x4 v[8]; f32x4 qv[4];
#pragma unroll
        for (int ks = 0; ks < 8; ++ks) v[ks] = vn[ks];
#pragma unroll
        for (int q = 0; q < 4; ++q) qv[q] = qn[q];
        float s = (qv[0][0] + qv[0][2]) + (qv[1][0] + qv[1][2]) + (qv[2][0] + qv[2][2]) + (qv[3][0] + qv[3][2]);
        float ss = (qv[0][1] + qv[0][3]) + (qv[1][1] + qv[1][3]) + (qv[2][1] + qv[2][3]) + (qv[3][1] + qv[3][3]);
        s += __shfl_xor(s, 16); s += __shfl_xor(s, 32); ss += __shfl_xor(ss, 16); ss += __shfl_xor(ss, 32);
        const float mu = s * (1.0f / D); const float rstd = rsqrtf(fmaxf(ss * (1.0f / D) - mu * mu, 0.f) + LN_EPS);
        f32x4 acc[3];
#pragma unroll
        for (int nt = 0; nt < 3; ++nt) acc[nt] = (f32x4){0.f, 0.f, 0.f, 0.f};
        u32x4 wc_[6], wn_[6];
#pragma unroll
        for (int q = 0; q < 6; ++q) wc_[q] = rwf[(size_t)((wid * 8 + 0) * 6 + q) * 64 + lane];
#pragma unroll
        for (int ks = 0; ks < 8; ++ks) {
            if (ks < 7) {
#pragma unroll
                for (int q = 0; q < 6; ++q) wn_[q] = rwf[(size_t)((wid * 8 + ks + 1) * 6 + q) * 64 + lane]; }
            const int kk = wid * 256 + ks * 32 + fq * 8;
            const f32x4 ga = *(const f32x4*)(GB + kk), gb = *(const f32x4*)(GB + kk + 4), ba = *(const f32x4*)(GB + D + kk), bb = *(const f32x4*)(GB + D + kk + 4);
            const f32x4 va = (f32x4){bflo(v[ks].x), bfhi(v[ks].x), bflo(v[ks].y), bfhi(v[ks].y)}, vb = (f32x4){bflo(v[ks].z), bfhi(v[ks].z), bflo(v[ks].w), bfhi(v[ks].w)};
            const f32x4 h0 = (va - mu) * rstd * ga + ba, h1 = (vb - mu) * rstd * gb + bb;
            u32x4 hi; hi.x = cvt_pk_bf16(h0[0], h0[1]); hi.y = cvt_pk_bf16(h0[2], h0[3]); hi.z = cvt_pk_bf16(h1[0], h1[1]); hi.w = cvt_pk_bf16(h1[2], h1[3]);
            *(u32x4*)(h1b + ro + ks * 32) = hi;
            u32x4 lo; lo.x = cvt_pk_bf16(h0[0] - bflo(hi.x), h0[1] - bfhi(hi.x)); lo.y = cvt_pk_bf16(h0[2] - bflo(hi.y), h0[3] - bfhi(hi.y));
            lo.z = cvt_pk_bf16(h1[0] - bflo(hi.z), h1[1] - bfhi(hi.z)); lo.w = cvt_pk_bf16(h1[2] - bflo(hi.w), h1[3] - bfhi(hi.w));
            const bf16x8 ahi = __builtin_bit_cast(bf16x8, hi), alo = __builtin_bit_cast(bf16x8, lo);
#pragma unroll
            for (int nt = 0; nt < 3; ++nt) {
                const bf16x8 whi = __builtin_bit_cast(bf16x8, wc_[nt * 2]), wlo = __builtin_bit_cast(bf16x8, wc_[nt * 2 + 1]);
                acc[nt] = __builtin_amdgcn_mfma_f32_16x16x32_bf16(whi, ahi, acc[nt], 0, 0, 0);
                acc[nt] = __builtin_amdgcn_mfma_f32_16x16x32_bf16(whi, alo, acc[nt], 0, 0, 0);
                acc[nt] = __builtin_amdgcn_mfma_f32_16x16x32_bf16(wlo, ahi, acc[nt], 0, 0, 0); }
#pragma unroll
            for (int q = 0; q < 6; ++q) wc_[q] = wn_[q];
        }
        { const int gn = grp + gridDim.x; if (gn < T / 16) { const size_t rn = (size_t)(gn * 16 + m) * D + wid * 256 + fq * 8;
#pragma unroll
            for (int ks = 0; ks < 8; ++ks) vn[ks] = *(const u32x4*)(v1b + rn + ks * 32);
#pragma unroll
            for (int q = 0; q < 4; ++q) qn[q] = *(const f32x4*)(stt + ((size_t)(gn * 16 + m) * 32 + fq * 8) * 2 + q * 4); } }
#pragma unroll
        for (int nt = 0; nt < 3; ++nt) *(f32x4*)(PL + (wid * 16 + m) * 48 + nt * 16 + fq * 4) = acc[nt];
        __syncthreads();
        for (int i = tid; i < 16 * 48; i += 512) { const int mm = i / 48, j = i - mm * 48; float sm = 0.f;
#pragma unroll
            for (int w = 0; w < 8; ++w) sm += PL[(w * 16 + mm) * 48 + j];
            LG[i] = sm + (j < 4 ? a.in[18][j] : (j < NR ? a.in[20][j - 4] : 0.f)); }
        __syncthreads();
        if (tid < 16 && rep == 0) {
            const float* l = LG + tid * 48;
            const float g0 = l[0], g1v = l[1], g2 = l[2], g3 = l[3];
            int gsel = 0; float gm = g0; if (g1v > gm) { gm = g1v; gsel = 1; } if (g2 > gm) { gm = g2; gsel = 2; } if (g3 > gm) { gm = g3; gsel = 3; }
            const float pg = 1.0f / (expf(g0 - gm) + expf(g1v - gm) + expf(g2 - gm) + expf(g3 - gm));
            float el[8];
#pragma unroll
            for (int i = 0; i < 8; ++i) el[i] = l[4 + gsel * 8 + i];
            int i1 = 0; float m1 = el[0];
#pragma unroll
            for (int i = 1; i < 8; ++i) if (el[i] > m1) { m1 = el[i]; i1 = i; }
            int i2 = -1; float m2 = -3.0e38f;
#pragma unroll
            for (int i = 0; i < 8; ++i) if (i != i1 && el[i] > m2) { m2 = el[i]; i2 = i; }
            const float e2 = expf(m2 - m1), inv = 1.0f / (1.0f + e2);
            const int tt = grp * 16 + tid; const int ea = gsel * 8 + i1, eb = gsel * 8 + i2;
            EL[tid * 2] = ea; EL[tid * 2 + 1] = eb;
            tok_e[tt * 2] = ea; tok_e[tt * 2 + 1] = eb; tok_gate[tt * 2] = pg * inv; tok_gate[tt * 2 + 1] = pg * e2 * inv;
        }
        __syncthreads();
        if (tid < 32 && rep == 0) { const int me = EL[tid]; int r = 0;
            for (int q = 0; q < tid; ++q) r += (EL[q] == me) ? 1 : 0;
            tok_rank[(grp * 16) * 2 + tid] = r; }
        else if (tid >= 32 && tid < 64 && rep == 0) { const int e = tid - 32; int c = 0;
#pragma unroll
            for (int q = 0; q < 32; ++q) c += (EL[q] == e) ? 1 : 0;
            gc[grp * 32 + e] = (unsigned char)c; }
    }
    __syncthreads();
}

__device__ __forceinline__ void moe_build_tab(const Args& a, int* tstart) {
    if (threadIdx.x == 0) { const unsigned* cnt = (const unsigned*)(a.ws + WS_CTL); int acc = 0;
        for (int e = 0; e < NE; ++e) { tstart[e] = acc; acc += ((int)__hip_atomic_load(cnt + e, __ATOMIC_RELAXED, __HIP_MEMORY_SCOPE_AGENT) + 255) >> 8; }
        tstart[NE] = acc; }
    __syncthreads();
}

__device__ void p6_slots(const Args& a, unsigned char* lds, int* tstart) {
    const int tid = threadIdx.x;
    unsigned char* ws = a.ws;
    const int* tok_e = (const int*)(ws + WS_ROUTE + RT_E); const int* tok_rank = (const int*)(ws + WS_ROUTE + RT_RANK); const float* tok_gate = (const float*)(ws + WS_ROUTE + RT_GATE);
    int* slot_tok = (int*)(ws + WS_ROUTE + RT_STOK); float* slot_gate = (float*)(ws + WS_ROUTE + RT_SGATE); int* tok_slot = (int*)(ws + WS_ROUTE + RT_SGATE + (size_t)MAXTILES * 256 * 4);
    unsigned char* GC = lds;
    unsigned short* BASE = (unsigned short*)(lds + 32768);
    int* CS = (int*)(lds + 98304);
    int* CNT = (int*)(lds + 98304 + 2048);
    __syncthreads();
    { const u32x4* src = (const u32x4*)(ws + WS_GC); u32x4* dst = (u32x4*)GC;
#pragma unroll
      for (int q = 0; q < 4; ++q) dst[tid + q * 512] = src[tid + q * 512]; }
    __syncthreads();
    const int e = tid & 31, c = tid >> 5;
    { int sm = 0; for (int g = c * 64; g < c * 64 + 64; ++g) sm += GC[g * 32 + e]; CS[e * 16 + c] = sm; }
    __syncthreads();
    if (tid < 32) { int run = 0; for (int q = 0; q < 16; ++q) { const int tmp = CS[tid * 16 + q]; CS[tid * 16 + q] = run; run += tmp; } CNT[tid] = run; }
    __syncthreads();
    if (tid == 0) { int acc = 0; for (int q = 0; q < NE; ++q) { tstart[q] = acc; acc += (CNT[q] + 255) >> 8; } tstart[NE] = acc; }
    if (blockIdx.x == 0 && tid < 32) ((unsigned*)(ws + WS_CTL))[tid] = (unsigned)CNT[tid];
    { int run = CS[e * 16 + c]; for (int g = c * 64; g < c * 64 + 64; ++g) { BASE[g * 32 + e] = (unsigned short)run; run += GC[g * 32 + e]; } }
    __syncthreads();
    for (int i = blockIdx.x * 512 + tid; i < T * 2; i += gridDim.x * 512) {
        const int ee = tok_e[i], s = tstart[ee] * 256 + (int)BASE[(i >> 5) * 32 + ee] + tok_rank[i]; slot_tok[s] = i >> 1; slot_gate[s] = tok_gate[i]; tok_slot[i] = s; }
    const int ns = tstart[NE] * 256;
    for (int s = blockIdx.x * 512 + tid; s < ns; s += gridDim.x * 512) {
        const int ee = moe_expert_of_tile(tstart, s >> 8); const int r = s - tstart[ee] * 256;
        if (r >= CNT[ee]) { slot_tok[s] = -1; slot_gate[s] = 0.f; } }
    __syncthreads();
}

__device__ void p9_ln2(const Args& a, const int* tstart, int rep) {
    const int tid = threadIdx.x, wid = tid >> 6, lane = tid & 63;
    const float* g2 = a.in[24]; const float* b2 = a.in[25];
    const bf16_t* ys = (const bf16_t*)(a.ws + WS_YS); const bf16_t* h1b = (const bf16_t*)(a.ws + WS_H1B);
    const int* tok_slot = (const int*)(a.ws + WS_ROUTE + RT_SGATE + (size_t)MAXTILES * 256 * 4);
    const int nw = gridDim.x * 8;
    for (int t = blockIdx.x * 8 + wid; t < T; t += nw) {
        float* roww = rep == 0 ? a.out + (size_t)t * D : (float*)(a.ws + 25 * MB) + (size_t)(t & 8191) * D;
        const size_t sa = (size_t)tok_slot[t * 2] * D, sb = (size_t)tok_slot[t * 2 + 1] * D;
        f32x4 h[8]; float s = 0.f;
#pragma unroll
        for (int i = 0; i < 8; ++i) { const u32x2 hv = *(const u32x2*)(h1b + (size_t)t * D + i * 256 + lane * 4);
            const u32x2 ya = *(const u32x2*)(ys + sa + i * 256 + lane * 4), yb = *(const u32x2*)(ys + sb + i * 256 + lane * 4);
            h[i][0] = ALPHA * bflo(hv.x) + (bflo(ya.x) + bflo(yb.x)); h[i][1] = ALPHA * bfhi(hv.x) + (bfhi(ya.x) + bfhi(yb.x));
            h[i][2] = ALPHA * bflo(hv.y) + (bflo(ya.y) + bflo(yb.y)); h[i][3] = ALPHA * bfhi(hv.y) + (bfhi(ya.y) + bfhi(yb.y));
            s += (h[i][0] + h[i][1]) + (h[i][2] + h[i][3]); }
        const float mu = wave_sum(s) * (1.0f / D); float vq = 0.f;
#pragma unroll
        for (int i = 0; i < 8; ++i) { const f32x4 d = h[i] - mu; vq += (d[0] * d[0] + d[1] * d[1]) + (d[2] * d[2] + d[3] * d[3]); }
        const float rstd = rsqrtf(wave_sum(vq) * (1.0f / D) + LN_EPS);
#pragma unroll
        for (int i = 0; i < 8; ++i) { const f32x4 gv = *(const f32x4*)(g2 + i * 256 + lane * 4), bv = *(const f32x4*)(b2 + i * 256 + lane * 4);
            *(f32x4*)(roww + i * 256 + lane * 4) = (h[i] - mu) * rstd * gv + bv; }
    }
}

constexpr int NPHASE = 12;
__global__ void __launch_bounds__(512, 2) fwd(Args a) {
    extern __shared__ __attribute__((aligned(16))) unsigned char lds[];
    cg::grid_group grid = cg::this_grid();
    unsigned char* ws = a.ws;
    int* tstart = (int*)(lds + MISC_OFF);
    volatile LAS unsigned* bst = (volatile LAS unsigned*)((LAS unsigned char*)lds + MISC_OFF + 256);
    if (threadIdx.x < 4) bst[threadIdx.x] = 0u;
    __syncthreads();
    XcdBarrier xbar = xcd_barrier_post((unsigned*)(ws + WS_BAR), bst);
    if (a.ph_hi > 1000) grid.sync();
#define IN(k) (a.ph_lo <= (k) && (k) < a.ph_hi)
    volatile unsigned long long* tsv = (volatile unsigned long long*)(lds + MISC_OFF + 512);
#define TS_START(k) do { if ((k) == PROBE_TS_A && blockIdx.x == 0 && threadIdx.x == 0) tsv[0] = __builtin_amdgcn_s_memrealtime(); } while (0)
#define TS_END(k) do { if ((k) == PROBE_TS_B && blockIdx.x == 0 && threadIdx.x == 0) tsv[1] = __builtin_amdgcn_s_memrealtime(); } while (0)
#define SEAM(k) do { if (IN(k) && IN((k) + 1)) xcd_barrier(xbar); } while (0)
    for (int q = 0; q < PROBE_SYNC; ++q) xcd_barrier(xbar);
    TS_START(0);
    if (IN(0)) for (int rep = 0; rep < (0 == PROBE_PHASE ? PROBE_REP : 1); ++rep) p0_prepass(a, lds, rep);
    SEAM(0); TS_END(0);
    TS_START(1);
    if (IN(1)) { DescProj d{(const char*)(ws + WS_XB), (const char*)(ws + WS_WIN), (bf16_t*)(ws + WS_PROJ), (bf16_t*)(ws + WS_A2), D, D}; gemm_run<0>(lds, d); }
    SEAM(1); TS_END(1);
    TS_START(2);
    if (IN(2)) { for (int rep = 0; rep < (2 == PROBE_PHASE ? PROBE_REP : 1); ++rep) p2_pooldiff(a);
        DescS1 d{(const char*)(ws + WS_A2), (const char*)(ws + WS_W1T), (float*)(ws + WS_XB), 256, 256}; gemm_run<6>(lds, d); }
    SEAM(2); TS_END(2);
    TS_START(3);
    if (IN(3)) for (int rep = 0; rep < (3 == PROBE_PHASE ? PROBE_REP : 1); ++rep) p3_scan(a, lds);
    SEAM(3); TS_END(3);
    TS_START(4);
    if (IN(4)) {
        { DescS2 d{(const char*)(ws + WS_A2), (const char*)(ws + WS_W2T), (bf16_t*)(ws + WS_YSSM), 512, 512}; gemm_run<7>(lds, d); }
        { DescPool d{(const char*)(ws + WS_DPOOL), (const char*)(ws + WS_POOLW), (bf16_t*)(ws + WS_XB), a.in[3], 256, 256}; gemm_run<1>(lds, d); }
    }
    SEAM(4); TS_END(4);
    TS_START(5);
    if (IN(5)) { DescGlu d{(const char*)(ws + WS_YSSM), (const char*)(ws + WS_GLU), (bf16_t*)(ws + WS_XB), a.in[13], DS, DS}; gemm_run<2>(lds, d); }
    SEAM(5); TS_END(5);
    TS_START(6);
    if (IN(6)) { DescOut d{(const char*)(ws + WS_XB), (const char*)(ws + WS_WOUT), (bf16_t*)(ws + WS_V1B), a.in[0], (float*)(ws + WS_ST), D, D}; gemm_run<3>(lds, d); }
    SEAM(6); TS_END(6);
    TS_START(7);
    if (IN(7)) for (int rep = 0; rep < (7 == PROBE_PHASE ? PROBE_REP : 1); ++rep) p5_ln1_router(a, lds, rep);
    SEAM(7); TS_END(7);
    TS_START(8);
    if (IN(8)) { for (int rep = 0; rep < (8 == PROBE_PHASE ? PROBE_REP : 1); ++rep) p6_slots(a, lds, tstart); }
    SEAM(8); TS_END(8);
    TS_START(9);
    if (IN(9)) { moe_build_tab(a, tstart);
        DescGU d{(const char*)(ws + WS_H1B), (const char*)(ws + WS_WGU), (bf16_t*)(ws + WS_HH), (const int*)(ws + WS_ROUTE + RT_STOK), tstart, D, D}; gemm_run<4>(lds, d); }
    SEAM(9); TS_END(9);
    TS_START(10);
    if (IN(10)) { moe_build_tab(a, tstart);
        DescDown d{(const char*)(ws + WS_HH), (const char*)(ws + WS_WD), (bf16_t*)(ws + WS_YS), (const float*)(ws + WS_ROUTE + RT_SGATE), tstart, DE, DE}; gemm_run<5>(lds, d); }
    SEAM(10); TS_END(10);
    TS_START(11);
    if (IN(11)) { moe_build_tab(a, tstart); for (int rep = 0; rep < (11 == PROBE_PHASE ? PROBE_REP : 1); ++rep) p9_ln2(a, tstart, rep); }
    TS_END(11);
    if (PROBE_TS_A >= 0 && blockIdx.x == 0 && threadIdx.x == 0) { const unsigned long long dt = tsv[1] - tsv[0], te = __builtin_amdgcn_s_memrealtime(); while (__builtin_amdgcn_s_memrealtime() - te < 4ull * dt) __builtin_amdgcn_s_sleep(32); }
#undef IN
#undef SEAM
}

extern "C" void kernel_launch(void* const* d_in, const int* in_sizes, int n_in, void* d_out, int out_size, void* d_ws, size_t ws_size, hipStream_t stream) {
    static int grid = 0;
    if (grid == 0) {
        if (n_in != 26 || out_size != T * D || ws_size < WS_END) { fprintf(stderr, "kernel_launch: unexpected shapes (n_in %d out %d ws %zu)\n", n_in, out_size, ws_size); grid = -1; return; }
        int dev = 0, cus = 0, per_cu = 0;
        (void)hipGetDevice(&dev); (void)hipDeviceGetAttribute(&cus, hipDeviceAttributeMultiprocessorCount, dev);
        (void)hipFuncSetAttribute((const void*)fwd, hipFuncAttributeMaxDynamicSharedMemorySize, LDS_BYTES);
        (void)hipOccupancyMaxActiveBlocksPerMultiprocessor(&per_cu, (const void*)fwd, 512, LDS_BYTES);
        if (per_cu < 1) { fprintf(stderr, "kernel_launch: occupancy query says %d blocks/CU\n", per_cu); per_cu = 1; }
        grid = cus;
    }
    if (grid < 0) return;
    (void)hipMemsetAsync((char*)d_ws + WS_CTL, 0, CTL_ZERO_BYTES, stream);
    Args a{};
    for (int i = 0; i < 26; ++i) a.in[i] = (const float*)d_in[i];
    a.out = (float*)d_out; a.ws = (unsigned char*)d_ws;
#if N_LAUNCH_MODE == 0
    a.ph_lo = 0; a.ph_hi = NPHASE;
    void* args[] = {&a};
    hipError_t e = hipLaunchCooperativeKernel((const void*)fwd, dim3(grid), dim3(512), args, LDS_BYTES, stream);
    if (e != hipSuccess) fprintf(stderr, "cooperative launch failed: %s (grid %d)\n", hipGetErrorString(e), grid);
#else
    for (int p = 0; p < NPHASE; ++p) { a.ph_lo = p; a.ph_hi = p + 1; hipLaunchKernelGGL(fwd, dim3(grid), dim3(512), LDS_BYTES, stream, a); }
#endif
}
```

```cpp
#include <hip/hip_runtime.h>
#include <hip/hip_cooperative_groups.h>
#include <cstdio>
namespace cg = cooperative_groups;

#ifndef N_LAUNCH_MODE
#define N_LAUNCH_MODE 0
#endif
#ifndef PROBE_PHASE
#define PROBE_PHASE -1
#endif
#ifndef PROBE_REP
#define PROBE_REP 1
#endif
#ifndef PROBE_SYNC
#define PROBE_SYNC 0
#endif
#ifndef PROBE_TS_A
#define PROBE_TS_A -1
#endif
#ifndef PROBE_TS_B
#define PROBE_TS_B -1
#endif
#ifndef PROBE_NOSTORE
#define PROBE_NOSTORE 0
#endif
#ifndef PROBE_P0PART
#define PROBE_P0PART 0
#endif
#ifndef PROBE_GEMM
#define PROBE_GEMM -1
#endif
#ifndef NAIVE_MASK
#define NAIVE_MASK 0x00
#endif

typedef unsigned short bf16_t;
typedef short bf16x8 __attribute__((ext_vector_type(8)));
typedef float f32x4 __attribute__((ext_vector_type(4)));
typedef float f32x2 __attribute__((ext_vector_type(2)));
typedef unsigned u32x4 __attribute__((ext_vector_type(4)));
typedef unsigned u32x2 __attribute__((ext_vector_type(2)));
typedef int i32x8 __attribute__((ext_vector_type(8)));
typedef int i32x4 __attribute__((ext_vector_type(4)));

constexpr int T = 16384, D = 2048, S = 8192, NB = 2;
constexpr int DP = 1024, DS = 1024, NG = 64, GC = 16, NP = 64;
constexpr int NE = 32, DE = 512, NR = 36;
constexpr int MAXTILES = 161;
constexpr float LN_EPS = 1e-5f;
constexpr float ALPHA = 1.189207115002721f;
constexpr float WSCALE = 32.0f, WSCALE_INV = 1.0f / 32.0f;

constexpr size_t MB = 1u << 20;
constexpr size_t WS_CTL = 0;
constexpr size_t WS_BAR = 65536;
constexpr size_t CTL_ZERO_BYTES = 131072;
constexpr size_t WS_YS = 281 * MB;
constexpr size_t WS_H1B = 217 * MB;
constexpr size_t WS_V1B = 281 * MB;
constexpr size_t WS_ST = 484 * MB;
constexpr size_t WS_H1F8 = 89 * MB;
constexpr size_t WS_HH = 442 * MB;
constexpr size_t WS_SSMP = 1 * MB;
constexpr size_t WS_RW = 3 * MB;
constexpr size_t WS_ROUTE = 4 * MB;
constexpr size_t WS_WIN = 6 * MB;
constexpr size_t WS_WOUT = 14 * MB;
constexpr size_t WS_GLU = 22 * MB;
constexpr size_t WS_POOLW = 24 * MB;
constexpr size_t WS_WGU = 25 * MB;
constexpr size_t WS_WD = 153 * MB;
constexpr size_t WS_XB = 217 * MB;
constexpr size_t WS_PROJ = 281 * MB;
constexpr size_t WS_DPOOL = 409 * MB;
constexpr size_t WS_YSSM = 441 * MB;
constexpr size_t WS_A2 = 345 * MB;
constexpr size_t WS_W1T = 484 * MB;
constexpr size_t WS_W2T = 492 * MB;
constexpr size_t WS_END = 508 * MB;
constexpr size_t SSMP_A16 = 1536 * 1024;

constexpr size_t WS_GC = 5 * MB + 512 * 1024;
constexpr size_t RT_E = 0, RT_RANK = (size_t)T * 2 * 4, RT_GATE = (size_t)T * 4 * 4, RT_STOK = (size_t)T * 6 * 4, RT_SGATE = RT_STOK + (size_t)MAXTILES * 256 * 4;

constexpr int LDS_BYTES = 128 * 1024 + 4096;
constexpr int MISC_OFF = 128 * 1024;

struct Args { const float* in[26]; float* out; unsigned char* ws; int ph_lo, ph_hi; };

__device__ __forceinline__ float bf2f(bf16_t b) { return __uint_as_float(((unsigned)b) << 16); }
__device__ __forceinline__ float bflo(unsigned w) { return __uint_as_float(w << 16); }
__device__ __forceinline__ float bfhi(unsigned w) { return __uint_as_float(w & 0xffff0000u); }
__device__ __forceinline__ unsigned cvt_pk_bf16(float lo, float hi) { unsigned r; asm("v_cvt_pk_bf16_f32 %0, %1, %2" : "=v"(r) : "v"(lo), "v"(hi)); return r; }
__device__ __forceinline__ unsigned pk4_fp8(float a, float b, float c, float d) { unsigned w = 0; w = __builtin_amdgcn_cvt_pk_fp8_f32(a, b, w, false); w = __builtin_amdgcn_cvt_pk_fp8_f32(c, d, w, true); return w; }
__device__ __forceinline__ float wave_sum(float v) {
#pragma unroll
    for (int o = 32; o >= 1; o >>= 1) v += __shfl_xor(v, o);
    return v;
}
__device__ __forceinline__ float gelu_tanh(float x) {
    const float u = 0.7978845608028654f * (x + 0.044715f * x * x * x);
    const float e = __expf(-2.0f * fabsf(u));
    float t = (1.0f - e) / (1.0f + e); t = u < 0.f ? -t : t;
    return 0.5f * x * (1.0f + t);
}
__device__ __forceinline__ float sigmoidf_(float z) { return 1.0f / (1.0f + __expf(-z)); }

#define LAS __attribute__((address_space(3)))
#define XB_TMO      128
#define XB_XCNT(j)  (256  + 64 * (j))
#define XB_XSUB(j)  (1280 + 64 * (j))
#define XB_XGEN(j)  (2304 + 64 * (j))
#define XB_TOP      3328
#define XB_TOPGEN   3392
#define XCD_BAR_WORDS 3456
#define XB_SPIN_CAP (1u << 18)
__device__ __forceinline__ unsigned xb_ld(unsigned* p)              { return __hip_atomic_load(p, __ATOMIC_RELAXED, __HIP_MEMORY_SCOPE_AGENT); }
__device__ __forceinline__ unsigned xb_add(unsigned* p, unsigned v) { return __hip_atomic_fetch_add(p, v, __ATOMIC_RELAXED, __HIP_MEMORY_SCOPE_AGENT); }
__device__ __forceinline__ unsigned xb_xcc_id() { return (unsigned)__builtin_amdgcn_s_getreg((3 << 11) | 20) & 0xFu; }
#define XB_SPIN(cond, bar) do { unsigned _sp = 0; while (cond) { __builtin_amdgcn_s_sleep(1); \
    if ((++_sp & 255u) == 0u) { if (xb_ld(&(bar)[XB_TMO])) break; if (_sp > XB_SPIN_CAP) { atomicAdd(&(bar)[XB_TMO], 1u); break; } } } } while (0)
struct XcdBarrier { unsigned* bar; unsigned x; volatile LAS unsigned* st; };
__device__ __forceinline__ XcdBarrier xcd_barrier_post(unsigned* bar, volatile LAS unsigned* st) {
    XcdBarrier b; b.bar = bar; b.x = xb_xcc_id(); b.st = st;
    if (threadIdx.x == 0) (void)xb_add(&bar[XB_XCNT(b.x)], 1u);
    return b;
}
__device__ __forceinline__ void xcd_barrier_complete(unsigned* bar, unsigned x, unsigned& nloc, unsigned& nx) {
    const unsigned G = gridDim.x * gridDim.y * gridDim.z;
    unsigned sum, cnt, mine, sp = 0u;
    for (;;) {
        sum = 0u; cnt = 0u; mine = 0u;
#pragma unroll
        for (unsigned j = 0; j < 16; ++j) { const unsigned c = xb_ld(&bar[XB_XCNT(j)]); sum += c; cnt += (c > 0u) ? 1u : 0u; mine = (j == x) ? c : mine; }
        if (sum == G) break;
        __builtin_amdgcn_s_sleep(1);
        if ((++sp & 255u) == 0u) { if (xb_ld(&bar[XB_TMO])) break; if (sp > XB_SPIN_CAP) { atomicAdd(&bar[XB_TMO], 1u); break; } }
    }
    nloc = mine > 0u ? mine : 1u; nx = cnt > 0u ? cnt : 1u;
}
__device__ __forceinline__ void xcd_barrier(const XcdBarrier& b) {
    asm volatile("s_waitcnt vmcnt(0)" ::: "memory");
    __syncthreads();
    if (threadIdx.x == 0) {
        unsigned* bar = b.bar;
        __builtin_amdgcn_s_waitcnt(0);
        unsigned nloc = b.st[0], nx = b.st[1];
        if (nloc == 0u) { xcd_barrier_complete(bar, b.x, nloc, nx); b.st[0] = nloc; b.st[1] = nx; }
        const unsigned old = xb_add(&bar[XB_XSUB(b.x)], 1u);
        const unsigned gen = old / nloc;
        if (old + 1u == (gen + 1u) * nloc) {
            __builtin_amdgcn_fence(__ATOMIC_RELEASE, "agent");
            asm volatile("s_waitcnt vmcnt(0)" ::: "memory");
            const unsigned og = xb_add(&bar[XB_TOP], 1u);
            const unsigned tg = og / nx;
            if (og + 1u == (tg + 1u) * nx) xb_add(&bar[XB_TOPGEN], 1u);
            else XB_SPIN(xb_ld(&bar[XB_TOPGEN]) == tg, bar);
            __builtin_amdgcn_fence(__ATOMIC_ACQUIRE, "agent");
            xb_add(&bar[XB_XGEN(b.x)], 1u);
            asm volatile("s_waitcnt vmcnt(0)" ::: "memory");
        } else {
            XB_SPIN(xb_ld(&bar[XB_XGEN(b.x)]) == gen, bar);
            __builtin_amdgcn_fence(__ATOMIC_ACQUIRE, "agent");
            asm volatile("s_waitcnt vmcnt(0)" ::: "memory");
        }
    }
    __syncthreads();
}

struct Unit { int r0, c0, e, pad; };

template <class DS_>
__device__ void gemm_naive(const DS_& d) {
    const int tid = threadIdx.x, wid = tid >> 6, lane = tid & 63, wr = wid >> 2, wc = wid & 3, fr = lane & 15, fq = lane >> 4;
    const int K = d.K; const size_t ldb2 = (size_t)d.ldb * 2;
    for (int ui = blockIdx.x;; ui += gridDim.x) {
        Unit u; if (!d.get(ui, u)) break;
        f32x4 acc[2][2][4][2];
        const char* Bp = d.b_ptr(u);
#pragma unroll
        for (int ai = 0; ai < 2; ++ai)
#pragma unroll
            for (int m = 0; m < 4; ++m) {
                const int r = 128 * ai + 64 * wr + 16 * m + fr;
                const char* ap = d.A + d.a_off(u, r);
#pragma unroll
                for (int bj = 0; bj < 2; ++bj)
#pragma unroll
                    for (int n = 0; n < 2; ++n) {
                        const int c = 128 * bj + 32 * wc + 8 * fq + 4 * n;
                        const char* bp = Bp + (size_t)c * ldb2;
                        float s0 = 0.f, s1 = 0.f, s2 = 0.f, s3 = 0.f;
                        for (int k = 0; k < K; k += 8) {
                            const u32x4 av = *(const u32x4*)(ap + k * 2);
                            const u32x4 b0 = *(const u32x4*)(bp + k * 2), b1 = *(const u32x4*)(bp + ldb2 + k * 2), b2 = *(const u32x4*)(bp + 2 * ldb2 + k * 2), b3 = *(const u32x4*)(bp + 3 * ldb2 + k * 2);
#pragma unroll
                            for (int j = 0; j < 4; ++j) {
                                const float al = bflo(av[j]), ah = bfhi(av[j]);
                                s0 += al * bflo(b0[j]); s0 += ah * bfhi(b0[j]);
                                s1 += al * bflo(b1[j]); s1 += ah * bfhi(b1[j]);
                                s2 += al * bflo(b2[j]); s2 += ah * bfhi(b2[j]);
                                s3 += al * bflo(b3[j]); s3 += ah * bfhi(b3[j]);
                            }
                        }
                        acc[ai][bj][m][n] = (f32x4){s0, s1, s2, s3};
                    }
            }
        d.epi(acc, u, wr, wc, fr, fq);
    }
}

constexpr int BK = 64, HALF = 128, HTB = HALF * BK * 2;
__device__ __forceinline__ int lds_byte(int r, int c) { const int st = (r >> 4) * 2 + (c >> 5), rr = r & 15, cc = c & 31, ob = rr * 64 + cc * 2; return st * 1024 + (ob ^ (((ob >> 9) & 1) << 5)); }
__device__ __forceinline__ int perm32(int rho) { const int n = rho >> 4, i = rho & 15; return 8 * (i >> 2) + 4 * n + (i & 3); }
__device__ __forceinline__ void stage_rc(int b, int& R, int& C) { const int st = b / 1024, sb = b % 1024, swz = sb ^ (((sb >> 9) & 1) << 5); R = (st >> 1) * 16 + swz / 64; C = (st & 1) * 32 + (swz % 64) / 2; }

template <bool FP8, class DS_>
__device__ __forceinline__ void gemm_fast(LAS unsigned char* lds, const DS_& d) {
    const int tid = threadIdx.x, wid = __builtin_amdgcn_readfirstlane(tid >> 6), lane = tid & 63, wr = wid >> 2, wc = wid & 3, fr = lane & 15, fq = lane >> 4;
    const int K = d.K, nt = K / BK;
    int Rr[2], Cc[2]; unsigned voffB[2];
#pragma unroll
    for (int i = 0; i < 2; ++i) { stage_rc(tid * 16 + i * 8192, Rr[i], Cc[i]); const int Rb = (Rr[i] & ~31) + perm32(Rr[i] & 31); voffB[i] = (unsigned)(Rb * d.ldb + Cc[i]) * 2u; }
    const size_t kstep = (size_t)(BK * 2);
    const size_t hstepB = (size_t)HALF * d.ldb * 2;
    const unsigned ldsw = (unsigned)wid * 1024u;
    const int aoff = lds_byte(wr * 64 + fr, fq * 8), boff = lds_byte(wc * 32 + fr, fq * 8);
#define G_SA(b, h) (((b) * 2 + (h)) * HTB)
#define G_SB(b, h) ((4 + (b) * 2 + (h)) * HTB)
#define G_STAGE(bufoff, gbase, voff) do { _Pragma("unroll") for (int _i = 0; _i < 2; ++_i) \
        __builtin_amdgcn_global_load_lds((const unsigned*)((const char*)(gbase) + (voff)[_i]), (LAS unsigned*)(lds + (bufoff) + ldsw + _i * 8192), 16, 0, 0); } while (0)
#define G_LDA(dst, b, h) do { _Pragma("unroll") for (int m = 0; m < 4; ++m) { const i32x4 l0_ = *(const LAS i32x4*)(lds + G_SA(b, h) + aoff + m * 2048), l1_ = *(const LAS i32x4*)(lds + G_SA(b, h) + aoff + m * 2048 + 1024); \
        dst[m] = __builtin_shufflevector(l0_, l1_, 0, 1, 2, 3, 4, 5, 6, 7); } } while (0)
#define G_LDB(dst, b, h) do { _Pragma("unroll") for (int n = 0; n < 2; ++n) { const i32x4 l0_ = *(const LAS i32x4*)(lds + G_SB(b, h) + boff + n * 2048), l1_ = *(const LAS i32x4*)(lds + G_SB(b, h) + boff + n * 2048 + 1024); \
        dst[n] = __builtin_shufflevector(l0_, l1_, 0, 1, 2, 3, 4, 5, 6, 7); } } while (0)
#define G_MMA(ai, bj, At, Bt) do { __builtin_amdgcn_s_setprio(1); _Pragma("unroll") for (int m = 0; m < 4; ++m) _Pragma("unroll") for (int n = 0; n < 2; ++n) { \
        if constexpr (FP8) asm volatile("v_mfma_f32_16x16x128_f8f6f4 %0, %1, %2, %0" : "+v"(acc[ai][bj][m][n]) : "v"(Bt[n]), "v"(At[m])); \
        else { acc[ai][bj][m][n] = __builtin_amdgcn_mfma_f32_16x16x32_bf16(__builtin_bit_cast(bf16x8, __builtin_shufflevector(Bt[n], Bt[n], 0, 1, 2, 3)), __builtin_bit_cast(bf16x8, __builtin_shufflevector(At[m], At[m], 0, 1, 2, 3)), acc[ai][bj][m][n], 0, 0, 0); \
               acc[ai][bj][m][n] = __builtin_amdgcn_mfma_f32_16x16x32_bf16(__builtin_bit_cast(bf16x8, __builtin_shufflevector(Bt[n], Bt[n], 4, 5, 6, 7)), __builtin_bit_cast(bf16x8, __builtin_shufflevector(At[m], At[m], 4, 5, 6, 7)), acc[ai][bj][m][n], 0, 0, 0); } } \
        __builtin_amdgcn_s_setprio(0); } while (0)
#define G_WAIT_V(n) asm volatile("s_waitcnt vmcnt(" #n ")" ::: "memory")
#define G_WAIT_L(n) asm volatile("s_waitcnt lgkmcnt(" #n ")" ::: "memory")
#define G_BAR __builtin_amdgcn_s_barrier()
#define G_SCHED __builtin_amdgcn_sched_barrier(0)
    Unit cur, nxt; int ui = blockIdx.x;
    if (!d.get(ui, cur)) return;
    f32x4 acc[2][2][4][2];
#pragma unroll
    for (int a_ = 0; a_ < 2; ++a_)
#pragma unroll
        for (int b_ = 0; b_ < 2; ++b_)
#pragma unroll
            for (int m = 0; m < 4; ++m)
#pragma unroll
                for (int n = 0; n < 2; ++n) acc[a_][b_][m][n] = (f32x4){0.f, 0.f, 0.f, 0.f};
    i32x8 At[4], B0[2], B1[2];
    unsigned vA[2][2], nvA[2][2];
#pragma unroll
    for (int h = 0; h < 2; ++h)
#pragma unroll
        for (int i = 0; i < 2; ++i) vA[h][i] = d.a_off(cur, h * HALF + Rr[i]) + (unsigned)Cc[i] * 2u;
    const char* const Ab = d.A;
    const char* cB = d.b_ptr(cur);
    G_STAGE(G_SB(0, 0), cB, voffB); G_STAGE(G_SA(0, 0), Ab, vA[0]); G_STAGE(G_SB(0, 1), cB + hstepB, voffB); G_STAGE(G_SA(0, 1), Ab, vA[1]);
    if (wr == 1) G_BAR;
    G_WAIT_V(4); G_BAR;
    G_STAGE(G_SB(1, 0), cB + kstep, voffB); G_STAGE(G_SA(1, 0), Ab + kstep, vA[0]); G_STAGE(G_SB(1, 1), cB + hstepB + kstep, voffB);
    G_WAIT_V(6); G_BAR;
    for (;;) {
        const bool has_next = d.get(ui + (int)gridDim.x, nxt);
        const char* nB = has_next ? d.b_ptr(nxt) : cB;
#pragma unroll
        for (int h = 0; h < 2; ++h)
#pragma unroll
            for (int i = 0; i < 2; ++i) nvA[h][i] = has_next ? (d.a_off(nxt, h * HALF + Rr[i]) + (unsigned)Cc[i] * 2u) : vA[h][i];
        for (int t = 0; t < nt; t += 2) {
            const bool last = (t == nt - 2);
            const char* a1 = Ab + (size_t)(t + 1) * kstep;
            const char* a2 = last ? Ab : Ab + (size_t)(t + 2) * kstep; const char* b2 = last ? nB : cB + (size_t)(t + 2) * kstep;
            const char* a3 = a2 + kstep; const char* b3 = b2 + kstep;
            unsigned va2[2][2];
#pragma unroll
            for (int h = 0; h < 2; ++h)
#pragma unroll
                for (int i = 0; i < 2; ++i) va2[h][i] = last ? nvA[h][i] : vA[h][i];
            G_LDB(B0, 0, 0); G_SCHED; G_LDA(At, 0, 0); G_STAGE(G_SA(1, 1), a1, vA[1]);
            G_WAIT_L(8); G_BAR; G_WAIT_L(0); G_MMA(0, 0, At, B0); G_BAR; G_SCHED;
            G_LDB(B1, 0, 1); G_STAGE(G_SB(0, 0), b2, voffB);
            G_BAR; G_WAIT_L(0); G_MMA(0, 1, At, B1); G_BAR;
            G_LDA(At, 0, 1); G_STAGE(G_SA(0, 0), a2, va2[0]);
            G_BAR; G_WAIT_L(0); G_MMA(1, 0, At, B0); G_BAR; G_SCHED;
            G_STAGE(G_SB(0, 1), b2 + hstepB, voffB);
            G_WAIT_V(6); G_BAR; G_MMA(1, 1, At, B1); G_BAR;
            G_LDB(B0, 1, 0); G_SCHED; G_LDA(At, 1, 0); G_STAGE(G_SA(0, 1), a2, va2[1]);
            G_WAIT_L(8); G_BAR; G_WAIT_L(0); G_MMA(0, 0, At, B0); G_BAR; G_SCHED;
            G_LDB(B1, 1, 1); G_STAGE(G_SB(1, 0), b3, voffB);
            G_BAR; G_WAIT_L(0); G_MMA(0, 1, At, B1); G_BAR;
            G_LDA(At, 1, 1); G_STAGE(G_SA(1, 0), a3, va2[0]);
            G_BAR; G_WAIT_L(0); G_MMA(1, 0, At, B0); G_BAR; G_SCHED;
            G_STAGE(G_SB(1, 1), b3 + hstepB, voffB);
            G_WAIT_V(6); G_BAR; G_MMA(1, 1, At, B1); G_BAR;
        }
        d.epi(acc, cur, wr, wc, fr, fq);
        if (!has_next) break;
#pragma unroll
        for (int a_ = 0; a_ < 2; ++a_)
#pragma unroll
            for (int b_ = 0; b_ < 2; ++b_)
#pragma unroll
                for (int m = 0; m < 4; ++m)
#pragma unroll
                    for (int n = 0; n < 2; ++n) acc[a_][b_][m][n] = (f32x4){0.f, 0.f, 0.f, 0.f};
        cur = nxt; cB = nB; ui += (int)gridDim.x;
#pragma unroll
        for (int h = 0; h < 2; ++h)
#pragma unroll
            for (int i = 0; i < 2; ++i) vA[h][i] = nvA[h][i];
    }
    G_WAIT_V(0);
    if (wr == 0) G_BAR;
    G_BAR;
#undef G_SA
#undef G_SB
#undef G_STAGE
#undef G_LDA
#undef G_LDB
#undef G_MMA
#undef G_WAIT_V
#undef G_WAIT_L
#undef G_BAR
#undef G_SCHED
}
template <int BIT, class DS_>
__device__ __forceinline__ void gemm_run(unsigned char* lds, const DS_& d) {
    if constexpr ((NAIVE_MASK >> BIT) & 1) gemm_naive(d); else gemm_fast<DS_::FP8>((LAS unsigned char*)lds, d);
}

__device__ __forceinline__ bool static_order(int L, int nM, int nN, int& pm, int& pn) {
    const int nwg = nM * nN; if (L >= nwg) return false;
    int wgid = L; { const int q = nwg / 8, r = nwg % 8, xcd = wgid % 8, off = wgid / 8; wgid = (xcd < r ? xcd * (q + 1) : r * (q + 1) + (xcd - r) * q) + off; }
    const int nig = 8 * nN, gid = wgid / nig, fm = gid * 8, gsz = (nM - fm) < 8 ? (nM - fm) : 8;
    pm = fm + ((wgid % nig) % gsz); pn = (wgid % nig) / gsz; return true;
}

#define EPI_LOOP_BEGIN _Pragma("unroll") for (int ai = 0; ai < 2; ++ai) _Pragma("unroll") for (int m = 0; m < 4; ++m) { const int lr = 128 * ai + 64 * wr + 16 * m + fr; \
    _Pragma("unroll") for (int bj = 0; bj < 2; ++bj) { const int lc = 128 * bj + 32 * wc + 8 * fq; const f32x4 v0 = acc[ai][bj][m][0], v1 = acc[ai][bj][m][1];
#define EPI_LOOP_END } }
__device__ __forceinline__ u32x4 pack8(const f32x4 a, const f32x4 b) { u32x4 w; w.x = cvt_pk_bf16(a[0], a[1]); w.y = cvt_pk_bf16(a[2], a[3]); w.z = cvt_pk_bf16(b[0], b[1]); w.w = cvt_pk_bf16(b[2], b[3]); return w; }

struct DescProj {
    static constexpr bool FP8 = false;
    const char* A; const char* Bt; bf16_t* O; bf16_t* A2; int K, ldb;
    __device__ bool get(int i, Unit& u) const { int pm, pn; if (i >= 512 * ((0) == PROBE_GEMM ? PROBE_REP : 1)) return false; i %= 512; if (!static_order(i, T / 256, D / 256, pm, pn)) return false; u.r0 = pm * 256; u.c0 = pn * 256; u.e = 0; u.pad = 0; return true; }
    __device__ unsigned a_off(const Unit& u, int r) const { return (unsigned)(u.r0 + r) * (unsigned)(D * 2); }
    __device__ const char* b_ptr(const Unit& u) const { return Bt + (size_t)u.c0 * D * 2; }
    __device__ void epi(const f32x4 (&acc)[2][2][4][2], const Unit& u, int wr, int wc, int fr, int fq) const {
        EPI_LOOP_BEGIN
            const u32x4 w = pack8(v0, v1);
            const int t = u.r0 + lr, nn = u.c0 + lc;
            if (u.c0 < DP) *(u32x4*)(O + (size_t)t * D + nn) = w;
            else { const int g = (nn - DP) >> 4, co = (nn - DP) & 15; *(u32x4*)(A2 + ((size_t)(g * 1024 + (t >> 4))) * 512 + (t & 15) * 16 + co) = w; }
        EPI_LOOP_END
    }
};
struct DescS1 {
    static constexpr bool FP8 = false;
    const char* A; const char* Bt; float* O; int K, ldb;
    __device__ bool get(int i, Unit& u) const { if (i >= 256 * ((6) == PROBE_GEMM ? PROBE_REP : 1)) return false; i &= 255; u.e = i >> 2; u.r0 = (i & 3) * 256; u.c0 = 0; u.pad = 0; return true; }
    __device__ unsigned a_off(const Unit& u, int r) const { return (unsigned)(u.e * 1024 + u.r0 + r) * 1024u; }
    __device__ const char* b_ptr(const Unit& u) const { return Bt + (size_t)u.e * 256 * 256 * 2; }
    __device__ void epi(const f32x4 (&acc)[2][2][4][2], const Unit& u, int wr, int wc, int fr, int fq) const {
        EPI_LOOP_BEGIN
            float* p = O + ((size_t)(u.e * 1024 + u.r0 + lr)) * 256 + lc; *(f32x4*)p = v0; *(f32x4*)(p + 4) = v1;
        EPI_LOOP_END
    }
};
struct DescS2 {
    static constexpr bool FP8 = false;
    const char* A; const char* Bt; bf16_t* O; int K, ldb;
    __device__ bool get(int i, Unit& u) const { if (i >= 256 * ((7) == PROBE_GEMM ? PROBE_REP : 1)) return false; i &= 255; u.e = i >> 2; u.r0 = (i & 3) * 256; u.c0 = 0; u.pad = 0; return true; }
    __device__ unsigned a_off(const Unit& u, int r) const { return (unsigned)(u.e * 1024 + u.r0 + r) * 1024u; }
    __device__ const char* b_ptr(const Unit& u) const { return Bt + (size_t)u.e * 256 * 512 * 2; }
    __device__ void epi(const f32x4 (&acc)[2][2][4][2], const Unit& u, int wr, int wc, int fr, int fq) const {
        EPI_LOOP_BEGIN
            const int t = (u.r0 + lr) * 16 + (lc >> 4), co = lc & 15;
            const f32x4 g0 = (f32x4){gelu_tanh(v0[0]), gelu_tanh(v0[1]), gelu_tanh(v0[2]), gelu_tanh(v0[3])}, g1 = (f32x4){gelu_tanh(v1[0]), gelu_tanh(v1[1]), gelu_tanh(v1[2]), gelu_tanh(v1[3])};
            *(u32x4*)(O + (size_t)t * DS + u.e * 16 + co) = pack8(g0, g1);
        EPI_LOOP_END
    }
};
struct DescPool {
    static constexpr bool FP8 = false;
    const char* A; const char* Bt; bf16_t* O; const float* scale; int K, ldb;
    __device__ bool get(int i, Unit& u) const { if (i >= 256 * ((1) == PROBE_GEMM ? PROBE_REP : 1)) return false; i &= 255; u.e = i & 3; u.r0 = (i >> 2) * 256; u.c0 = u.e * 256; u.pad = 0; return true; }
    __device__ unsigned a_off(const Unit& u, int r) const { return ((unsigned)(u.r0 + r) * (unsigned)DP + (unsigned)u.e * 256u) * 2u; }
    __device__ const char* b_ptr(const Unit& u) const { return Bt + (size_t)u.e * 256 * 256 * 2; }
    __device__ void epi(const f32x4 (&acc)[2][2][4][2], const Unit& u, int wr, int wc, int fr, int fq) const {
        f32x4 scv[2][2];
#pragma unroll
        for (int bj = 0; bj < 2; ++bj)
#pragma unroll
            for (int n = 0; n < 2; ++n) scv[bj][n] = *(const f32x4*)(scale + u.c0 + 128 * bj + 32 * wc + 8 * fq + 4 * n);
        EPI_LOOP_BEGIN
            *(u32x4*)(O + (size_t)(u.r0 + lr) * D + u.c0 + lc) = pack8(v0 * scv[bj][0], v1 * scv[bj][1]);
        EPI_LOOP_END
    }
};
struct DescGlu {
    static constexpr bool FP8 = false;
    const char* A; const char* Bt; bf16_t* O; const float* bias; int K, ldb;
    __device__ bool get(int i, Unit& u) const { int pm, pn; if (i >= 256 * ((2) == PROBE_GEMM ? PROBE_REP : 1)) return false; i %= 256; if (!static_order(i, T / 256, DS / 256, pm, pn)) return false; u.r0 = pm * 256; u.c0 = pn * 256; u.e = 0; u.pad = 0; return true; }
    __device__ unsigned a_off(const Unit& u, int r) const { return (unsigned)(u.r0 + r) * (unsigned)(DS * 2); }
    __device__ const char* b_ptr(const Unit& u) const { return Bt + (size_t)u.c0 * DS * 2; }
    __device__ void epi(const f32x4 (&acc)[2][2][4][2], const Unit& u, int wr, int wc, int fr, int fq) const {
        f32x4 bvv[2][2];
#pragma unroll
        for (int bj = 0; bj < 2; ++bj)
#pragma unroll
            for (int n = 0; n < 2; ++n) bvv[bj][n] = *(const f32x4*)(bias + u.c0 + 128 * bj + 32 * wc + 8 * fq + 4 * n);
        const char* __restrict__ Yp = A + ((size_t)(u.r0 + 64 * wr + fr) * DS + u.c0 + 32 * wc + 8 * fq) * 2;
        u32x4 yq[4][2];
#pragma unroll
        for (int p = 0; p < 4; ++p)
#pragma unroll
            for (int q = 0; q < 2; ++q) yq[p][q] = *(const u32x4*)(Yp + ((size_t)(128 * (p >> 2) + 16 * (p & 3)) * DS) * 2 + q * 256);
#pragma unroll
        for (int rg = 0; rg < 8; ++rg) { const int ai = rg >> 2, m = rg & 3; const int lr = 128 * ai + 64 * wr + 16 * m + fr;
            u32x4 yc[2]; yc[0] = yq[rg & 3][0]; yc[1] = yq[rg & 3][1];
            if (rg < 4) { const int r2 = rg + 4;
#pragma unroll
                for (int q = 0; q < 2; ++q) yq[rg & 3][q] = *(const u32x4*)(Yp + ((size_t)(128 * (r2 >> 2) + 16 * (r2 & 3)) * DS) * 2 + q * 256); }
#pragma unroll
            for (int bj = 0; bj < 2; ++bj) { const int lc = 128 * bj + 32 * wc + 8 * fq; const f32x4 v0 = acc[ai][bj][m][0] + bvv[bj][0], v1 = acc[ai][bj][m][1] + bvv[bj][1]; const u32x4 yw = yc[bj];
                const f32x4 o0 = (f32x4){bflo(yw.x) * sigmoidf_(v0[0]), bfhi(yw.x) * sigmoidf_(v0[1]), bflo(yw.y) * sigmoidf_(v0[2]), bfhi(yw.y) * sigmoidf_(v0[3])};
                const f32x4 o1 = (f32x4){bflo(yw.z) * sigmoidf_(v1[0]), bfhi(yw.z) * sigmoidf_(v1[1]), bflo(yw.w) * sigmoidf_(v1[2]), bfhi(yw.w) * sigmoidf_(v1[3])};
                *(u32x4*)(O + (size_t)(u.r0 + lr) * D + DP + u.c0 + lc) = pack8(o0, o1); } }
    }
};
struct DescOut {
    static constexpr bool FP8 = false;
    const char* A; const char* Bt; bf16_t* O; const float* X; float* ST; int K, ldb;
    __device__ bool get(int i, Unit& u) const { int pm, pn; if (i >= 512 * ((3) == PROBE_GEMM ? PROBE_REP : 1)) return false; i %= 512; if (!static_order(i, T / 256, D / 256, pm, pn)) return false; u.r0 = pm * 256; u.c0 = pn * 256; u.e = 0; u.pad = 0; return true; }
    __device__ unsigned a_off(const Unit& u, int r) const { return (unsigned)(u.r0 + r) * (unsigned)(D * 2); }
    __device__ const char* b_ptr(const Unit& u) const { return Bt + (size_t)u.c0 * D * 2; }
    __device__ void epi(const f32x4 (&acc)[2][2][4][2], const Unit& u, int wr, int wc, int fr, int fq) const {
        const float* __restrict__ Xp = X + (size_t)(u.r0 + 64 * wr + fr) * D + u.c0 + 32 * wc + 8 * fq;
        f32x4 xq[3][4];
#pragma unroll
        for (int p = 0; p < 3; ++p)
#pragma unroll
            for (int q = 0; q < 4; ++q) xq[p][q] = *(const f32x4*)(Xp + (size_t)(128 * (p >> 2) + 16 * (p & 3)) * D + (q >> 1) * 128 + (q & 1) * 4);
#pragma unroll
        for (int rg = 0; rg < 8; ++rg) { const int ai = rg >> 2, m = rg & 3; const int lr = 128 * ai + 64 * wr + 16 * m + fr; float s = 0.f, ss = 0.f;
            f32x4 xc[4];
#pragma unroll
            for (int q = 0; q < 4; ++q) xc[q] = xq[rg % 3][q];
            if (rg < 5) { const int r2 = rg + 3;
#pragma unroll
                for (int q = 0; q < 4; ++q) xq[rg % 3][q] = *(const f32x4*)(Xp + (size_t)(128 * (r2 >> 2) + 16 * (r2 & 3)) * D + (q >> 1) * 128 + (q & 1) * 4); }
#pragma unroll
            for (int bj = 0; bj < 2; ++bj) { const int lc = 128 * bj + 32 * wc + 8 * fq; const size_t o = (size_t)(u.r0 + lr) * D + u.c0 + lc;
                const f32x4 v0 = xc[bj * 2] * ALPHA + acc[ai][bj][m][0], v1 = xc[bj * 2 + 1] * ALPHA + acc[ai][bj][m][1];
                s += ((v0[0] + v0[1]) + (v0[2] + v0[3])) + ((v1[0] + v1[1]) + (v1[2] + v1[3]));
                ss += ((v0[0] * v0[0] + v0[1] * v0[1]) + (v0[2] * v0[2] + v0[3] * v0[3])) + ((v1[0] * v1[0] + v1[1] * v1[1]) + (v1[2] * v1[2] + v1[3] * v1[3]));
                *(u32x4*)(O + o) = pack8(v0, v1); }
            s += __shfl_xor(s, 16); s += __shfl_xor(s, 32); ss += __shfl_xor(ss, 16); ss += __shfl_xor(ss, 32);
            if (fq == 0) *(f32x2*)(ST + ((size_t)(u.r0 + lr) * 32 + (u.c0 >> 8) * 4 + wc) * 2) = (f32x2){s, ss}; }
    }
};
struct MoeTab { const int* tstart; };
__device__ __forceinline__ int moe_expert_of_tile(const int* tstart, int tile) { int e = 0;
#pragma unroll 1
    for (int j = 1; j < NE; ++j) e += (tile >= tstart[j]) ? 1 : 0;
    return e; }
__device__ __forceinline__ bool moe_order(int nt, int npn, int i, int& tile, int& pn) {
    const int G = (int)gridDim.x, r = i / G, b = i - r * G, per = G >> 3, x = b & 7, j = b >> 3;
    const int lo = (x * nt) >> 3, hi = ((x + 1) * nt) >> 3, u = j + per * r;
    if (j >= per || u >= (hi - lo) * npn) return false;
    tile = lo + u / npn; pn = u - (u / npn) * npn; return true;
}
struct DescGU {
    static constexpr bool FP8 = true;
    const char* A; const char* Bt; bf16_t* O; const int* slot_tok; const int* tstart; int K, ldb;
    __device__ bool get(int i, Unit& u) const { int tile, pn; if (!moe_order(tstart[NE], 4, i, tile, pn)) return false; u.r0 = tile * 256; u.c0 = pn * 256; u.e = moe_expert_of_tile(tstart, tile); u.pad = 0; return true; }
    __device__ unsigned a_off(const Unit& u, int r) const { int t = slot_tok[u.r0 + r]; t = t < 0 ? 0 : t; return (unsigned)t * (unsigned)D; }
    __device__ const char* b_ptr(const Unit& u) const { return Bt + ((size_t)u.e * 1024 + u.c0) * D; }
    __device__ void epi(const f32x4 (&acc)[2][2][4][2], const Unit& u, int wr, int wc, int fr, int fq) const {
#pragma unroll
        for (int ai = 0; ai < 2; ++ai)
#pragma unroll
            for (int m = 0; m < 4; ++m) { const int lr = 128 * ai + 64 * wr + 16 * m + fr; f32x4 h[2];
#pragma unroll
                for (int n = 0; n < 2; ++n) { const f32x4 g = acc[ai][0][m][n] * WSCALE_INV, up = acc[ai][1][m][n] * WSCALE_INV;
#pragma unroll
                    for (int j = 0; j < 4; ++j) h[n][j] = g[j] * sigmoidf_(g[j]) * up[j]; }
                u32x2 w; w.x = pk4_fp8(h[0][0], h[0][1], h[0][2], h[0][3]); w.y = pk4_fp8(h[1][0], h[1][1], h[1][2], h[1][3]);
                *(u32x2*)((unsigned char*)O + (size_t)(u.r0 + lr) * DE + (u.c0 >> 1) + 32 * wc + 8 * fq) = w; }
    }
};
struct DescDown {
    static constexpr bool FP8 = true;
    const char* A; const char* Bt; bf16_t* O; const float* slot_gate; const int* tstart; int K, ldb;
    __device__ bool get(int i, Unit& u) const { int tile, pn; const int G_ = (int)gridDim.x; const int rr_ = i / G_; const int reps_ = ((5) == PROBE_GEMM ? PROBE_REP : 1); int rep_ = 0, ii_ = i; if (reps_ > 1) { rep_ = rr_ % reps_; ii_ = (rr_ / reps_) * G_ + (i - rr_ * G_); } if (!moe_order(tstart[NE], 8, ii_, tile, pn)) return false; u.r0 = tile * 256; u.c0 = pn * 256; u.pad = rep_; u.e = moe_expert_of_tile(tstart, tile); return true; }
    __device__ unsigned a_off(const Unit& u, int r) const { return (unsigned)(u.r0 + r) * (unsigned)DE; }
    __device__ const char* b_ptr(const Unit& u) const { return Bt + ((size_t)u.e * D + u.c0) * DE; }
    __device__ void epi(const f32x4 (&acc)[2][2][4][2], const Unit& u, int wr, int wc, int fr, int fq) const {
        float gts[8];
#pragma unroll
        for (int rg = 0; rg < 8; ++rg) gts[rg] = slot_gate[u.r0 + 128 * (rg >> 2) + 64 * wr + 16 * (rg & 3) + fr];
#pragma unroll
        for (int ai = 0; ai < 2; ++ai)
#pragma unroll
            for (int m = 0; m < 4; ++m) { const int lr = 128 * ai + 64 * wr + 16 * m + fr; const float gt = gts[ai * 4 + m] * WSCALE_INV;
#pragma unroll
                for (int bj = 0; bj < 2; ++bj) { const int lc = 128 * bj + 32 * wc + 8 * fq;
                    if (!(PROBE_NOSTORE && u.pad > 0)) *(u32x4*)(O + (size_t)(u.r0 + lr) * D + u.c0 + lc) = pack8(acc[ai][bj][m][0] * gt, acc[ai][bj][m][1] * gt); } }
    }
};

__device__ __forceinline__ void tr_job(const Args& a, int j, const float*& src, int& lds_, unsigned char*& dst, int& ldd, int& f8) {
    unsigned char* ws = a.ws;
    if (j < 1024) { const int kt = j >> 5, nt = j & 31; src = a.in[1] + (size_t)kt * 64 * D + nt * 64; lds_ = D; dst = ws + WS_WIN + ((size_t)nt * 64 * D + kt * 64) * 2; ldd = D * 2; f8 = 0; return; }
    j -= 1024;
    if (j < 1024) { const int kt = j >> 5, nt = j & 31; src = a.in[14] + (size_t)kt * 64 * D + nt * 64; lds_ = D; dst = ws + WS_WOUT + ((size_t)nt * 64 * D + kt * 64) * 2; ldd = D * 2; f8 = 0; return; }
    j -= 1024;
    if (j < 256) { const int kt = j >> 4, nt = j & 15; src = a.in[12] + (size_t)kt * 64 * DS + nt * 64; lds_ = DS; dst = ws + WS_GLU + ((size_t)nt * 64 * DS + kt * 64) * 2; ldd = DS * 2; f8 = 0; return; }
    j -= 256;
    if (j < 64) { const int g = j >> 4, r = j & 15, kt = r >> 2, nt = r & 3; src = a.in[2] + (size_t)g * 65536 + kt * 64 * 256 + nt * 64; lds_ = 256; dst = ws + WS_POOLW + ((size_t)g * 65536 + nt * 64 * 256 + kt * 64) * 2; ldd = 512; f8 = 0; return; }
    j -= 64;
    if (j < 16384) { const int up = j >= 8192; if (up) j -= 8192; const int e = j >> 8, r = j & 255, kt = r >> 3, nt = r & 7, n0 = nt * 64;
        src = (up ? a.in[22] : a.in[21]) + (size_t)e * D * DE + (size_t)kt * 64 * DE + n0; lds_ = DE;
        const int drow = (n0 >> 7) * 256 + (n0 & 127) + (up ? 128 : 0);
        dst = ws + WS_WGU + ((size_t)e * 1024 + drow) * D + kt * 64; ldd = D; f8 = 1; return; }
    j -= 16384;
    { const int e = j >> 8, r = j & 255, kt = r >> 5, nt = r & 31; src = a.in[23] + (size_t)e * DE * D + (size_t)kt * 64 * D + nt * 64; lds_ = D;
      dst = ws + WS_WD + ((size_t)e * D + nt * 64) * DE + kt * 64; ldd = DE; f8 = 1; }
}
constexpr int TR_JOBS = 1024 + 1024 + 256 + 64 + 16384 + 8192;

__device__ void p0_prepass(const Args& a, unsigned char* lds, int rep) {
    const int tid = threadIdx.x, G = gridDim.x, bid = blockIdx.x;
    unsigned char* ws = a.ws;
    if (rep == 0 || PROBE_P0PART == 1) {
        const f32x4* x4 = (const f32x4*)a.in[0]; u32x4* xb = (u32x4*)(ws + WS_XB);
        const size_t n8 = (size_t)T * D / 8, stride = (size_t)G * 512;
        for (size_t i = (size_t)bid * 512 + tid; i < n8; i += 4 * stride) {
            f32x4 v[8];
#pragma unroll
            for (int q = 0; q < 4; ++q) { const size_t ii = i + q * stride; if (ii < n8) { v[2 * q] = x4[2 * ii]; v[2 * q + 1] = x4[2 * ii + 1]; } }
#pragma unroll
            for (int q = 0; q < 4; ++q) { const size_t ii = i + q * stride; if (ii < n8) { u32x4 o; o.x = cvt_pk_bf16(v[2 * q][0], v[2 * q][1]); o.y = cvt_pk_bf16(v[2 * q][2], v[2 * q][3]);
                o.z = cvt_pk_bf16(v[2 * q + 1][0], v[2 * q + 1][1]); o.w = cvt_pk_bf16(v[2 * q + 1][2], v[2 * q + 1][3]); xb[ii] = o; } }
        }
    }
    if (rep == 0 || PROBE_P0PART == 2) {
        bf16_t* tl = (bf16_t*)lds;
        const int lr = tid >> 4, lc4 = (tid & 15) * 4;
        const int on = tid >> 3, okg = (tid & 7) * 8;
        constexpr int NGRP = TR_JOBS / 8;
        int g_lo, g_hi, g_x = -1;
        if (G == 256) { constexpr int S1 = 11, S2 = 15, REM0 = 128 * S1 + 128 * S2;
            if (bid >= 128) { g_lo = (bid - 128) * S2; g_hi = g_lo + S2; if (REM0 + (bid - 128) < NGRP) g_x = REM0 + (bid - 128); }
            else { g_lo = 128 * S2 + bid * S1; g_hi = g_lo + S1; } }
        else { const int per = (NGRP + G - 1) / G; g_lo = bid * per; g_hi = g_lo + per; if (g_hi > NGRP) g_hi = NGRP; if (g_lo > NGRP) g_lo = NGRP; }
        for (int gi = g_lo; gi <= g_hi; ++gi) {
            int jg; if (gi < g_hi) jg = gi * 8; else { if (g_x < 0) break; jg = g_x * 8; }
            f32x4 v[8][2]; unsigned char* dst[8]; int ldd[8]; int f8[8];
#pragma unroll
            for (int q = 0; q < 8; ++q) { const float* src; int ls; tr_job(a, jg + q, src, ls, dst[q], ldd[q], f8[q]);
                v[q][0] = *(const f32x4*)(src + (size_t)lr * ls + lc4); v[q][1] = *(const f32x4*)(src + (size_t)(lr + 32) * ls + lc4); }
            __syncthreads();
#pragma unroll
            for (int q = 0; q < 8; ++q) { unsigned* t0 = (unsigned*)(tl + q * 64 * 66);
                t0[(lr * 66 + lc4) >> 1] = cvt_pk_bf16(v[q][0][0], v[q][0][1]); t0[((lr * 66 + lc4) >> 1) + 1] = cvt_pk_bf16(v[q][0][2], v[q][0][3]);
                t0[((lr + 32) * 66 + lc4) >> 1] = cvt_pk_bf16(v[q][1][0], v[q][1][1]); t0[(((lr + 32) * 66 + lc4) >> 1) + 1] = cvt_pk_bf16(v[q][1][2], v[q][1][3]); }
            __syncthreads();
#pragma unroll
            for (int q = 0; q < 8; ++q) { const bf16_t* t0 = tl + q * 64 * 66; unsigned f[8];
#pragma unroll
                for (int e = 0; e < 8; ++e) f[e] = t0[(okg + e) * 66 + on];
                if (f8[q]) { u32x2 o; o.x = pk4_fp8(WSCALE * bflo(f[0]), WSCALE * bflo(f[1]), WSCALE * bflo(f[2]), WSCALE * bflo(f[3])); o.y = pk4_fp8(WSCALE * bflo(f[4]), WSCALE * bflo(f[5]), WSCALE * bflo(f[6]), WSCALE * bflo(f[7]));
                    *(u32x2*)(dst[q] + (size_t)on * ldd[q] + okg) = o; }
                else { u32x4 o; o.x = f[0] | (f[1] << 16); o.y = f[2] | (f[3] << 16); o.z = f[4] | (f[5] << 16); o.w = f[6] | (f[7] << 16);
                    *(u32x4*)(dst[q] + (size_t)on * ldd[q] + okg * 2) = o; } }
        }
        __syncthreads();
    }
    if (rep == 0 || PROBE_P0PART == 3)
    {
        f32x2* pw = (f32x2*)lds;
        f32x2* Bb = (f32x2*)(lds + 17408);
        f32x2* Cc = (f32x2*)(lds + 17408 + 16384);
        float* KT = (float*)(lds + 17408 + 16384 + 16640);
        for (int job = bid; job < 2 * NG; job += G) {
            const int g = job >> 1, half = job & 1;
            __syncthreads();
            for (int i = tid; i < 2 * 17 * 64; i += 512) { const int dr = i / (17 * 64), l = (i >> 6) % 17, p = i & 63, ix = (dr * NG + g) * NP + p;
                const float lre = a.in[4][ix], lim = a.in[5][ix], dt = expf(a.in[6][dr * NG + g]);
                const float mg = expf(lre * dt * (float)l); float sn, cs; sincosf(lim * dt * (float)l, &sn, &cs); pw[i] = (f32x2){mg * cs, mg * sn}; }
            for (int i = tid; i < 2 * 64; i += 512) { const int dr = i >> 6, p = i & 63, ix = (dr * NG + g) * NP + p;
                const float lre = a.in[4][ix], lim = a.in[5][ix], dt = expf(a.in[6][dr * NG + g]);
                const float mg = expf(lre * dt), ar = mg * cosf(lim * dt), ai = mg * sinf(lim * dt), den = lre * lre + lim * lim;
                const float zr = ((ar - 1.0f) * lre + ai * lim) / den, zi = (ai * lre - (ar - 1.0f) * lim) / den;
#pragma unroll
                for (int c = 0; c < GC; ++c) { const float br = a.in[7][(size_t)ix * GC + c], bi = a.in[8][(size_t)ix * GC + c]; Bb[i * GC + c] = (f32x2){zr * br - zi * bi, zr * bi + zi * br}; } }
            for (int i = tid; i < 2 * GC * NP; i += 512) { const int dr = i >> 10, r = i & 1023; const size_t o = ((size_t)(dr * NG + g) * GC) * NP + r; Cc[(i >> 6) * 65 + (i & 63)] = (f32x2){a.in[9][o], a.in[10][o]}; }
            __syncthreads();
            { const int dr = tid >> 8, l = (tid >> 4) & 15, co = tid & 15; float ac[16];
#pragma unroll
              for (int c = 0; c < 16; ++c) ac[c] = 0.f;
              for (int p = 0; p < NP; ++p) { const f32x2 cv = Cc[(dr * 16 + co) * 65 + p], wv = pw[(dr * 17 + l) * 64 + p]; const float cr = cv.x * wv.x - cv.y * wv.y, ci = cv.x * wv.y + cv.y * wv.x;
                  const f32x4* bq = (const f32x4*)(Bb + (dr * 64 + p) * 16);
#pragma unroll
                  for (int c = 0; c < 8; ++c) { const f32x4 bv = bq[c]; ac[2 * c] += cr * bv[0] - ci * bv[1]; ac[2 * c + 1] += cr * bv[2] - ci * bv[3]; } }
#pragma unroll
              for (int c = 0; c < 16; ++c) KT[((dr * 16 + l) * 16 + co) * 16 + c] = ac[c]; }
            __syncthreads();
            bf16_t* w2 = (bf16_t*)(ws + WS_W2T) + (size_t)g * 256 * 512;
            for (int it = tid; it < 128 * 64; it += 512) { const int rr = it >> 6, kg = it & 63, n = half * 128 + rr, j = n >> 4, co = n & 15; float f[8];
                if (kg < 32) { const int i = kg >> 1, ci0 = (kg & 1) * 8;
#pragma unroll
                    for (int e = 0; e < 8; ++e) { const int ci = ci0 + e; float v = 0.f;
                        if (i <= j) v += KT[((0 * 16 + (j - i)) * 16 + co) * 16 + ci];
                        if (i >= j) v += KT[((1 * 16 + (i - j)) * 16 + co) * 16 + ci];
                        if (i == j && ci == co) v += a.in[11][g * GC + co];
                        f[e] = v; } }
                else { const int kk = (kg - 32) * 8, dr = kk >> 7, ri = (kk >> 6) & 1, p0 = kk & 63, ex = dr == 0 ? j + 1 : 16 - j;
#pragma unroll
                    for (int e = 0; e < 8; ++e) { const f32x2 cv = Cc[(dr * 16 + co) * 65 + p0 + e], wv = pw[(dr * 17 + ex) * 64 + p0 + e];
                        f[e] = ri == 0 ? (cv.x * wv.x - cv.y * wv.y) : -(cv.x * wv.y + cv.y * wv.x); } }
                u32x4 o; o.x = cvt_pk_bf16(f[0], f[1]); o.y = cvt_pk_bf16(f[2], f[3]); o.z = cvt_pk_bf16(f[4], f[5]); o.w = cvt_pk_bf16(f[6], f[7]);
                *(u32x4*)(w2 + (size_t)n * 512 + kg * 8) = o; }
            bf16_t* w1 = (bf16_t*)(ws + WS_W1T) + (size_t)g * 256 * 256;
            for (int it = tid; it < 128 * 32; it += 512) { const int rr = it >> 5, kg = it & 31, dr = half, ri = rr >> 6, p = rr & 63, i = kg >> 1, ci0 = (kg & 1) * 8, ex = dr == 0 ? 15 - i : i;
                const f32x2 wv = pw[(dr * 17 + ex) * 64 + p]; float f[8];
#pragma unroll
                for (int e = 0; e < 8; ++e) { const f32x2 bv = Bb[(dr * 64 + p) * 16 + ci0 + e]; f[e] = ri == 0 ? (wv.x * bv.x - wv.y * bv.y) : (wv.x * bv.y + wv.y * bv.x); }
                u32x4 o; o.x = cvt_pk_bf16(f[0], f[1]); o.y = cvt_pk_bf16(f[2], f[3]); o.z = cvt_pk_bf16(f[4], f[5]); o.w = cvt_pk_bf16(f[6], f[7]);
                *(u32x4*)(w1 + (size_t)(half * 128 + rr) * 256 + kg * 8) = o; }
            if (tid < 64) ((f32x2*)(ws + WS_SSMP + SSMP_A16))[(half * NG + g) * NP + tid] = pw[(half * 17 + 16) * 64 + tid];
        }
        __syncthreads();
    }
    {
        u32x4* rwf = (u32x4*)(ws + WS_RW);
        for (int i = bid * 512 + tid; i < 8 * 8 * 3 * 64; i += G * 512) {
            const int lane_ = i & 63, f = i >> 6, nt = f % 3, ks = (f / 3) & 7, w = f / 24, n = lane_ & 15, fq = lane_ >> 4, j = nt * 16 + n;
            float wv[8];
#pragma unroll
            for (int e = 0; e < 8; ++e) { const int k = w * 256 + ks * 32 + fq * 8 + e; wv[e] = j < 4 ? a.in[17][k * 4 + j] : (j < NR ? a.in[19][k * NE + (j - 4)] : 0.f); }
            u32x4 hi; hi.x = cvt_pk_bf16(wv[0], wv[1]); hi.y = cvt_pk_bf16(wv[2], wv[3]); hi.z = cvt_pk_bf16(wv[4], wv[5]); hi.w = cvt_pk_bf16(wv[6], wv[7]);
            u32x4 lo; lo.x = cvt_pk_bf16(wv[0] - bflo(hi.x), wv[1] - bfhi(hi.x)); lo.y = cvt_pk_bf16(wv[2] - bflo(hi.y), wv[3] - bfhi(hi.y));
            lo.z = cvt_pk_bf16(wv[4] - bflo(hi.z), wv[5] - bfhi(hi.z)); lo.w = cvt_pk_bf16(wv[6] - bflo(hi.w), wv[7] - bfhi(hi.w));
            rwf[(size_t)(f * 2 + 0) * 64 + lane_] = hi; rwf[(size_t)(f * 2 + 1) * 64 + lane_] = lo;
        }
    }
}

template <int W>
__device__ __forceinline__ void pooldiff_item(const bf16_t* proj, bf16_t* dp, int t, int c8) {
    const int s = t & (S - 1);
    const bf16_t* base = proj + (size_t)t * D + c8;
    float sum[8];
#pragma unroll
    for (int e = 0; e < 8; ++e) sum[e] = 0.f;
    u32x4 self;
#pragma unroll
    for (int q = -W / 2; q < W / 2; ++q) { const bool ok = (s + q >= 0) && (s + q < S);
        u32x4 v = (u32x4){0u, 0u, 0u, 0u}; if (ok) v = *(const u32x4*)(base + (ptrdiff_t)q * D);
        if (q == 0) self = v;
#pragma unroll
        for (int e = 0; e < 4; ++e) { sum[2 * e] += bflo(v[e]); sum[2 * e + 1] += bfhi(v[e]); } }
    int lo = s - W / 2, hi = s + W / 2; lo = lo < 0 ? 0 : lo; hi = hi > S ? S : hi;
    const float inv = 1.0f / (float)(hi - lo);
    u32x4 o;
#pragma unroll
    for (int e = 0; e < 4; ++e) o[e] = cvt_pk_bf16(sum[2 * e] * inv - bflo(self[e]), sum[2 * e + 1] * inv - bfhi(self[e]));
    *(u32x4*)(dp + (size_t)t * DP + c8) = o;
}
__device__ void p2_pooldiff(const Args& a) {
    const bf16_t* proj = (const bf16_t*)(a.ws + WS_PROJ); bf16_t* dp = (bf16_t*)(a.ws + WS_DPOOL);
    const int n = T * (DP / 8);
    for (int i = blockIdx.x * 512 + threadIdx.x; i < n; i += gridDim.x * 512) {
        const int lane = i & 63, g = (i >> 6) & 3, t = (i >> 8) * 2 + (lane >> 5), c8 = (g * 32 + (lane & 31)) * 8;
        if (g == 0) pooldiff_item<2>(proj, dp, t, c8); else if (g == 1) pooldiff_item<4>(proj, dp, t, c8); else if (g == 2) pooldiff_item<8>(proj, dp, t, c8); else pooldiff_item<16>(proj, dp, t, c8);
    }
}

__device__ void p3_scan(const Args& a, unsigned char* lds) {
    const int tid = threadIdx.x, wid = tid >> 6, lane = tid & 63;
    unsigned char* ws = a.ws;
    const float* Sb = (const float*)(ws + WS_XB); bf16_t* A2 = (bf16_t*)(ws + WS_A2); const f32x2* a16 = (const f32x2*)(ws + WS_SSMP + SSMP_A16);
    f32x2* F = (f32x2*)lds;
    for (int job = blockIdx.x; job < 256; job += gridDim.x) {
        const int g = job >> 2, b = (job >> 1) & 1, dr = job & 1, p = lane;
        const f32x2 A = a16[(dr * NG + g) * NP + p];
        float pr = A.x, pi = A.y;
#pragma unroll
        for (int q = 0; q < 6; ++q) { const float nr = pr * pr - pi * pi, ni = 2.0f * pr * pi; pr = nr; pi = ni; }
        const float* sp = Sb + ((size_t)(g * 1024 + b * 512 + wid * 64)) * 256 + dr * 128 + p;
        float xr = 0.f, xi = 0.f;
#pragma unroll 8
        for (int q = 0; q < 64; ++q) { const int c = dr == 0 ? q : 63 - q; const float sr = sp[c * 256], si = sp[c * 256 + 64];
            const float nr = A.x * xr - A.y * xi + sr, ni = A.x * xi + A.y * xr + si; xr = nr; xi = ni; }
        __syncthreads();
        F[wid * 64 + p] = (f32x2){xr, xi};
        __syncthreads();
        float cr = 0.f, ci = 0.f;
        if (dr == 0) { for (int v = 0; v < wid; ++v) { const f32x2 f = F[v * 64 + p]; const float nr = pr * cr - pi * ci + f.x, ni = pr * ci + pi * cr + f.y; cr = nr; ci = ni; } }
        else { for (int v = 7; v > wid; --v) { const f32x2 f = F[v * 64 + p]; const float nr = pr * cr - pi * ci + f.x, ni = pr * ci + pi * cr + f.y; cr = nr; ci = ni; } }
        xr = cr; xi = ci;
        bf16_t* op = A2 + ((size_t)(g * 1024 + b * 512 + wid * 64)) * 512 + 256 + dr * 128 + p;
#pragma unroll 8
        for (int q = 0; q < 64; ++q) { const int c = dr == 0 ? q : 63 - q; const float sr = sp[c * 256], si = sp[c * 256 + 64];
            op[c * 512] = (bf16_t)(cvt_pk_bf16(xr, xr) & 0xffffu); op[c * 512 + 64] = (bf16_t)(cvt_pk_bf16(xi, xi) & 0xffffu);
            const float nr = A.x * xr - A.y * xi + sr, ni = A.x * xi + A.y * xr + si; xr = nr; xi = ni; }
    }
}

__device__ void p5_ln1_router(const Args& a, unsigned char* lds, int rep) {
    const int tid = threadIdx.x, wid = tid >> 6, lane = tid & 63, m = lane & 15, fq = lane >> 4;
    unsigned char* ws = a.ws;
    const bf16_t* __restrict__ v1b = (const bf16_t*)(ws + WS_V1B); const float* __restrict__ stt = (const float*)(ws + WS_ST); bf16_t* __restrict__ h1b = (bf16_t*)(ws + WS_H1B); const u32x4* __restrict__ rwf = (const u32x4*)(ws + WS_RW);
    unsigned char* __restrict__ h1f8 = ws + WS_H1F8;
    if (rep) { h1b = (bf16_t*)(ws + 345 * MB); h1f8 = ws + 409 * MB; }
    const float* g1 = a.in[15]; const float* b1 = a.in[16];
    int* tok_e = (int*)(ws + WS_ROUTE + RT_E); int* tok_rank = (int*)(ws + WS_ROUTE + RT_RANK); float* tok_gate = (float*)(ws + WS_ROUTE + RT_GATE);
    float* PL = (float*)(lds + 1024);
    float* LG = (float*)(lds + 1024 + 24576);
    float* GB = (float*)(lds + 32768);
    int* EL = (int*)(lds + 512);
    unsigned char* gc = (unsigned char*)(ws + WS_GC);
    __syncthreads();
    for (int i = tid; i < D; i += 512) { GB[i] = g1[i]; GB[D + i] = b1[i]; }
    __syncthreads();
    u32x4 vn[8]; f32x4 qn[4];
    { const int grp = blockIdx.x; if (grp < T / 16) { const size_t ro = (size_t)(grp * 16 + m) * D + wid * 256 + fq * 8;
#pragma unroll
        for (int ks = 0; ks < 8; ++ks) vn[ks] = *(const u32x4*)(v1b + ro + ks * 32);
#pragma unroll
        for (int q = 0; q < 4; ++q) qn[q] = *(const f32x4*)(stt + ((size_t)(grp * 16 + m) * 32 + fq * 8) * 2 + q * 4); } }
    for (int grp = blockIdx.x; grp < T / 16; grp += gridDim.x) {
        const int t = grp * 16 + m; const size_t ro = (size_t)t * D + wid * 256 + fq * 8;
        u32x4 v[8]; f32x4 qv[4];
#pragma unroll
        for (int ks = 0; ks < 8; ++ks) v[ks] = vn[ks];
#pragma unroll
        for (int q = 0; q < 4; ++q) qv[q] = qn[q];
        float s = (qv[0][0] + qv[0][2]) + (qv[1][0] + qv[1][2]) + (qv[2][0] + qv[2][2]) + (qv[3][0] + qv[3][2]);
        float ss = (qv[0][1] + qv[0][3]) + (qv[1][1] + qv[1][3]) + (qv[2][1] + qv[2][3]) + (qv[3][1] + qv[3][3]);
        s += __shfl_xor(s, 16); s += __shfl_xor(s, 32); ss += __shfl_xor(ss, 16); ss += __shfl_xor(ss, 32);
        const float mu = s * (1.0f / D); const float rstd = rsqrtf(fmaxf(ss * (1.0f / D) - mu * mu, 0.f) + LN_EPS);
        f32x4 acc[3];
#pragma unroll
        for (int nt = 0; nt < 3; ++nt) acc[nt] = (f32x4){0.f, 0.f, 0.f, 0.f};
        u32x4 wc_[6], wn_[6];
#pragma unroll
        for (int q = 0; q < 6; ++q) wc_[q] = rwf[(size_t)((wid * 8 + 0) * 6 + q) * 64 + lane];
#pragma unroll
        for (int ks = 0; ks < 8; ++ks) {
            if (ks < 7) {
#pragma unroll
                for (int q = 0; q < 6; ++q) wn_[q] = rwf[(size_t)((wid * 8 + ks + 1) * 6 + q) * 64 + lane]; }
            const int kk = wid * 256 + ks * 32 + fq * 8;
            const f32x4 ga = *(const f32x4*)(GB + kk), gb = *(const f32x4*)(GB + kk + 4), ba = *(const f32x4*)(GB + D + kk), bb = *(const f32x4*)(GB + D + kk + 4);
            const f32x4 va = (f32x4){bflo(v[ks].x), bfhi(v[ks].x), bflo(v[ks].y), bfhi(v[ks].y)}, vb = (f32x4){bflo(v[ks].z), bfhi(v[ks].z), bflo(v[ks].w), bfhi(v[ks].w)};
            const f32x4 h0 = (va - mu) * rstd * ga + ba, h1 = (vb - mu) * rstd * gb + bb;
            u32x4 hi; hi.x = cvt_pk_bf16(h0[0], h0[1]); hi.y = cvt_pk_bf16(h0[2], h0[3]); hi.z = cvt_pk_bf16(h1[0], h1[1]); hi.w = cvt_pk_bf16(h1[2], h1[3]);
            *(u32x4*)(h1b + ro + ks * 32) = hi;
            { u32x2 q8; q8.x = pk4_fp8(h0[0], h0[1], h0[2], h0[3]); q8.y = pk4_fp8(h1[0], h1[1], h1[2], h1[3]); *(u32x2*)(h1f8 + ro + ks * 32) = q8; }
            u32x4 lo; lo.x = cvt_pk_bf16(h0[0] - bflo(hi.x), h0[1] - bfhi(hi.x)); lo.y = cvt_pk_bf16(h0[2] - bflo(hi.y), h0[3] - bfhi(hi.y));
            lo.z = cvt_pk_bf16(h1[0] - bflo(hi.z), h1[1] - bfhi(hi.z)); lo.w = cvt_pk_bf16(h1[2] - bflo(hi.w), h1[3] - bfhi(hi.w));
            const bf16x8 ahi = __builtin_bit_cast(bf16x8, hi), alo = __builtin_bit_cast(bf16x8, lo);
#pragma unroll
            for (int nt = 0; nt < 3; ++nt) {
                const bf16x8 whi = __builtin_bit_cast(bf16x8, wc_[nt * 2]), wlo = __builtin_bit_cast(bf16x8, wc_[nt * 2 + 1]);
                acc[nt] = __builtin_amdgcn_mfma_f32_16x16x32_bf16(whi, ahi, acc[nt], 0, 0, 0);
                acc[nt] = __builtin_amdgcn_mfma_f32_16x16x32_bf16(whi, alo, acc[nt], 0, 0, 0);
                acc[nt] = __builtin_amdgcn_mfma_f32_16x16x32_bf16(wlo, ahi, acc[nt], 0, 0, 0); }
#pragma unroll
            for (int q = 0; q < 6; ++q) wc_[q] = wn_[q];
        }
        { const int gn = grp + gridDim.x; if (gn < T / 16) { const size_t rn = (size_t)(gn * 16 + m) * D + wid * 256 + fq * 8;
#pragma unroll
            for (int ks = 0; ks < 8; ++ks) vn[ks] = *(const u32x4*)(v1b + rn + ks * 32);
#pragma unroll
            for (int q = 0; q < 4; ++q) qn[q] = *(const f32x4*)(stt + ((size_t)(gn * 16 + m) * 32 + fq * 8) * 2 + q * 4); } }
#pragma unroll
        for (int nt = 0; nt < 3; ++nt) *(f32x4*)(PL + (wid * 16 + m) * 48 + nt * 16 + fq * 4) = acc[nt];
        __syncthreads();
        for (int i = tid; i < 16 * 48; i += 512) { const int mm = i / 48, j = i - mm * 48; float sm = 0.f;
#pragma unroll
            for (int w = 0; w < 8; ++w) sm += PL[(w * 16 + mm) * 48 + j];
            LG[i] = sm + (j < 4 ? a.in[18][j] : (j < NR ? a.in[20][j - 4] : 0.f)); }
        __syncthreads();
        if (tid < 16 && rep == 0) {
            const float* l = LG + tid * 48;
            const float g0 = l[0], g1v = l[1], g2 = l[2], g3 = l[3];
            int gsel = 0; float gm = g0; if (g1v > gm) { gm = g1v; gsel = 1; } if (g2 > gm) { gm = g2; gsel = 2; } if (g3 > gm) { gm = g3; gsel = 3; }
            const float pg = 1.0f / (expf(g0 - gm) + expf(g1v - gm) + expf(g2 - gm) + expf(g3 - gm));
            float el[8];
#pragma unroll
            for (int i = 0; i < 8; ++i) el[i] = l[4 + gsel * 8 + i];
            int i1 = 0; float m1 = el[0];
#pragma unroll
            for (int i = 1; i < 8; ++i) if (el[i] > m1) { m1 = el[i]; i1 = i; }
            int i2 = -1; float m2 = -3.0e38f;
#pragma unroll
            for (int i = 0; i < 8; ++i) if (i != i1 && el[i] > m2) { m2 = el[i]; i2 = i; }
            const float e2 = expf(m2 - m1), inv = 1.0f / (1.0f + e2);
            const int tt = grp * 16 + tid; const int ea = gsel * 8 + i1, eb = gsel * 8 + i2;
            EL[tid * 2] = ea; EL[tid * 2 + 1] = eb;
            tok_e[tt * 2] = ea; tok_e[tt * 2 + 1] = eb; tok_gate[tt * 2] = pg * inv; tok_gate[tt * 2 + 1] = pg * e2 * inv;
        }
        __syncthreads();
        if (tid < 32 && rep == 0) { const int me = EL[tid]; int r = 0;
            for (int q = 0; q < tid; ++q) r += (EL[q] == me) ? 1 : 0;
            tok_rank[(grp * 16) * 2 + tid] = r; }
        else if (tid >= 32 && tid < 64 && rep == 0) { const int e = tid - 32; int c = 0;
#pragma unroll
            for (int q = 0; q < 32; ++q) c += (EL[q] == e) ? 1 : 0;
            gc[grp * 32 + e] = (unsigned char)c; }
    }
    __syncthreads();
}

__device__ __forceinline__ void moe_build_tab(const Args& a, int* tstart) {
    if (threadIdx.x == 0) { const unsigned* cnt = (const unsigned*)(a.ws + WS_CTL); int acc = 0;
        for (int e = 0; e < NE; ++e) { tstart[e] = acc; acc += ((int)__hip_atomic_load(cnt + e, __ATOMIC_RELAXED, __HIP_MEMORY_SCOPE_AGENT) + 255) >> 8; }
        tstart[NE] = acc; }
    __syncthreads();
}

__device__ void p6_slots(const Args& a, unsigned char* lds, int* tstart) {
    const int tid = threadIdx.x;
    unsigned char* ws = a.ws;
    const int* tok_e = (const int*)(ws + WS_ROUTE + RT_E); const int* tok_rank = (const int*)(ws + WS_ROUTE + RT_RANK); const float* tok_gate = (const float*)(ws + WS_ROUTE + RT_GATE);
    int* slot_tok = (int*)(ws + WS_ROUTE + RT_STOK); float* slot_gate = (float*)(ws + WS_ROUTE + RT_SGATE); int* tok_slot = (int*)(ws + WS_ROUTE + RT_SGATE + (size_t)MAXTILES * 256 * 4);
    unsigned char* GC = lds;
    unsigned short* BASE = (unsigned short*)(lds + 32768);
    int* CS = (int*)(lds + 98304);
    int* CNT = (int*)(lds + 98304 + 2048);
    __syncthreads();
    { const u32x4* src = (const u32x4*)(ws + WS_GC); u32x4* dst = (u32x4*)GC;
#pragma unroll
      for (int q = 0; q < 4; ++q) dst[tid + q * 512] = src[tid + q * 512]; }
    __syncthreads();
    const int e = tid & 31, c = tid >> 5;
    { int sm = 0; for (int g = c * 64; g < c * 64 + 64; ++g) sm += GC[g * 32 + e]; CS[e * 16 + c] = sm; }
    __syncthreads();
    if (tid < 32) { int run = 0; for (int q = 0; q < 16; ++q) { const int tmp = CS[tid * 16 + q]; CS[tid * 16 + q] = run; run += tmp; } CNT[tid] = run; }
    __syncthreads();
    if (tid == 0) { int acc = 0; for (int q = 0; q < NE; ++q) { tstart[q] = acc; acc += (CNT[q] + 255) >> 8; } tstart[NE] = acc; }
    if (blockIdx.x == 0 && tid < 32) ((unsigned*)(ws + WS_CTL))[tid] = (unsigned)CNT[tid];
    { int run = CS[e * 16 + c]; for (int g = c * 64; g < c * 64 + 64; ++g) { BASE[g * 32 + e] = (unsigned short)run; run += GC[g * 32 + e]; } }
    __syncthreads();
    for (int i = blockIdx.x * 512 + tid; i < T * 2; i += gridDim.x * 512) {
        const int ee = tok_e[i], s = tstart[ee] * 256 + (int)BASE[(i >> 5) * 32 + ee] + tok_rank[i]; slot_tok[s] = i >> 1; slot_gate[s] = tok_gate[i]; tok_slot[i] = s; }
    const int ns = tstart[NE] * 256;
    for (int s = blockIdx.x * 512 + tid; s < ns; s += gridDim.x * 512) {
        const int ee = moe_expert_of_tile(tstart, s >> 8); const int r = s - tstart[ee] * 256;
        if (r >= CNT[ee]) { slot_tok[s] = -1; slot_gate[s] = 0.f; } }
    __syncthreads();
}

__device__ void p9_ln2(const Args& a, const int* tstart, int rep) {
    const int tid = threadIdx.x, wid = tid >> 6, lane = tid & 63;
    const float* g2 = a.in[24]; const float* b2 = a.in[25];
    const bf16_t* ys = (const bf16_t*)(a.ws + WS_YS); const bf16_t* h1b = (const bf16_t*)(a.ws + WS_H1B);
    const int* tok_slot = (const int*)(a.ws + WS_ROUTE + RT_SGATE + (size_t)MAXTILES * 256 * 4);
    const int nw = gridDim.x * 8;
    for (int t = blockIdx.x * 8 + wid; t < T; t += nw) {
        float* roww = rep == 0 ? a.out + (size_t)t * D : (float*)(a.ws + 25 * MB) + (size_t)(t & 8191) * D;
        const size_t sa = (size_t)tok_slot[t * 2] * D, sb = (size_t)tok_slot[t * 2 + 1] * D;
        f32x4 h[8]; float s = 0.f;
#pragma unroll
        for (int i = 0; i < 8; ++i) { const u32x2 hv = *(const u32x2*)(h1b + (size_t)t * D + i * 256 + lane * 4);
            const u32x2 ya = *(const u32x2*)(ys + sa + i * 256 + lane * 4), yb = *(const u32x2*)(ys + sb + i * 256 + lane * 4);
            h[i][0] = ALPHA * bflo(hv.x) + (bflo(ya.x) + bflo(yb.x)); h[i][1] = ALPHA * bfhi(hv.x) + (bfhi(ya.x) + bfhi(yb.x));
            h[i][2] = ALPHA * bflo(hv.y) + (bflo(ya.y) + bflo(yb.y)); h[i][3] = ALPHA * bfhi(hv.y) + (bfhi(ya.y) + bfhi(yb.y));
            s += (h[i][0] + h[i][1]) + (h[i][2] + h[i][3]); }
        const float mu = wave_sum(s) * (1.0f / D); float vq = 0.f;
#pragma unroll
        for (int i = 0; i < 8; ++i) { const f32x4 d = h[i] - mu; vq += (d[0] * d[0] + d[1] * d[1]) + (d[2] * d[2] + d[3] * d[3]); }
        const float rstd = rsqrtf(wave_sum(vq) * (1.0f / D) + LN_EPS);
#pragma unroll
        for (int i = 0; i < 8; ++i) { const f32x4 gv = *(const f32x4*)(g2 + i * 256 + lane * 4), bv = *(const f32x4*)(b2 + i * 256 + lane * 4);
            *(f32x4*)(roww + i * 256 + lane * 4) = (h[i] - mu) * rstd * gv + bv; }
    }
}

constexpr int NPHASE = 12;
__global__ void __launch_bounds__(512, 2) fwd(Args a) {
    extern __shared__ __attribute__((aligned(16))) unsigned char lds[];
    cg::grid_group grid = cg::this_grid();
    unsigned char* ws = a.ws;
    int* tstart = (int*)(lds + MISC_OFF);
    volatile LAS unsigned* bst = (volatile LAS unsigned*)((LAS unsigned char*)lds + MISC_OFF + 256);
    if (threadIdx.x < 4) bst[threadIdx.x] = 0u;
    __syncthreads();
    XcdBarrier xbar = xcd_barrier_post((unsigned*)(ws + WS_BAR), bst);
    if (a.ph_hi > 1000) grid.sync();
#define IN(k) (a.ph_lo <= (k) && (k) < a.ph_hi)
    volatile unsigned long long* tsv = (volatile unsigned long long*)(lds + MISC_OFF + 512);
#define TS_START(k) do { if ((k) == PROBE_TS_A && blockIdx.x == 0 && threadIdx.x == 0) tsv[0] = __builtin_amdgcn_s_memrealtime(); } while (0)
#define TS_END(k) do { if ((k) == PROBE_TS_B && blockIdx.x == 0 && threadIdx.x == 0) tsv[1] = __builtin_amdgcn_s_memrealtime(); } while (0)
#define SEAM(k) do { if (IN(k) && IN((k) + 1)) xcd_barrier(xbar); } while (0)
    for (int q = 0; q < PROBE_SYNC; ++q) xcd_barrier(xbar);
    TS_START(0);
    if (IN(0)) for (int rep = 0; rep < (0 == PROBE_PHASE ? PROBE_REP : 1); ++rep) p0_prepass(a, lds, rep);
    SEAM(0); TS_END(0);
    TS_START(1);
    if (IN(1)) { DescProj d{(const char*)(ws + WS_XB), (const char*)(ws + WS_WIN), (bf16_t*)(ws + WS_PROJ), (bf16_t*)(ws + WS_A2), D, D}; gemm_run<0>(lds, d); }
    SEAM(1); TS_END(1);
    TS_START(2);
    if (IN(2)) { for (int rep = 0; rep < (2 == PROBE_PHASE ? PROBE_REP : 1); ++rep) p2_pooldiff(a);
        DescS1 d{(const char*)(ws + WS_A2), (const char*)(ws + WS_W1T), (float*)(ws + WS_XB), 256, 256}; gemm_run<6>(lds, d); }
    SEAM(2); TS_END(2);
    TS_START(3);
    if (IN(3)) for (int rep = 0; rep < (3 == PROBE_PHASE ? PROBE_REP : 1); ++rep) p3_scan(a, lds);
    SEAM(3); TS_END(3);
    TS_START(4);
    if (IN(4)) {
        { DescS2 d{(const char*)(ws + WS_A2), (const char*)(ws + WS_W2T), (bf16_t*)(ws + WS_YSSM), 512, 512}; gemm_run<7>(lds, d); }
        { DescPool d{(const char*)(ws + WS_DPOOL), (const char*)(ws + WS_POOLW), (bf16_t*)(ws + WS_XB), a.in[3], 256, 256}; gemm_run<1>(lds, d); }
    }
    SEAM(4); TS_END(4);
    TS_START(5);
    if (IN(5)) { DescGlu d{(const char*)(ws + WS_YSSM), (const char*)(ws + WS_GLU), (bf16_t*)(ws + WS_XB), a.in[13], DS, DS}; gemm_run<2>(lds, d); }
    SEAM(5); TS_END(5);
    TS_START(6);
    if (IN(6)) { DescOut d{(const char*)(ws + WS_XB), (const char*)(ws + WS_WOUT), (bf16_t*)(ws + WS_V1B), a.in[0], (float*)(ws + WS_ST), D, D}; gemm_run<3>(lds, d); }
    SEAM(6); TS_END(6);
    TS_START(7);
    if (IN(7)) for (int rep = 0; rep < (7 == PROBE_PHASE ? PROBE_REP : 1); ++rep) p5_ln1_router(a, lds, rep);
    SEAM(7); TS_END(7);
    TS_START(8);
    if (IN(8)) { for (int rep = 0; rep < (8 == PROBE_PHASE ? PROBE_REP : 1); ++rep) p6_slots(a, lds, tstart); }
    SEAM(8); TS_END(8);
    TS_START(9);
    if (IN(9)) { moe_build_tab(a, tstart);
        DescGU d{(const char*)(ws + WS_H1F8), (const char*)(ws + WS_WGU), (bf16_t*)(ws + WS_HH), (const int*)(ws + WS_ROUTE + RT_STOK), tstart, D / 2, D / 2}; gemm_run<4>(lds, d); }
    SEAM(9); TS_END(9);
    TS_START(10);
    if (IN(10)) { moe_build_tab(a, tstart);
        DescDown d{(const char*)(ws + WS_HH), (const char*)(ws + WS_WD), (bf16_t*)(ws + WS_YS), (const float*)(ws + WS_ROUTE + RT_SGATE), tstart, DE / 2, DE / 2}; gemm_run<5>(lds, d); }
    SEAM(10); TS_END(10);
    TS_START(11);
    if (IN(11)) { moe_build_tab(a, tstart); for (int rep = 0; rep < (11 == PROBE_PHASE ? PROBE_REP : 1); ++rep) p9_ln2(a, tstart, rep); }
    TS_END(11);
    if (PROBE_TS_A >= 0 && blockIdx.x == 0 && threadIdx.x == 0) { const unsigned long long dt = tsv[1] - tsv[0], te = __builtin_amdgcn_s_memrealtime(); while (__builtin_amdgcn_s_memrealtime() - te < 4ull * dt) __builtin_amdgcn_s_sleep(32); }
#undef IN
#undef SEAM
}

extern "C" void kernel_launch(void* const* d_in, const int* in_sizes, int n_in, void* d_out, int out_size, void* d_ws, size_t ws_size, hipStream_t stream) {
    static int grid = 0;
    if (grid == 0) {
        if (n_in != 26 || out_size != T * D || ws_size < WS_END) { fprintf(stderr, "kernel_launch: unexpected shapes (n_in %d out %d ws %zu)\n", n_in, out_size, ws_size); grid = -1; return; }
        int dev = 0, cus = 0, per_cu = 0;
        (void)hipGetDevice(&dev); (void)hipDeviceGetAttribute(&cus, hipDeviceAttributeMultiprocessorCount, dev);
        (void)hipFuncSetAttribute((const void*)fwd, hipFuncAttributeMaxDynamicSharedMemorySize, LDS_BYTES);
        (void)hipOccupancyMaxActiveBlocksPerMultiprocessor(&per_cu, (const void*)fwd, 512, LDS_BYTES);
        if (per_cu < 1) { fprintf(stderr, "kernel_launch: occupancy query says %d blocks/CU\n", per_cu); per_cu = 1; }
        grid = cus;
    }
    if (grid < 0) return;
    (void)hipMemsetAsync((char*)d_ws + WS_CTL, 0, CTL_ZERO_BYTES, stream);
    Args a{};
    for (int i = 0; i < 26; ++i) a.in[i] = (const float*)d_in[i];
    a.out = (float*)d_out; a.ws = (unsigned char*)d_ws;
#if N_LAUNCH_MODE == 0
    a.ph_lo = 0; a.ph_hi = NPHASE;
    void* args[] = {&a};
    hipError_t e = hipLaunchCooperativeKernel((const void*)fwd, dim3(grid), dim3(512), args, LDS_BYTES, stream);
    if (e != hipSuccess) fprintf(stderr, "cooperative launch failed: %s (grid %d)\n", hipGetErrorString(e), grid);
#else
    for (int p = 0; p < NPHASE; ++p) { a.ph_lo = p; a.ph_hi = p + 1; hipLaunchKernelGGL(fwd, dim3(grid), dim3(512), LDS_BYTES, stream, a); }
#endif
}
```

```cpp
#include <hip/hip_runtime.h>
#include <hip/hip_cooperative_groups.h>
#include <cstdio>
namespace cg = cooperative_groups;

#ifndef N_LAUNCH_MODE
#define N_LAUNCH_MODE 0
#endif
#ifndef PROBE_PHASE
#define PROBE_PHASE -1
#endif
#ifndef PROBE_REP
#define PROBE_REP 1
#endif
#ifndef PROBE_SYNC
#define PROBE_SYNC 0
#endif
#ifndef PROBE_TS_A
#define PROBE_TS_A -1
#endif
#ifndef PROBE_TS_B
#define PROBE_TS_B -1
#endif
#ifndef PROBE_NOSTORE
#define PROBE_NOSTORE 0
#endif
#ifndef PROBE_P0PART
#define PROBE_P0PART 0
#endif
#ifndef PROBE_BLK
#define PROBE_BLK 0
#endif
#ifndef PROBE_DUP
#define PROBE_DUP 0
#endif
#ifndef PROBE_GEMM
#define PROBE_GEMM -1
#endif
#ifndef NAIVE_MASK
#define NAIVE_MASK 0x00
#endif

typedef unsigned short bf16_t;
typedef short bf16x8 __attribute__((ext_vector_type(8)));
typedef float f32x4 __attribute__((ext_vector_type(4)));
typedef float f32x2 __attribute__((ext_vector_type(2)));
typedef unsigned u32x4 __attribute__((ext_vector_type(4)));
typedef unsigned u32x2 __attribute__((ext_vector_type(2)));
typedef int i32x8 __attribute__((ext_vector_type(8)));
typedef int i32x4 __attribute__((ext_vector_type(4)));

constexpr int T = 16384, D = 2048, S = 8192, NB = 2;
constexpr int DP = 1024, DS = 1024, NG = 64, GC = 16, NP = 64;
constexpr int NE = 32, DE = 512, NR = 36;
constexpr int MAXTILES = 161;
constexpr float LN_EPS = 1e-5f;
constexpr float ALPHA = 1.189207115002721f;
constexpr float WSCALE = 32.0f, WSCALE_INV = 1.0f / 32.0f;
constexpr float YSCALE = 64.0f, YSCALE_INV = 1.0f / 64.0f;

constexpr size_t MB = 1u << 20;
constexpr size_t WS_CTL = 0;
constexpr size_t WS_BAR = 65536;
constexpr size_t CTL_ZERO_BYTES = 131072;
constexpr size_t WS_YS = 281 * MB;
constexpr size_t WS_H1B = 217 * MB;
constexpr size_t WS_V1B = 281 * MB;
constexpr size_t WS_ST = 484 * MB;
constexpr size_t WS_S = 89 * MB;
constexpr size_t WS_H1F8 = 89 * MB;
constexpr size_t WS_HH = 442 * MB;
constexpr size_t WS_SSMP = 1 * MB;
constexpr size_t WS_RW = 3 * MB;
constexpr size_t WS_ROUTE = 4 * MB;
constexpr size_t WS_WIN = 6 * MB;
constexpr size_t WS_WOUT = 14 * MB;
constexpr size_t WS_GLU = 22 * MB;
constexpr size_t WS_POOLW = 24 * MB;
constexpr size_t WS_WGU = 25 * MB;
constexpr size_t WS_WD = 153 * MB;
constexpr size_t WS_XB = 217 * MB;
constexpr size_t WS_PROJ = 281 * MB;
constexpr size_t WS_DPOOL = 409 * MB;
constexpr size_t WS_YSSM = 441 * MB;
constexpr size_t WS_A2 = 345 * MB;
constexpr size_t WS_W1T = 484 * MB;
constexpr size_t WS_W2T = 492 * MB;
constexpr size_t WS_END = 508 * MB;
constexpr size_t SSMP_A16 = 1536 * 1024;

constexpr size_t WS_GC = 5 * MB + 512 * 1024;
constexpr size_t RT_E = 0, RT_RANK = (size_t)T * 2 * 4, RT_GATE = (size_t)T * 4 * 4, RT_STOK = (size_t)T * 6 * 4, RT_SGATE = RT_STOK + (size_t)MAXTILES * 256 * 4;

constexpr int LDS_BYTES = 128 * 1024 + 4096 + 8192;
constexpr int UTAB_OFF = 128 * 1024 + 4096;
constexpr int MISC_OFF = 128 * 1024;

struct Args { const float* in[26]; float* out; unsigned char* ws; int ph_lo, ph_hi; };

__device__ __forceinline__ float bf2f(bf16_t b) { return __uint_as_float(((unsigned)b) << 16); }
__device__ __forceinline__ float bflo(unsigned w) { return __uint_as_float(w << 16); }
__device__ __forceinline__ float bfhi(unsigned w) { return __uint_as_float(w & 0xffff0000u); }
__device__ __forceinline__ unsigned cvt_pk_bf16(float lo, float hi) { unsigned r; asm("v_cvt_pk_bf16_f32 %0, %1, %2" : "=v"(r) : "v"(lo), "v"(hi)); return r; }
__device__ __forceinline__ unsigned pk4_fp8(float a, float b, float c, float d) { unsigned w = 0; w = __builtin_amdgcn_cvt_pk_fp8_f32(a, b, w, false); w = __builtin_amdgcn_cvt_pk_fp8_f32(c, d, w, true); return w; }
__device__ __forceinline__ float wave_sum(float v) {
#pragma unroll
    for (int o = 32; o >= 1; o >>= 1) v += __shfl_xor(v, o);
    return v;
}
__device__ __forceinline__ float gelu_tanh(float x) {
    const float u = 0.7978845608028654f * (x + 0.044715f * x * x * x);
    const float e = __expf(-2.0f * fabsf(u));
    float t = (1.0f - e) / (1.0f + e); t = u < 0.f ? -t : t;
    return 0.5f * x * (1.0f + t);
}
__device__ __forceinline__ float sigmoidf_(float z) { return 1.0f / (1.0f + __expf(-z)); }

#define LAS __attribute__((address_space(3)))
#define XB_TMO      128
#define XB_XCNT(j)  (256  + 64 * (j))
#define XB_XSUB(j)  (1280 + 64 * (j))
#define XB_XGEN(j)  (2304 + 64 * (j))
#define XB_TOP      3328
#define XB_TOPGEN   3392
#define XCD_BAR_WORDS 3456
#define XB_SPIN_CAP (1u << 18)
__device__ __forceinline__ unsigned xb_ld(unsigned* p)              { return __hip_atomic_load(p, __ATOMIC_RELAXED, __HIP_MEMORY_SCOPE_AGENT); }
__device__ __forceinline__ unsigned xb_add(unsigned* p, unsigned v) { return __hip_atomic_fetch_add(p, v, __ATOMIC_RELAXED, __HIP_MEMORY_SCOPE_AGENT); }
__device__ __forceinline__ unsigned xb_xcc_id() { return (unsigned)__builtin_amdgcn_s_getreg((3 << 11) | 20) & 0xFu; }
#define XB_SPIN(cond, bar) do { unsigned _sp = 0; while (cond) { __builtin_amdgcn_s_sleep(1); \
    if ((++_sp & 255u) == 0u) { if (xb_ld(&(bar)[XB_TMO])) break; if (_sp > XB_SPIN_CAP) { atomicAdd(&(bar)[XB_TMO], 1u); break; } } } } while (0)
struct XcdBarrier { unsigned* bar; unsigned x; volatile LAS unsigned* st; };
__device__ __forceinline__ XcdBarrier xcd_barrier_post(unsigned* bar, volatile LAS unsigned* st) {
    XcdBarrier b; b.bar = bar; b.x = xb_xcc_id(); b.st = st;
    if (threadIdx.x == 0) (void)xb_add(&bar[XB_XCNT(b.x)], 1u);
    return b;
}
__device__ __forceinline__ void xcd_barrier_complete(unsigned* bar, unsigned x, unsigned& nloc, unsigned& nx) {
    const unsigned G = gridDim.x * gridDim.y * gridDim.z;
    unsigned sum, cnt, mine, sp = 0u;
    for (;;) {
        sum = 0u; cnt = 0u; mine = 0u;
#pragma unroll
        for (unsigned j = 0; j < 16; ++j) { const unsigned c = xb_ld(&bar[XB_XCNT(j)]); sum += c; cnt += (c > 0u) ? 1u : 0u; mine = (j == x) ? c : mine; }
        if (sum == G) break;
        __builtin_amdgcn_s_sleep(1);
        if ((++sp & 255u) == 0u) { if (xb_ld(&bar[XB_TMO])) break; if (sp > XB_SPIN_CAP) { atomicAdd(&bar[XB_TMO], 1u); break; } }
    }
    nloc = mine > 0u ? mine : 1u; nx = cnt > 0u ? cnt : 1u;
}
__device__ __forceinline__ void xcd_barrier(const XcdBarrier& b) {
    asm volatile("s_waitcnt vmcnt(0)" ::: "memory");
    __syncthreads();
    if (threadIdx.x == 0) {
        unsigned* bar = b.bar;
        __builtin_amdgcn_s_waitcnt(0);
        unsigned nloc = b.st[0], nx = b.st[1];
        if (nloc == 0u) { xcd_barrier_complete(bar, b.x, nloc, nx); b.st[0] = nloc; b.st[1] = nx; }
        const unsigned old = xb_add(&bar[XB_XSUB(b.x)], 1u);
        const unsigned gen = old / nloc;
        if (old + 1u == (gen + 1u) * nloc) {
            __builtin_amdgcn_fence(__ATOMIC_RELEASE, "agent");
            asm volatile("s_waitcnt vmcnt(0)" ::: "memory");
            const unsigned og = xb_add(&bar[XB_TOP], 1u);
            const unsigned tg = og / nx;
            if (og + 1u == (tg + 1u) * nx) xb_add(&bar[XB_TOPGEN], 1u);
            else XB_SPIN(xb_ld(&bar[XB_TOPGEN]) == tg, bar);
            __builtin_amdgcn_fence(__ATOMIC_ACQUIRE, "agent");
            xb_add(&bar[XB_XGEN(b.x)], 1u);
            asm volatile("s_waitcnt vmcnt(0)" ::: "memory");
        } else {
            XB_SPIN(xb_ld(&bar[XB_XGEN(b.x)]) == gen, bar);
            __builtin_amdgcn_fence(__ATOMIC_ACQUIRE, "agent");
            asm volatile("s_waitcnt vmcnt(0)" ::: "memory");
        }
    }
    __syncthreads();
}

struct Unit { int r0, c0, e, pad; };

template <class DS_>
__device__ void gemm_naive(const DS_& d) {
    const int tid = threadIdx.x, wid = tid >> 6, lane = tid & 63, wr = wid >> 2, wc = wid & 3, fr = lane & 15, fq = lane >> 4;
    const int K = d.K; const size_t ldb2 = (size_t)d.ldb * 2;
    for (int ui = blockIdx.x;; ui += gridDim.x) {
        Unit u; if (!d.get(ui, u)) break;
        f32x4 acc[2][2][4][2];
        const char* Bp = d.b_ptr(u);
#pragma unroll
        for (int ai = 0; ai < 2; ++ai)
#pragma unroll
            for (int m = 0; m < 4; ++m) {
                const int r = 128 * ai + 64 * wr + 16 * m + fr;
                const char* ap = d.A + d.a_off(u, r);
#pragma unroll
                for (int bj = 0; bj < 2; ++bj)
#pragma unroll
                    for (int n = 0; n < 2; ++n) {
                        const int c = 128 * bj + 32 * wc + 8 * fq + 4 * n;
                        const char* bp = Bp + (size_t)c * ldb2;
                        float s0 = 0.f, s1 = 0.f, s2 = 0.f, s3 = 0.f;
                        for (int k = 0; k < K; k += 8) {
                            const u32x4 av = *(const u32x4*)(ap + k * 2);
                            const u32x4 b0 = *(const u32x4*)(bp + k * 2), b1 = *(const u32x4*)(bp + ldb2 + k * 2), b2 = *(const u32x4*)(bp + 2 * ldb2 + k * 2), b3 = *(const u32x4*)(bp + 3 * ldb2 + k * 2);
#pragma unroll
                            for (int j = 0; j < 4; ++j) {
                                const float al = bflo(av[j]), ah = bfhi(av[j]);
                                s0 += al * bflo(b0[j]); s0 += ah * bfhi(b0[j]);
                                s1 += al * bflo(b1[j]); s1 += ah * bfhi(b1[j]);
                                s2 += al * bflo(b2[j]); s2 += ah * bfhi(b2[j]);
                                s3 += al * bflo(b3[j]); s3 += ah * bfhi(b3[j]);
                            }
                        }
                        acc[ai][bj][m][n] = (f32x4){s0, s1, s2, s3};
                    }
            }
        d.epi(acc, u, wr, wc, fr, fq);
    }
}

constexpr int BK = 64, HALF = 128, HTB = HALF * BK * 2;
__device__ __forceinline__ int lds_byte(int r, int c) { const int st = (r >> 4) * 2 + (c >> 5), rr = r & 15, cc = c & 31, ob = rr * 64 + cc * 2; return st * 1024 + (ob ^ (((ob >> 9) & 1) << 5)); }
__device__ __forceinline__ int perm32(int rho) { const int n = rho >> 4, i = rho & 15; return 8 * (i >> 2) + 4 * n + (i & 3); }
__device__ __forceinline__ void stage_rc(int b, int& R, int& C) { const int st = b / 1024, sb = b % 1024, swz = sb ^ (((sb >> 9) & 1) << 5); R = (st >> 1) * 16 + swz / 64; C = (st & 1) * 32 + (swz % 64) / 2; }

template <bool FP8, class DS_>
__device__ __forceinline__ void gemm_fast(LAS unsigned char* lds, const DS_& d) {
    const int tid = threadIdx.x, wid = __builtin_amdgcn_readfirstlane(tid >> 6), lane = tid & 63, wr = wid >> 2, wc = wid & 3, fr = lane & 15, fq = lane >> 4;
    const int K = d.K, nt = K / BK;
    int Rr[2], Cc[2]; unsigned voffB[2];
#pragma unroll
    for (int i = 0; i < 2; ++i) { stage_rc(tid * 16 + i * 8192, Rr[i], Cc[i]); const int Rb = (Rr[i] & ~31) + perm32(Rr[i] & 31); voffB[i] = (unsigned)(Rb * d.ldb + Cc[i]) * 2u; }
    const size_t kstep = (size_t)(BK * 2);
    const size_t hstepB = (size_t)HALF * d.ldb * 2;
    const unsigned ldsw = (unsigned)wid * 1024u;
    const int aoff = lds_byte(wr * 64 + fr, fq * 8), boff = lds_byte(wc * 32 + fr, fq * 8);
#define G_SA(b, h) (((b) * 2 + (h)) * HTB)
#define G_SB(b, h) ((4 + (b) * 2 + (h)) * HTB)
#define G_STAGE(bufoff, gbase, voff) do { _Pragma("unroll") for (int _i = 0; _i < 2; ++_i) \
        __builtin_amdgcn_global_load_lds((const unsigned*)((const char*)(gbase) + (voff)[_i]), (LAS unsigned*)(lds + (bufoff) + ldsw + _i * 8192), 16, 0, 0); } while (0)
#define G_LDA(dst, b, h) do { _Pragma("unroll") for (int m = 0; m < 4; ++m) { const i32x4 l0_ = *(const LAS i32x4*)(lds + G_SA(b, h) + aoff + m * 2048), l1_ = *(const LAS i32x4*)(lds + G_SA(b, h) + aoff + m * 2048 + 1024); \
        dst[m] = __builtin_shufflevector(l0_, l1_, 0, 1, 2, 3, 4, 5, 6, 7); } } while (0)
#define G_LDB(dst, b, h) do { _Pragma("unroll") for (int n = 0; n < 2; ++n) { const i32x4 l0_ = *(const LAS i32x4*)(lds + G_SB(b, h) + boff + n * 2048), l1_ = *(const LAS i32x4*)(lds + G_SB(b, h) + boff + n * 2048 + 1024); \
        dst[n] = __builtin_shufflevector(l0_, l1_, 0, 1, 2, 3, 4, 5, 6, 7); } } while (0)
#define G_MMA(ai, bj, At, Bt) do { __builtin_amdgcn_s_setprio(1); _Pragma("unroll") for (int m = 0; m < 4; ++m) _Pragma("unroll") for (int n = 0; n < 2; ++n) { \
        if constexpr (FP8) asm volatile("v_mfma_f32_16x16x128_f8f6f4 %0, %1, %2, %0" : "+v"(acc[ai][bj][m][n]) : "v"(Bt[n]), "v"(At[m])); \
        else { acc[ai][bj][m][n] = __builtin_amdgcn_mfma_f32_16x16x32_bf16(__builtin_bit_cast(bf16x8, __builtin_shufflevector(Bt[n], Bt[n], 0, 1, 2, 3)), __builtin_bit_cast(bf16x8, __builtin_shufflevector(At[m], At[m], 0, 1, 2, 3)), acc[ai][bj][m][n], 0, 0, 0); \
               acc[ai][bj][m][n] = __builtin_amdgcn_mfma_f32_16x16x32_bf16(__builtin_bit_cast(bf16x8, __builtin_shufflevector(Bt[n], Bt[n], 4, 5, 6, 7)), __builtin_bit_cast(bf16x8, __builtin_shufflevector(At[m], At[m], 4, 5, 6, 7)), acc[ai][bj][m][n], 0, 0, 0); } } \
        __builtin_amdgcn_s_setprio(0); } while (0)
#define G_WAIT_V(n) asm volatile("s_waitcnt vmcnt(" #n ")" ::: "memory")
#define G_WAIT_L(n) asm volatile("s_waitcnt lgkmcnt(" #n ")" ::: "memory")
#define G_BAR __builtin_amdgcn_s_barrier()
#define G_SCHED __builtin_amdgcn_sched_barrier(0)
    Unit cur, nxt; int ui = blockIdx.x;
    if (!d.get(ui, cur)) return;
    f32x4 acc[2][2][4][2];
#pragma unroll
    for (int a_ = 0; a_ < 2; ++a_)
#pragma unroll
        for (int b_ = 0; b_ < 2; ++b_)
#pragma unroll
            for (int m = 0; m < 4; ++m)
#pragma unroll
                for (int n = 0; n < 2; ++n) acc[a_][b_][m][n] = (f32x4){0.f, 0.f, 0.f, 0.f};
    i32x8 At[4], B0[2], B1[2];
    unsigned vA[2][2], nvA[2][2];
#pragma unroll
    for (int h = 0; h < 2; ++h)
#pragma unroll
        for (int i = 0; i < 2; ++i) vA[h][i] = d.a_off(cur, h * HALF + Rr[i]) + (unsigned)Cc[i] * 2u;
    const char* const Ab = d.A;
    const char* cB = d.b_ptr(cur);
    G_STAGE(G_SB(0, 0), cB, voffB); G_STAGE(G_SA(0, 0), Ab, vA[0]); G_STAGE(G_SB(0, 1), cB + hstepB, voffB); G_STAGE(G_SA(0, 1), Ab, vA[1]);
    if (wr == 1) G_BAR;
    G_WAIT_V(4); G_BAR;
    G_STAGE(G_SB(1, 0), cB + kstep, voffB); G_STAGE(G_SA(1, 0), Ab + kstep, vA[0]); G_STAGE(G_SB(1, 1), cB + hstepB + kstep, voffB);
    G_WAIT_V(6); G_BAR;
    for (;;) {
        const bool has_next = d.get(ui + (int)gridDim.x, nxt);
        const char* nB = has_next ? d.b_ptr(nxt) : cB;
#pragma unroll
        for (int h = 0; h < 2; ++h)
#pragma unroll
            for (int i = 0; i < 2; ++i) nvA[h][i] = has_next ? (d.a_off(nxt, h * HALF + Rr[i]) + (unsigned)Cc[i] * 2u) : vA[h][i];
        for (int t = 0; t < nt; t += 2) {
            const bool last = (t == nt - 2);
            const char* a1 = Ab + (size_t)(t + 1) * kstep;
            const char* a2 = last ? Ab : Ab + (size_t)(t + 2) * kstep; const char* b2 = last ? nB : cB + (size_t)(t + 2) * kstep;
            const char* a3 = a2 + kstep; const char* b3 = b2 + kstep;
            unsigned va2[2][2];
#pragma unroll
            for (int h = 0; h < 2; ++h)
#pragma unroll
                for (int i = 0; i < 2; ++i) va2[h][i] = last ? nvA[h][i] : vA[h][i];
            G_LDB(B0, 0, 0); G_SCHED; G_LDA(At, 0, 0); G_STAGE(G_SA(1, 1), a1, vA[1]);
            G_WAIT_L(8); G_BAR; G_WAIT_L(0); G_MMA(0, 0, At, B0); G_BAR; G_SCHED;
            G_LDB(B1, 0, 1); G_STAGE(G_SB(0, 0), b2, voffB);
            G_BAR; G_WAIT_L(0); G_MMA(0, 1, At, B1); G_BAR;
            G_LDA(At, 0, 1); G_STAGE(G_SA(0, 0), a2, va2[0]);
            G_BAR; G_WAIT_L(0); G_MMA(1, 0, At, B0); G_BAR; G_SCHED;
            G_STAGE(G_SB(0, 1), b2 + hstepB, voffB);
            G_WAIT_V(6); G_BAR; G_MMA(1, 1, At, B1); G_BAR;
            G_LDB(B0, 1, 0); G_SCHED; G_LDA(At, 1, 0); G_STAGE(G_SA(0, 1), a2, va2[1]);
            G_WAIT_L(8); G_BAR; G_WAIT_L(0); G_MMA(0, 0, At, B0); G_BAR; G_SCHED;
            G_LDB(B1, 1, 1); G_STAGE(G_SB(1, 0), b3, voffB);
            G_BAR; G_WAIT_L(0); G_MMA(0, 1, At, B1); G_BAR;
            G_LDA(At, 1, 1); G_STAGE(G_SA(1, 0), a3, va2[0]);
            G_BAR; G_WAIT_L(0); G_MMA(1, 0, At, B0); G_BAR; G_SCHED;
            G_STAGE(G_SB(1, 1), b3 + hstepB, voffB);
            G_WAIT_V(6); G_BAR; G_MMA(1, 1, At, B1); G_BAR;
        }
        d.epi(acc, cur, wr, wc, fr, fq);
        if (!has_next) break;
#pragma unroll
        for (int a_ = 0; a_ < 2; ++a_)
#pragma unroll
            for (int b_ = 0; b_ < 2; ++b_)
#pragma unroll
                for (int m = 0; m < 4; ++m)
#pragma unroll
                    for (int n = 0; n < 2; ++n) acc[a_][b_][m][n] = (f32x4){0.f, 0.f, 0.f, 0.f};
        cur = nxt; cB = nB; ui += (int)gridDim.x;
#pragma unroll
        for (int h = 0; h < 2; ++h)
#pragma unroll
            for (int i = 0; i < 2; ++i) vA[h][i] = nvA[h][i];
    }
    G_WAIT_V(0);
    if (wr == 0) G_BAR;
    G_BAR;
#undef G_SA
#undef G_SB
#undef G_STAGE
#undef G_LDA
#undef G_LDB
#undef G_MMA
#undef G_WAIT_V
#undef G_WAIT_L
#undef G_BAR
#undef G_SCHED
}
template <int BIT, class DS_>
__device__ __forceinline__ void gemm_run(unsigned char* lds, const DS_& d) {
    if constexpr ((NAIVE_MASK >> BIT) & 1) gemm_naive(d); else gemm_fast<DS_::FP8>((LAS unsigned char*)lds, d);
}

__device__ __forceinline__ bool static_order(int L, int nM, int nN, int& pm, int& pn) {
    const int nwg = nM * nN; if (L >= nwg) return false;
    int wgid = L; { const int q = nwg / 8, r = nwg % 8, xcd = wgid % 8, off = wgid / 8; wgid = (xcd < r ? xcd * (q + 1) : r * (q + 1) + (xcd - r) * q) + off; }
    const int nig = 8 * nN, gid = wgid / nig, fm = gid * 8, gsz = (nM - fm) < 8 ? (nM - fm) : 8;
    pm = fm + ((wgid % nig) % gsz); pn = (wgid % nig) / gsz; return true;
}

#define EPI_LOOP_BEGIN _Pragma("unroll") for (int ai = 0; ai < 2; ++ai) _Pragma("unroll") for (int m = 0; m < 4; ++m) { const int lr = 128 * ai + 64 * wr + 16 * m + fr; \
    _Pragma("unroll") for (int bj = 0; bj < 2; ++bj) { const int lc = 128 * bj + 32 * wc + 8 * fq; const f32x4 v0 = acc[ai][bj][m][0], v1 = acc[ai][bj][m][1];
#define EPI_LOOP_END } }
__device__ __forceinline__ u32x4 pack8(const f32x4 a, const f32x4 b) { u32x4 w; w.x = cvt_pk_bf16(a[0], a[1]); w.y = cvt_pk_bf16(a[2], a[3]); w.z = cvt_pk_bf16(b[0], b[1]); w.w = cvt_pk_bf16(b[2], b[3]); return w; }

struct DescProj {
    static constexpr bool FP8 = false;
    const char* A; const char* Bt; bf16_t* O; bf16_t* A2; int K, ldb;
    __device__ bool get(int i, Unit& u) const { int pm, pn; if (i >= 512 * ((0) == PROBE_GEMM ? PROBE_REP : 1)) return false; i %= 512; if (!static_order(i, T / 256, D / 256, pm, pn)) return false; u.r0 = pm * 256; u.c0 = pn * 256; u.e = 0; u.pad = 0; return true; }
    __device__ unsigned a_off(const Unit& u, int r) const { return (unsigned)(u.r0 + r) * (unsigned)(D * 2); }
    __device__ const char* b_ptr(const Unit& u) const { return Bt + (size_t)u.c0 * D * 2; }
    __device__ void epi(const f32x4 (&acc)[2][2][4][2], const Unit& u, int wr, int wc, int fr, int fq) const {
        EPI_LOOP_BEGIN
            const u32x4 w = pack8(v0, v1);
            const int t = u.r0 + lr, nn = u.c0 + lc;
            if (u.c0 < DP) *(u32x4*)(O + (size_t)t * D + nn) = w;
            else { const int g = (nn - DP) >> 4, co = (nn - DP) & 15; *(u32x4*)(A2 + ((size_t)(g * 1024 + (t >> 4))) * 512 + (t & 15) * 16 + co) = w; }
        EPI_LOOP_END
    }
};
struct DescS1 {
    static constexpr bool FP8 = false;
    const char* A; const char* Bt; bf16_t* O; int job; int K, ldb;
    __device__ bool get(int i, Unit& u) const { const int k = i / (int)gridDim.x; if (k >= 2) return false; u.e = job >> 1; u.r0 = (job & 1) * 512 + k * 256; u.c0 = 0; u.pad = 0; return true; }
    __device__ unsigned a_off(const Unit& u, int r) const { return (unsigned)(u.e * 1024 + u.r0 + r) * 1024u; }
    __device__ const char* b_ptr(const Unit& u) const { return Bt + (size_t)u.e * 256 * 256 * 2; }
    __device__ void epi(const f32x4 (&acc)[2][2][4][2], const Unit& u, int wr, int wc, int fr, int fq) const {
        EPI_LOOP_BEGIN
            *(u32x4*)(O + ((size_t)(u.e * 1024 + u.r0 + lr)) * 256 + lc) = pack8(v0, v1);
        EPI_LOOP_END
    }
};
struct DescS2 {
    static constexpr bool FP8 = false;
    const char* A; const char* Bt; bf16_t* O; int job; int K, ldb;
    __device__ bool get(int i, Unit& u) const { const int k = i / (int)gridDim.x; if (k >= 2) return false; u.e = job >> 1; u.r0 = (job & 1) * 512 + k * 256; u.c0 = 0; u.pad = 0; return true; }
    __device__ unsigned a_off(const Unit& u, int r) const { return (unsigned)(u.e * 1024 + u.r0 + r) * 1024u; }
    __device__ const char* b_ptr(const Unit& u) const { return Bt + (size_t)u.e * 256 * 512 * 2; }
    __device__ void epi(const f32x4 (&acc)[2][2][4][2], const Unit& u, int wr, int wc, int fr, int fq) const {
        EPI_LOOP_BEGIN
            const int t = (u.r0 + lr) * 16 + (lc >> 4), co = lc & 15;
            const f32x4 g0 = (f32x4){gelu_tanh(v0[0]), gelu_tanh(v0[1]), gelu_tanh(v0[2]), gelu_tanh(v0[3])}, g1 = (f32x4){gelu_tanh(v1[0]), gelu_tanh(v1[1]), gelu_tanh(v1[2]), gelu_tanh(v1[3])};
            *(u32x4*)(O + (size_t)t * DS + u.e * 16 + co) = pack8(g0, g1);
        EPI_LOOP_END
    }
};
struct DescPool {
    static constexpr bool FP8 = false;
    const char* A; const char* Bt; bf16_t* O; const float* scale; int pb, nP; int K, ldb;
    __device__ bool get(int i, Unit& u) const { const int k = i / (int)gridDim.x, j = pb + k * nP; if (pb < 0 || j >= 256) return false; u.e = j & 3; u.r0 = (j >> 2) * 256; u.c0 = u.e * 256; u.pad = 0; return true; }
    __device__ unsigned a_off(const Unit& u, int r) const { return ((unsigned)(u.r0 + r) * (unsigned)DP + (unsigned)u.e * 256u) * 2u; }
    __device__ const char* b_ptr(const Unit& u) const { return Bt + (size_t)u.e * 256 * 256 * 2; }
    __device__ void epi(const f32x4 (&acc)[2][2][4][2], const Unit& u, int wr, int wc, int fr, int fq) const {
        f32x4 scv[2][2];
#pragma unroll
        for (int bj = 0; bj < 2; ++bj)
#pragma unroll
            for (int n = 0; n < 2; ++n) scv[bj][n] = *(const f32x4*)(scale + u.c0 + 128 * bj + 32 * wc + 8 * fq + 4 * n);
        EPI_LOOP_BEGIN
            *(u32x4*)(O + (size_t)(u.r0 + lr) * D + u.c0 + lc) = pack8(v0 * scv[bj][0], v1 * scv[bj][1]);
        EPI_LOOP_END
    }
};
struct DescGlu {
    static constexpr bool FP8 = false;
    const char* A; const char* Bt; bf16_t* O; const float* bias; int K, ldb;
    __device__ bool get(int i, Unit& u) const { int pm, pn; if (i >= 256 * ((2) == PROBE_GEMM ? PROBE_REP : 1)) return false; i %= 256; if (!static_order(i, T / 256, DS / 256, pm, pn)) return false; u.r0 = pm * 256; u.c0 = pn * 256; u.e = 0; u.pad = 0; return true; }
    __device__ unsigned a_off(const Unit& u, int r) const { return (unsigned)(u.r0 + r) * (unsigned)(DS * 2); }
    __device__ const char* b_ptr(const Unit& u) const { return Bt + (size_t)u.c0 * DS * 2; }
    __device__ void epi(const f32x4 (&acc)[2][2][4][2], const Unit& u, int wr, int wc, int fr, int fq) const {
        f32x4 bvv[2][2];
#pragma unroll
        for (int bj = 0; bj < 2; ++bj)
#pragma unroll
            for (int n = 0; n < 2; ++n) bvv[bj][n] = *(const f32x4*)(bias + u.c0 + 128 * bj + 32 * wc + 8 * fq + 4 * n);
        const char* __restrict__ Yp = A + ((size_t)(u.r0 + 64 * wr + fr) * DS + u.c0 + 32 * wc + 8 * fq) * 2;
        u32x4 yq[4][2];
#pragma unroll
        for (int p = 0; p < 4; ++p)
#pragma unroll
            for (int q = 0; q < 2; ++q) yq[p][q] = *(const u32x4*)(Yp + ((size_t)(128 * (p >> 2) + 16 * (p & 3)) * DS) * 2 + q * 256);
#pragma unroll
        for (int rg = 0; rg < 8; ++rg) { const int ai = rg >> 2, m = rg & 3; const int lr = 128 * ai + 64 * wr + 16 * m + fr;
            u32x4 yc[2]; yc[0] = yq[rg & 3][0]; yc[1] = yq[rg & 3][1];
            if (rg < 4) { const int r2 = rg + 4;
#pragma unroll
                for (int q = 0; q < 2; ++q) yq[rg & 3][q] = *(const u32x4*)(Yp + ((size_t)(128 * (r2 >> 2) + 16 * (r2 & 3)) * DS) * 2 + q * 256); }
#pragma unroll
            for (int bj = 0; bj < 2; ++bj) { const int lc = 128 * bj + 32 * wc + 8 * fq; const f32x4 v0 = acc[ai][bj][m][0] + bvv[bj][0], v1 = acc[ai][bj][m][1] + bvv[bj][1]; const u32x4 yw = yc[bj];
                const f32x4 o0 = (f32x4){bflo(yw.x) * sigmoidf_(v0[0]), bfhi(yw.x) * sigmoidf_(v0[1]), bflo(yw.y) * sigmoidf_(v0[2]), bfhi(yw.y) * sigmoidf_(v0[3])};
                const f32x4 o1 = (f32x4){bflo(yw.z) * sigmoidf_(v1[0]), bfhi(yw.z) * sigmoidf_(v1[1]), bflo(yw.w) * sigmoidf_(v1[2]), bfhi(yw.w) * sigmoidf_(v1[3])};
                *(u32x4*)(O + (size_t)(u.r0 + lr) * D + DP + u.c0 + lc) = pack8(o0, o1); } }
    }
};
struct DescOut {
    static constexpr bool FP8 = false;
    const char* A; const char* Bt; bf16_t* O; const float* X; float* ST; int K, ldb;
    __device__ bool get(int i, Unit& u) const { int pm, pn; if (i >= 512 * ((3) == PROBE_GEMM ? PROBE_REP : 1)) return false; i %= 512; if (!static_order(i, T / 256, D / 256, pm, pn)) return false; u.r0 = pm * 256; u.c0 = pn * 256; u.e = 0; u.pad = 0; return true; }
    __device__ unsigned a_off(const Unit& u, int r) const { return (unsigned)(u.r0 + r) * (unsigned)(D * 2); }
    __device__ const char* b_ptr(const Unit& u) const { return Bt + (size_t)u.c0 * D * 2; }
    __device__ void epi(const f32x4 (&acc)[2][2][4][2], const Unit& u, int wr, int wc, int fr, int fq) const {
        const float* __restrict__ Xp = X + (size_t)(u.r0 + 64 * wr + fr) * D + u.c0 + 32 * wc + 8 * fq;
        f32x4 xq[3][4];
#pragma unroll
        for (int p = 0; p < 3; ++p)
#pragma unroll
            for (int q = 0; q < 4; ++q) xq[p][q] = *(const f32x4*)(Xp + (size_t)(128 * (p >> 2) + 16 * (p & 3)) * D + (q >> 1) * 128 + (q & 1) * 4);
#pragma unroll
        for (int rg = 0; rg < 8; ++rg) { const int ai = rg >> 2, m = rg & 3; const int lr = 128 * ai + 64 * wr + 16 * m + fr; float s = 0.f, ss = 0.f;
            f32x4 xc[4];
#pragma unroll
            for (int q = 0; q < 4; ++q) xc[q] = xq[rg % 3][q];
            if (rg < 5) { const int r2 = rg + 3;
#pragma unroll
                for (int q = 0; q < 4; ++q) xq[rg % 3][q] = *(const f32x4*)(Xp + (size_t)(128 * (r2 >> 2) + 16 * (r2 & 3)) * D + (q >> 1) * 128 + (q & 1) * 4); }
#pragma unroll
            for (int bj = 0; bj < 2; ++bj) { const int lc = 128 * bj + 32 * wc + 8 * fq; const size_t o = (size_t)(u.r0 + lr) * D + u.c0 + lc;
                const f32x4 v0 = xc[bj * 2] * ALPHA + acc[ai][bj][m][0], v1 = xc[bj * 2 + 1] * ALPHA + acc[ai][bj][m][1];
                s += ((v0[0] + v0[1]) + (v0[2] + v0[3])) + ((v1[0] + v1[1]) + (v1[2] + v1[3]));
                ss += ((v0[0] * v0[0] + v0[1] * v0[1]) + (v0[2] * v0[2] + v0[3] * v0[3])) + ((v1[0] * v1[0] + v1[1] * v1[1]) + (v1[2] * v1[2] + v1[3] * v1[3]));
                *(u32x4*)(O + o) = pack8(v0, v1); }
            s += __shfl_xor(s, 16); s += __shfl_xor(s, 32); ss += __shfl_xor(ss, 16); ss += __shfl_xor(ss, 32);
            if (fq == 0) *(f32x2*)(ST + ((size_t)(u.r0 + lr) * 32 + (u.c0 >> 8) * 4 + wc) * 2) = (f32x2){s, ss}; }
    }
};
struct MoeTab { const int* tstart; };
__device__ __forceinline__ int moe_expert_of_tile(const int* tstart, int tile) { int e = 0;
#pragma unroll 1
    for (int j = 1; j < NE; ++j) e += (tile >= tstart[j]) ? 1 : 0;
    return e; }
__device__ __forceinline__ bool moe_order(int nt, int npn, int i, int& tile, int& pn) {
    const int G = (int)gridDim.x, r = i / G, b = i - r * G, per = G >> 3, x = b & 7, j = b >> 3;
    const int lo = (x * nt) >> 3, hi = ((x + 1) * nt) >> 3, u = j + per * r;
    if (j >= per || u >= (hi - lo) * npn) return false;
    tile = lo + u / npn; pn = u - (u / npn) * npn; return true;
}
struct DescGU {
    static constexpr bool FP8 = true;
    const char* A; const char* Bt; bf16_t* O; const int* utab; const int* tstart; int K, ldb;
    __device__ bool get(int i, Unit& u) const { int tile, pn; if (!moe_order(tstart[NE], 4, i, tile, pn)) return false; u.r0 = tile * 256; u.c0 = pn * 256; u.e = tstart[256 + tile]; u.pad = i / (int)gridDim.x; return true; }
    __device__ unsigned a_off(const Unit& u, int r) const { return (unsigned)utab[u.pad * 256 + r] * (unsigned)D; }
    __device__ const char* b_ptr(const Unit& u) const { return Bt + ((size_t)u.e * 1024 + u.c0) * D; }
    __device__ void epi(const f32x4 (&acc)[2][2][4][2], const Unit& u, int wr, int wc, int fr, int fq) const {
#pragma unroll
        for (int ai = 0; ai < 2; ++ai)
#pragma unroll
            for (int m = 0; m < 4; ++m) { const int lr = 128 * ai + 64 * wr + 16 * m + fr; f32x4 h[2];
#pragma unroll
                for (int n = 0; n < 2; ++n) { const f32x4 g = acc[ai][0][m][n] * WSCALE_INV, up = acc[ai][1][m][n] * WSCALE_INV;
#pragma unroll
                    for (int j = 0; j < 4; ++j) h[n][j] = g[j] * sigmoidf_(g[j]) * up[j]; }
                u32x2 w; w.x = pk4_fp8(h[0][0], h[0][1], h[0][2], h[0][3]); w.y = pk4_fp8(h[1][0], h[1][1], h[1][2], h[1][3]);
                *(u32x2*)((unsigned char*)O + (size_t)(u.r0 + lr) * DE + (u.c0 >> 1) + 32 * wc + 8 * fq) = w; }
    }
};
struct DescDown {
    static constexpr bool FP8 = true;
    const char* A; const char* Bt; bf16_t* O; const float* gtab; const int* tstart; int K, ldb;
    __device__ bool get(int i, Unit& u) const { int tile, pn; if (!moe_order(tstart[NE], 8, i, tile, pn)) return false; u.r0 = tile * 256; u.c0 = pn * 256; u.pad = i / (int)gridDim.x; u.e = tstart[256 + tile]; return true; }
    __device__ unsigned a_off(const Unit& u, int r) const { return (unsigned)(u.r0 + r) * (unsigned)DE; }
    __device__ const char* b_ptr(const Unit& u) const { return Bt + ((size_t)u.e * D + u.c0) * DE; }
    __device__ void epi(const f32x4 (&acc)[2][2][4][2], const Unit& u, int wr, int wc, int fr, int fq) const {
        float gts[8];
#pragma unroll
        for (int rg = 0; rg < 8; ++rg) gts[rg] = gtab[u.pad * 256 + 128 * (rg >> 2) + 64 * wr + 16 * (rg & 3) + fr];
#pragma unroll
        for (int ai = 0; ai < 2; ++ai)
#pragma unroll
            for (int m = 0; m < 4; ++m) { const int lr = 128 * ai + 64 * wr + 16 * m + fr; const float gt = gts[ai * 4 + m];
#pragma unroll
                for (int bj = 0; bj < 2; ++bj) { const int lc = 128 * bj + 32 * wc + 8 * fq;
                    const f32x4 y0 = acc[ai][bj][m][0] * gt, y1 = acc[ai][bj][m][1] * gt; u32x2 w; w.x = pk4_fp8(y0[0], y0[1], y0[2], y0[3]); w.y = pk4_fp8(y1[0], y1[1], y1[2], y1[3]);
                    *(u32x2*)((unsigned char*)O + (size_t)(u.r0 + lr) * D + u.c0 + lc) = w; } }
    }
};

__device__ __forceinline__ void tr_job(const Args& a, int j, const float*& src, int& lds_, unsigned char*& dst, int& ldd, int& f8) {
    unsigned char* ws = a.ws;
    if (j < 1024) { const int kt = j >> 5, nt = j & 31; src = a.in[1] + (size_t)kt * 64 * D + nt * 64; lds_ = D; dst = ws + WS_WIN + ((size_t)nt * 64 * D + kt * 64) * 2; ldd = D * 2; f8 = 0; return; }
    j -= 1024;
    if (j < 1024) { const int kt = j >> 5, nt = j & 31; src = a.in[14] + (size_t)kt * 64 * D + nt * 64; lds_ = D; dst = ws + WS_WOUT + ((size_t)nt * 64 * D + kt * 64) * 2; ldd = D * 2; f8 = 0; return; }
    j -= 1024;
    if (j < 256) { const int kt = j >> 4, nt = j & 15; src = a.in[12] + (size_t)kt * 64 * DS + nt * 64; lds_ = DS; dst = ws + WS_GLU + ((size_t)nt * 64 * DS + kt * 64) * 2; ldd = DS * 2; f8 = 0; return; }
    j -= 256;
    if (j < 64) { const int g = j >> 4, r = j & 15, kt = r >> 2, nt = r & 3; src = a.in[2] + (size_t)g * 65536 + kt * 64 * 256 + nt * 64; lds_ = 256; dst = ws + WS_POOLW + ((size_t)g * 65536 + nt * 64 * 256 + kt * 64) * 2; ldd = 512; f8 = 0; return; }
    j -= 64;
    if (j < 16384) { const int up = j >= 8192; if (up) j -= 8192; const int e = j >> 8, r = j & 255, kt = r >> 3, nt = r & 7, n0 = nt * 64;
        src = (up ? a.in[22] : a.in[21]) + (size_t)e * D * DE + (size_t)kt * 64 * DE + n0; lds_ = DE;
        const int drow = (n0 >> 7) * 256 + (n0 & 127) + (up ? 128 : 0);
        dst = ws + WS_WGU + ((size_t)e * 1024 + drow) * D + kt * 64; ldd = D; f8 = 1; return; }
    j -= 16384;
    { const int e = j >> 8, r = j & 255, kt = r >> 5, nt = r & 31; src = a.in[23] + (size_t)e * DE * D + (size_t)kt * 64 * D + nt * 64; lds_ = D;
      dst = ws + WS_WD + ((size_t)e * D + nt * 64) * DE + kt * 64; ldd = DE; f8 = 1; }
}
constexpr int TR_JOBS = 1024 + 1024 + 256 + 64 + 16384 + 8192;

__device__ void p0_prepass(const Args& a, unsigned char* lds, int rep) {
    const int tid = threadIdx.x, G = gridDim.x, bid = blockIdx.x;
    unsigned char* ws = a.ws;
    if (rep == 0 || PROBE_P0PART == 1) {
        const f32x4* x4 = (const f32x4*)a.in[0]; u32x4* xb = (u32x4*)(ws + WS_XB);
        const size_t n8 = (size_t)T * D / 8, stride = (size_t)G * 512;
        for (size_t i = (size_t)bid * 512 + tid; i < n8; i += 4 * stride) {
            f32x4 v[8];
#pragma unroll
            for (int q = 0; q < 4; ++q) { const size_t ii = i + q * stride; if (ii < n8) { v[2 * q] = x4[2 * ii]; v[2 * q + 1] = x4[2 * ii + 1]; } }
#pragma unroll
            for (int q = 0; q < 4; ++q) { const size_t ii = i + q * stride; if (ii < n8) { u32x4 o; o.x = cvt_pk_bf16(v[2 * q][0], v[2 * q][1]); o.y = cvt_pk_bf16(v[2 * q][2], v[2 * q][3]);
                o.z = cvt_pk_bf16(v[2 * q + 1][0], v[2 * q + 1][1]); o.w = cvt_pk_bf16(v[2 * q + 1][2], v[2 * q + 1][3]); xb[ii] = o; } }
        }
    }
    if (rep == 0 || PROBE_P0PART == 2) {
        bf16_t* tl = (bf16_t*)lds;
        const int lr = tid >> 4, lc4 = (tid & 15) * 4;
        const int on = tid >> 3, okg = (tid & 7) * 8;
        constexpr int NGRP = TR_JOBS / 8;
        int g_lo, g_hi, g_x = -1;
        if (G == 256) { constexpr int S1 = 11, S2 = 15, REM0 = 128 * S1 + 128 * S2;
            if (bid >= 128) { g_lo = (bid - 128) * S2; g_hi = g_lo + S2; if (REM0 + (bid - 128) < NGRP) g_x = REM0 + (bid - 128); }
            else { g_lo = 128 * S2 + bid * S1; g_hi = g_lo + S1; } }
        else { const int per = (NGRP + G - 1) / G; g_lo = bid * per; g_hi = g_lo + per; if (g_hi > NGRP) g_hi = NGRP; if (g_lo > NGRP) g_lo = NGRP; }
        for (int gi = g_lo; gi <= g_hi; ++gi) {
            int jg; if (gi < g_hi) jg = gi * 8; else { if (g_x < 0) break; jg = g_x * 8; }
            f32x4 v[8][2]; unsigned char* dst[8]; int ldd[8]; int f8[8];
#pragma unroll
            for (int q = 0; q < 8; ++q) { const float* src; int ls; tr_job(a, jg + q, src, ls, dst[q], ldd[q], f8[q]);
                v[q][0] = *(const f32x4*)(src + (size_t)lr * ls + lc4); v[q][1] = *(const f32x4*)(src + (size_t)(lr + 32) * ls + lc4); }
            __syncthreads();
#pragma unroll
            for (int q = 0; q < 8; ++q) { unsigned* t0 = (unsigned*)(tl + q * 64 * 66);
                t0[(lr * 66 + lc4) >> 1] = cvt_pk_bf16(v[q][0][0], v[q][0][1]); t0[((lr * 66 + lc4) >> 1) + 1] = cvt_pk_bf16(v[q][0][2], v[q][0][3]);
                t0[((lr + 32) * 66 + lc4) >> 1] = cvt_pk_bf16(v[q][1][0], v[q][1][1]); t0[(((lr + 32) * 66 + lc4) >> 1) + 1] = cvt_pk_bf16(v[q][1][2], v[q][1][3]); }
            __syncthreads();
#pragma unroll
            for (int q = 0; q < 8; ++q) { const bf16_t* t0 = tl + q * 64 * 66; unsigned f[8];
#pragma unroll
                for (int e = 0; e < 8; ++e) f[e] = t0[(okg + e) * 66 + on];
                if (f8[q]) { u32x2 o; o.x = pk4_fp8(WSCALE * bflo(f[0]), WSCALE * bflo(f[1]), WSCALE * bflo(f[2]), WSCALE * bflo(f[3])); o.y = pk4_fp8(WSCALE * bflo(f[4]), WSCALE * bflo(f[5]), WSCALE * bflo(f[6]), WSCALE * bflo(f[7]));
                    *(u32x2*)(dst[q] + (size_t)on * ldd[q] + okg) = o; }
                else { u32x4 o; o.x = f[0] | (f[1] << 16); o.y = f[2] | (f[3] << 16); o.z = f[4] | (f[5] << 16); o.w = f[6] | (f[7] << 16);
                    *(u32x4*)(dst[q] + (size_t)on * ldd[q] + okg * 2) = o; } }
        }
        __syncthreads();
    }
    if (rep == 0 || PROBE_P0PART == 3)
    {
        f32x2* pw = (f32x2*)lds;
        f32x2* Bb = (f32x2*)(lds + 17408);
        f32x2* Cc = (f32x2*)(lds + 17408 + 16384);
        float* KT = (float*)(lds + 17408 + 16384 + 16640);
        for (int job = bid; job < 2 * NG; job += G) {
            const int g = job >> 1, half = job & 1;
            __syncthreads();
            for (int i = tid; i < 2 * 17 * 64; i += 512) { const int dr = i / (17 * 64), l = (i >> 6) % 17, p = i & 63, ix = (dr * NG + g) * NP + p;
                const float lre = a.in[4][ix], lim = a.in[5][ix], dt = expf(a.in[6][dr * NG + g]);
                const float mg = expf(lre * dt * (float)l); float sn, cs; sincosf(lim * dt * (float)l, &sn, &cs); pw[i] = (f32x2){mg * cs, mg * sn}; }
            for (int i = tid; i < 2 * 64; i += 512) { const int dr = i >> 6, p = i & 63, ix = (dr * NG + g) * NP + p;
                const float lre = a.in[4][ix], lim = a.in[5][ix], dt = expf(a.in[6][dr * NG + g]);
                const float mg = expf(lre * dt), ar = mg * cosf(lim * dt), ai = mg * sinf(lim * dt), den = lre * lre + lim * lim;
                const float zr = ((ar - 1.0f) * lre + ai * lim) / den, zi = (ai * lre - (ar - 1.0f) * lim) / den;
#pragma unroll
                for (int c = 0; c < GC; ++c) { const float br = a.in[7][(size_t)ix * GC + c], bi = a.in[8][(size_t)ix * GC + c]; Bb[i * GC + c] = (f32x2){zr * br - zi * bi, zr * bi + zi * br}; } }
            for (int i = tid; i < 2 * GC * NP; i += 512) { const int dr = i >> 10, r = i & 1023; const size_t o = ((size_t)(dr * NG + g) * GC) * NP + r; Cc[(i >> 6) * 65 + (i & 63)] = (f32x2){a.in[9][o], a.in[10][o]}; }
            __syncthreads();
            { const int dr = tid >> 8, l = (tid >> 4) & 15, co = tid & 15; float ac[16];
#pragma unroll
              for (int c = 0; c < 16; ++c) ac[c] = 0.f;
              for (int p = 0; p < NP; ++p) { const f32x2 cv = Cc[(dr * 16 + co) * 65 + p], wv = pw[(dr * 17 + l) * 64 + p]; const float cr = cv.x * wv.x - cv.y * wv.y, ci = cv.x * wv.y + cv.y * wv.x;
                  const f32x4* bq = (const f32x4*)(Bb + (dr * 64 + p) * 16);
#pragma unroll
                  for (int c = 0; c < 8; ++c) { const f32x4 bv = bq[c]; ac[2 * c] += cr * bv[0] - ci * bv[1]; ac[2 * c + 1] += cr * bv[2] - ci * bv[3]; } }
#pragma unroll
              for (int c = 0; c < 16; ++c) KT[((dr * 16 + l) * 16 + co) * 16 + c] = ac[c]; }
            __syncthreads();
            bf16_t* w2 = (bf16_t*)(ws + WS_W2T) + (size_t)g * 256 * 512;
            for (int it = tid; it < 128 * 64; it += 512) { const int rr = it >> 6, kg = it & 63, n = half * 128 + rr, j = n >> 4, co = n & 15; float f[8];
                if (kg < 32) { const int i = kg >> 1, ci0 = (kg & 1) * 8;
#pragma unroll
                    for (int e = 0; e < 8; ++e) { const int ci = ci0 + e; float v = 0.f;
                        if (i <= j) v += KT[((0 * 16 + (j - i)) * 16 + co) * 16 + ci];
                        if (i >= j) v += KT[((1 * 16 + (i - j)) * 16 + co) * 16 + ci];
                        if (i == j && ci == co) v += a.in[11][g * GC + co];
                        f[e] = v; } }
                else { const int kk = (kg - 32) * 8, dr = kk >> 7, ri = (kk >> 6) & 1, p0 = kk & 63, ex = dr == 0 ? j + 1 : 16 - j;
#pragma unroll
                    for (int e = 0; e < 8; ++e) { const f32x2 cv = Cc[(dr * 16 + co) * 65 + p0 + e], wv = pw[(dr * 17 + ex) * 64 + p0 + e];
                        f[e] = ri == 0 ? (cv.x * wv.x - cv.y * wv.y) : -(cv.x * wv.y + cv.y * wv.x); } }
                u32x4 o; o.x = cvt_pk_bf16(f[0], f[1]); o.y = cvt_pk_bf16(f[2], f[3]); o.z = cvt_pk_bf16(f[4], f[5]); o.w = cvt_pk_bf16(f[6], f[7]);
                *(u32x4*)(w2 + (size_t)n * 512 + kg * 8) = o; }
            bf16_t* w1 = (bf16_t*)(ws + WS_W1T) + (size_t)g * 256 * 256;
            for (int it = tid; it < 128 * 32; it += 512) { const int rr = it >> 5, kg = it & 31, dr = half, ri = rr & 1, p = rr >> 1, i = kg >> 1, ci0 = (kg & 1) * 8, ex = dr == 0 ? 15 - i : i;
                const f32x2 wv = pw[(dr * 17 + ex) * 64 + p]; float f[8];
#pragma unroll
                for (int e = 0; e < 8; ++e) { const f32x2 bv = Bb[(dr * 64 + p) * 16 + ci0 + e]; f[e] = ri == 0 ? (wv.x * bv.x - wv.y * bv.y) : (wv.x * bv.y + wv.y * bv.x); }
                u32x4 o; o.x = cvt_pk_bf16(f[0], f[1]); o.y = cvt_pk_bf16(f[2], f[3]); o.z = cvt_pk_bf16(f[4], f[5]); o.w = cvt_pk_bf16(f[6], f[7]);
                *(u32x4*)(w1 + (size_t)(half * 128 + rr) * 256 + kg * 8) = o; }
            if (tid < 64) ((f32x2*)(ws + WS_SSMP + SSMP_A16))[(half * NG + g) * NP + tid] = pw[(half * 17 + 16) * 64 + tid];
        }
        __syncthreads();
    }
    {
        u32x4* rwf = (u32x4*)(ws + WS_RW);
        for (int i = bid * 512 + tid; i < 8 * 8 * 3 * 64; i += G * 512) {
            const int lane_ = i & 63, f = i >> 6, nt = f % 3, ks = (f / 3) & 7, w = f / 24, n = lane_ & 15, fq = lane_ >> 4, j = nt * 16 + n;
            float wv[8];
#pragma unroll
            for (int e = 0; e < 8; ++e) { const int k = w * 256 + ks * 32 + fq * 8 + e; wv[e] = j < 4 ? a.in[17][k * 4 + j] : (j < NR ? a.in[19][k * NE + (j - 4)] : 0.f); }
            u32x4 hi; hi.x = cvt_pk_bf16(wv[0], wv[1]); hi.y = cvt_pk_bf16(wv[2], wv[3]); hi.z = cvt_pk_bf16(wv[4], wv[5]); hi.w = cvt_pk_bf16(wv[6], wv[7]);
            u32x4 lo; lo.x = cvt_pk_bf16(wv[0] - bflo(hi.x), wv[1] - bfhi(hi.x)); lo.y = cvt_pk_bf16(wv[2] - bflo(hi.y), wv[3] - bfhi(hi.y));
            lo.z = cvt_pk_bf16(wv[4] - bflo(hi.z), wv[5] - bfhi(hi.z)); lo.w = cvt_pk_bf16(wv[6] - bflo(hi.w), wv[7] - bfhi(hi.w));
            rwf[(size_t)(f * 2 + 0) * 64 + lane_] = hi; rwf[(size_t)(f * 2 + 1) * 64 + lane_] = lo;
        }
    }
}

template <int W>
__device__ __forceinline__ void pooldiff_item(const bf16_t* proj, bf16_t* dp, int t, int c8) {
    const int s = t & (S - 1);
    const bf16_t* base = proj + (size_t)t * D + c8;
    float sum[8];
#pragma unroll
    for (int e = 0; e < 8; ++e) sum[e] = 0.f;
    u32x4 self;
#pragma unroll
    for (int q = -W / 2; q < W / 2; ++q) { const bool ok = (s + q >= 0) && (s + q < S);
        u32x4 v = (u32x4){0u, 0u, 0u, 0u}; if (ok) v = *(const u32x4*)(base + (ptrdiff_t)q * D);
        if (q == 0) self = v;
#pragma unroll
        for (int e = 0; e < 4; ++e) { sum[2 * e] += bflo(v[e]); sum[2 * e + 1] += bfhi(v[e]); } }
    int lo = s - W / 2, hi = s + W / 2; lo = lo < 0 ? 0 : lo; hi = hi > S ? S : hi;
    const float inv = 1.0f / (float)(hi - lo);
    u32x4 o;
#pragma unroll
    for (int e = 0; e < 4; ++e) o[e] = cvt_pk_bf16(sum[2 * e] * inv - bflo(self[e]), sum[2 * e + 1] * inv - bfhi(self[e]));
    *(u32x4*)(dp + (size_t)t * DP + c8) = o;
}
__device__ void pooldiff_job(const Args& a, int job) {
    const bf16_t* proj = (const bf16_t*)(a.ws + WS_PROJ); bf16_t* dp = (bf16_t*)(a.ws + WS_DPOOL);
    const int g = job & 3, r0 = (job >> 2) * 256;
    for (int i = threadIdx.x; i < 256 * 32; i += 512) {
        const int t = r0 + (i >> 5), c8 = (g * 32 + (i & 31)) * 8;
        if (g == 0) pooldiff_item<2>(proj, dp, t, c8); else if (g == 1) pooldiff_item<4>(proj, dp, t, c8); else if (g == 2) pooldiff_item<8>(proj, dp, t, c8); else pooldiff_item<16>(proj, dp, t, c8);
    }
}

__device__ void ssm_scan(const Args& a, unsigned char* lds, int g, int b) {
    const int tid = threadIdx.x, wid = tid >> 6, lane = tid & 63, p = lane;
    unsigned char* ws = a.ws;
    const unsigned* Sb = (const unsigned*)(ws + WS_S); bf16_t* A2 = (bf16_t*)(ws + WS_A2); const f32x2* a16 = (const f32x2*)(ws + WS_SSMP + SSMP_A16);
    f32x2* F = (f32x2*)lds;
    const f32x2 Af = a16[(0 * NG + g) * NP + p], Ab = a16[(1 * NG + g) * NP + p];
    float pfr = Af.x, pfi = Af.y, pbr = Ab.x, pbi = Ab.y;
#pragma unroll
    for (int q = 0; q < 6; ++q) { const float nr = pfr * pfr - pfi * pfi, ni = 2.0f * pfr * pfi; pfr = nr; pfi = ni; const float mr = pbr * pbr - pbi * pbi, mi = 2.0f * pbr * pbi; pbr = mr; pbi = mi; }
    const unsigned* sp = Sb + ((size_t)(g * 1024 + b * 512 + wid * 64)) * 128 + p;
    float fr_ = 0.f, fi_ = 0.f, br_ = 0.f, bi_ = 0.f;
#pragma unroll 16
    for (int q = 0; q < 64; ++q) { const unsigned wf = sp[q * 128], wb = sp[(63 - q) * 128 + 64];
        const float sfr = bflo(wf), sfi = bfhi(wf), sbr = bflo(wb), sbi = bfhi(wb);
        const float nfr = Af.x * fr_ - Af.y * fi_ + sfr, nfi = Af.x * fi_ + Af.y * fr_ + sfi; fr_ = nfr; fi_ = nfi;
        const float nbr = Ab.x * br_ - Ab.y * bi_ + sbr, nbi = Ab.x * bi_ + Ab.y * br_ + sbi; br_ = nbr; bi_ = nbi; }
    __syncthreads();
    F[wid * 64 + p] = (f32x2){fr_, fi_}; F[512 + wid * 64 + p] = (f32x2){br_, bi_};
    __syncthreads();
    float cfr = 0.f, cfi = 0.f, cbr = 0.f, cbi = 0.f;
    for (int v = 0; v < wid; ++v) { const f32x2 f = F[v * 64 + p]; const float nr = pfr * cfr - pfi * cfi + f.x, ni = pfr * cfi + pfi * cfr + f.y; cfr = nr; cfi = ni; }
    for (int v = 7; v > wid; --v) { const f32x2 f = F[512 + v * 64 + p]; const float nr = pbr * cbr - pbi * cbi + f.x, ni = pbr * cbi + pbi * cbr + f.y; cbr = nr; cbi = ni; }
    fr_ = cfr; fi_ = cfi; br_ = cbr; bi_ = cbi;
    bf16_t* op = A2 + ((size_t)(g * 1024 + b * 512 + wid * 64)) * 512 + 256 + p;
#pragma unroll 16
    for (int q = 0; q < 64; ++q) { const unsigned wf = sp[q * 128], wb = sp[(63 - q) * 128 + 64];
        const float sfr = bflo(wf), sfi = bfhi(wf), sbr = bflo(wb), sbi = bfhi(wb);
        bf16_t* of = op + q * 512; bf16_t* ob = op + (63 - q) * 512 + 128;
        of[0] = (bf16_t)(cvt_pk_bf16(fr_, fr_) & 0xffffu); of[64] = (bf16_t)(cvt_pk_bf16(fi_, fi_) & 0xffffu);
        ob[0] = (bf16_t)(cvt_pk_bf16(br_, br_) & 0xffffu); ob[64] = (bf16_t)(cvt_pk_bf16(bi_, bi_) & 0xffffu);
        const float nfr = Af.x * fr_ - Af.y * fi_ + sfr, nfi = Af.x * fi_ + Af.y * fr_ + sfi; fr_ = nfr; fi_ = nfi;
        const float nbr = Ab.x * br_ - Ab.y * bi_ + sbr, nbi = Ab.x * bi_ + Ab.y * br_ + sbi; br_ = nbr; bi_ = nbi; }
}

__device__ void p5_ln1_router(const Args& a, unsigned char* lds, int rep) {
    const int tid = threadIdx.x, wid = tid >> 6, lane = tid & 63, m = lane & 15, fq = lane >> 4;
    unsigned char* ws = a.ws;
    const bf16_t* __restrict__ v1b = (const bf16_t*)(ws + WS_V1B); const float* __restrict__ stt = (const float*)(ws + WS_ST); bf16_t* __restrict__ h1b = (bf16_t*)(ws + WS_H1B); const u32x4* __restrict__ rwf = (const u32x4*)(ws + WS_RW);
    unsigned char* __restrict__ h1f8 = ws + WS_H1F8;
    if (rep) { h1b = (bf16_t*)(ws + 345 * MB); h1f8 = ws + 409 * MB; }
    const float* g1 = a.in[15]; const float* b1 = a.in[16];
    int* tok_e = (int*)(ws + WS_ROUTE + RT_E); int* tok_rank = (int*)(ws + WS_ROUTE + RT_RANK); float* tok_gate = (float*)(ws + WS_ROUTE + RT_GATE);
    float* PL = (float*)(lds + 1024);
    float* LG = (float*)(lds + 1024 + 24576);
    float* GB = (float*)(lds + 32768);
    int* EL = (int*)(lds + 512);
    unsigned char* gc = (unsigned char*)(ws + WS_GC);
    __syncthreads();
    for (int i = tid; i < D; i += 512) { GB[i] = g1[i]; GB[D + i] = b1[i]; }
    __syncthreads();
    u32x4 vn[8]; f32x4 qn[4];
    { const int grp = blockIdx.x; if (grp < T / 16) { const size_t ro = (size_t)(grp * 16 + m) * D + wid * 256 + fq * 8;
#pragma unroll
        for (int ks = 0; ks < 8; ++ks) vn[ks] = *(const u32x4*)(v1b + ro + ks * 32);
#pragma unroll
        for (int q = 0; q < 4; ++q) qn[q] = *(const f32x4*)(stt + ((size_t)(grp * 16 + m) * 32 + fq * 8) * 2 + q * 4); } }
    for (int grp = blockIdx.x; grp < T / 16; grp += gridDim.x) {
        const int t = grp * 16 + m; const size_t ro = (size_t)t * D + wid * 256 + fq * 8;
        u32x4 v[8]; f32x4 qv[4];
#pragma unroll
        for (int ks = 0; ks < 8; ++ks) v[ks] = vn[ks];
#pragma unroll
        for (int q = 0; q < 4; ++q) qv[q] = qn[q];
        float s = (qv[0][0] + qv[0][2]) + (qv[1][0] + qv[1][2]) + (qv[2][0] + qv[2][2]) + (qv[3][0] + qv[3][2]);
        float ss = (qv[0][1] + qv[0][3]) + (qv[1][1] + qv[1][3]) + (qv[2][1] + qv[2][3]) + (qv[3][1] + qv[3][3]);
        s += __shfl_xor(s, 16); s += __shfl_xor(s, 32); ss += __shfl_xor(ss, 16); ss += __shfl_xor(ss, 32);
        const float mu = s * (1.0f / D); const float rstd = rsqrtf(fmaxf(ss * (1.0f / D) - mu * mu, 0.f) + LN_EPS);
        f32x4 acc[3];
#pragma unroll
        for (int nt = 0; nt < 3; ++nt) acc[nt] = (f32x4){0.f, 0.f, 0.f, 0.f};
        u32x4 wc_[6], wn_[6];
#pragma unroll
        for (int q = 0; q < 6; ++q) wc_[q] = rwf[(size_t)((wid * 8 + 0) * 6 + q) * 64 + lane];
#pragma unroll
        for (int ks = 0; ks < 8; ++ks) {
            if (ks < 7) {
#pragma unroll
                for (int q = 0; q < 6; ++q) wn_[q] = rwf[(size_t)((wid * 8 + ks + 1) * 6 + q) * 64 + lane]; }
            const int kk = wid * 256 + ks * 32 + fq * 8;
            const f32x4 ga = *(const f32x4*)(GB + kk), gb = *(const f32x4*)(GB + kk + 4), ba = *(const f32x4*)(GB + D + kk), bb = *(const f32x4*)(GB + D + kk + 4);
            const f32x4 va = (f32x4){bflo(v[ks].x), bfhi(v[ks].x), bflo(v[ks].y), bfhi(v[ks].y)}, vb = (f32x4){bflo(v[ks].z), bfhi(v[ks].z), bflo(v[ks].w), bfhi(v[ks].w)};
            const f32x4 h0 = (va - mu) * rstd * ga + ba, h1 = (vb - mu) * rstd * gb + bb;
            u32x4 hi; hi.x = cvt_pk_bf16(h0[0], h0[1]); hi.y = cvt_pk_bf16(h0[2], h0[3]); hi.z = cvt_pk_bf16(h1[0], h1[1]); hi.w = cvt_pk_bf16(h1[2], h1[3]);
            *(u32x4*)(h1b + ro + ks * 32) = hi;
            { u32x2 q8; q8.x = pk4_fp8(h0[0], h0[1], h0[2], h0[3]); q8.y = pk4_fp8(h1[0], h1[1], h1[2], h1[3]); *(u32x2*)(h1f8 + ro + ks * 32) = q8; }
            u32x4 lo; lo.x = cvt_pk_bf16(h0[0] - bflo(hi.x), h0[1] - bfhi(hi.x)); lo.y = cvt_pk_bf16(h0[2] - bflo(hi.y), h0[3] - bfhi(hi.y));
            lo.z = cvt_pk_bf16(h1[0] - bflo(hi.z), h1[1] - bfhi(hi.z)); lo.w = cvt_pk_bf16(h1[2] - bflo(hi.w), h1[3] - bfhi(hi.w));
            const bf16x8 ahi = __builtin_bit_cast(bf16x8, hi), alo = __builtin_bit_cast(bf16x8, lo);
#pragma unroll
            for (int nt = 0; nt < 3; ++nt) {
                const bf16x8 whi = __builtin_bit_cast(bf16x8, wc_[nt * 2]), wlo = __builtin_bit_cast(bf16x8, wc_[nt * 2 + 1]);
                acc[nt] = __builtin_amdgcn_mfma_f32_16x16x32_bf16(whi, ahi, acc[nt], 0, 0, 0);
                acc[nt] = __builtin_amdgcn_mfma_f32_16x16x32_bf16(whi, alo, acc[nt], 0, 0, 0);
                acc[nt] = __builtin_amdgcn_mfma_f32_16x16x32_bf16(wlo, ahi, acc[nt], 0, 0, 0); }
#pragma unroll
            for (int q = 0; q < 6; ++q) wc_[q] = wn_[q];
        }
        { const int gn = grp + gridDim.x; if (gn < T / 16) { const size_t rn = (size_t)(gn * 16 + m) * D + wid * 256 + fq * 8;
#pragma unroll
            for (int ks = 0; ks < 8; ++ks) vn[ks] = *(const u32x4*)(v1b + rn + ks * 32);
#pragma unroll
            for (int q = 0; q < 4; ++q) qn[q] = *(const f32x4*)(stt + ((size_t)(gn * 16 + m) * 32 + fq * 8) * 2 + q * 4); } }
#pragma unroll
        for (int nt = 0; nt < 3; ++nt) *(f32x4*)(PL + (wid * 16 + m) * 48 + nt * 16 + fq * 4) = acc[nt];
        __syncthreads();
        for (int i = tid; i < 16 * 48; i += 512) { const int mm = i / 48, j = i - mm * 48; float sm = 0.f;
#pragma unroll
            for (int w = 0; w < 8; ++w) sm += PL[(w * 16 + mm) * 48 + j];
            LG[i] = sm + (j < 4 ? a.in[18][j] : (j < NR ? a.in[20][j - 4] : 0.f)); }
        __syncthreads();
        if (tid < 16 && rep == 0) {
            const float* l = LG + tid * 48;
            const float g0 = l[0], g1v = l[1], g2 = l[2], g3 = l[3];
            int gsel = 0; float gm = g0; if (g1v > gm) { gm = g1v; gsel = 1; } if (g2 > gm) { gm = g2; gsel = 2; } if (g3 > gm) { gm = g3; gsel = 3; }
            const float pg = 1.0f / (expf(g0 - gm) + expf(g1v - gm) + expf(g2 - gm) + expf(g3 - gm));
            float el[8];
#pragma unroll
            for (int i = 0; i < 8; ++i) el[i] = l[4 + gsel * 8 + i];
            int i1 = 0; float m1 = el[0];
#pragma unroll
            for (int i = 1; i < 8; ++i) if (el[i] > m1) { m1 = el[i]; i1 = i; }
            int i2 = -1; float m2 = -3.0e38f;
#pragma unroll
            for (int i = 0; i < 8; ++i) if (i != i1 && el[i] > m2) { m2 = el[i]; i2 = i; }
            const float e2 = expf(m2 - m1), inv = 1.0f / (1.0f + e2);
            const int tt = grp * 16 + tid; const int ea = gsel * 8 + i1, eb = gsel * 8 + i2;
            EL[tid * 2] = ea; EL[tid * 2 + 1] = eb;
            tok_e[tt * 2] = ea; tok_e[tt * 2 + 1] = eb; tok_gate[tt * 2] = pg * inv; tok_gate[tt * 2 + 1] = pg * e2 * inv;
        }
        __syncthreads();
        if (tid < 32 && rep == 0) { const int me = EL[tid]; int r = 0;
            for (int q = 0; q < tid; ++q) r += (EL[q] == me) ? 1 : 0;
            tok_rank[(grp * 16) * 2 + tid] = r; }
        else if (tid >= 32 && tid < 64 && rep == 0) { const int e = tid - 32; int c = 0;
#pragma unroll
            for (int q = 0; q < 32; ++q) c += (EL[q] == e) ? 1 : 0;
            gc[grp * 32 + e] = (unsigned char)c; }
    }
    __syncthreads();
}

__device__ __forceinline__ void moe_build_tab(const Args& a, int* tstart) {
    if (threadIdx.x == 0) { const unsigned* cnt = (const unsigned*)(a.ws + WS_CTL); int acc = 0;
        for (int e = 0; e < NE; ++e) { tstart[e] = acc; acc += ((int)__hip_atomic_load(cnt + e, __ATOMIC_RELAXED, __HIP_MEMORY_SCOPE_AGENT) + 255) >> 8; }
        tstart[NE] = acc; }
    __syncthreads();
    if ((int)threadIdx.x < tstart[NE]) tstart[256 + threadIdx.x] = moe_expert_of_tile(tstart, (int)threadIdx.x);
    __syncthreads();
}

__device__ void p6_slots(const Args& a, unsigned char* lds, int* tstart) {
    const int tid = threadIdx.x;
    unsigned char* ws = a.ws;
    const int* tok_e = (const int*)(ws + WS_ROUTE + RT_E); const int* tok_rank = (const int*)(ws + WS_ROUTE + RT_RANK); const float* tok_gate = (const float*)(ws + WS_ROUTE + RT_GATE);
    int* slot_tok = (int*)(ws + WS_ROUTE + RT_STOK); float* slot_gate = (float*)(ws + WS_ROUTE + RT_SGATE); int* tok_slot = (int*)(ws + WS_ROUTE + RT_SGATE + (size_t)MAXTILES * 256 * 4);
    unsigned char* GC = lds;
    unsigned short* BASE = (unsigned short*)(lds + 32768);
    int* CS = (int*)(lds + 98304);
    int* CNT = (int*)(lds + 98304 + 2048);
    __syncthreads();
    { const u32x4* src = (const u32x4*)(ws + WS_GC); u32x4* dst = (u32x4*)GC;
#pragma unroll
      for (int q = 0; q < 4; ++q) dst[tid + q * 512] = src[tid + q * 512]; }
    __syncthreads();
    const int e = tid & 31, c = tid >> 5;
    { int sm = 0; for (int g = c * 64; g < c * 64 + 64; ++g) sm += GC[g * 32 + e]; CS[e * 16 + c] = sm; }
    __syncthreads();
    if (tid < 32) { int run = 0; for (int q = 0; q < 16; ++q) { const int tmp = CS[tid * 16 + q]; CS[tid * 16 + q] = run; run += tmp; } CNT[tid] = run; }
    __syncthreads();
    if (tid == 0) { int acc = 0; for (int q = 0; q < NE; ++q) { tstart[q] = acc; acc += (CNT[q] + 255) >> 8; } tstart[NE] = acc; }
    __syncthreads();
    if (tid < tstart[NE]) tstart[256 + tid] = moe_expert_of_tile(tstart, tid);
    if (blockIdx.x == 0 && tid < 32) ((unsigned*)(ws + WS_CTL))[tid] = (unsigned)CNT[tid];
    { int run = CS[e * 16 + c]; for (int g = c * 64; g < c * 64 + 64; ++g) { BASE[g * 32 + e] = (unsigned short)run; run += GC[g * 32 + e]; } }
    __syncthreads();
    for (int i = blockIdx.x * 512 + tid; i < T * 2; i += gridDim.x * 512) {
        const int ee = tok_e[i], s = tstart[ee] * 256 + (int)BASE[(i >> 5) * 32 + ee] + tok_rank[i]; slot_tok[s] = i >> 1; slot_gate[s] = tok_gate[i]; tok_slot[i] = s; }
    const int ns = tstart[NE] * 256;
    for (int s = blockIdx.x * 512 + tid; s < ns; s += gridDim.x * 512) {
        const int ee = moe_expert_of_tile(tstart, s >> 8); const int r = s - tstart[ee] * 256;
        if (r >= CNT[ee]) { slot_tok[s] = -1; slot_gate[s] = 0.f; } }
    __syncthreads();
}

__device__ __forceinline__ void fp8x8_acc(const u32x2 w, float (&f)[8]) {
    const f32x2 a = __builtin_amdgcn_cvt_pk_f32_fp8((int)w.x, false), b = __builtin_amdgcn_cvt_pk_f32_fp8((int)w.x, true), c = __builtin_amdgcn_cvt_pk_f32_fp8((int)w.y, false), d = __builtin_amdgcn_cvt_pk_f32_fp8((int)w.y, true);
    f[0] += a[0]; f[1] += a[1]; f[2] += b[0]; f[3] += b[1]; f[4] += c[0]; f[5] += c[1]; f[6] += d[0]; f[7] += d[1];
}
__device__ void p9_ln2(const Args& a, const int* tstart, int rep) {
    const int tid = threadIdx.x, wid = tid >> 6, lane = tid & 63;
    const float* g2 = a.in[24]; const float* b2 = a.in[25];
    const unsigned char* ys = a.ws + WS_YS; const bf16_t* h1b = (const bf16_t*)(a.ws + WS_H1B);
    const int* tok_slot = (const int*)(a.ws + WS_ROUTE + RT_SGATE + (size_t)MAXTILES * 256 * 4);
    const int nw = gridDim.x * 8;
    for (int t = blockIdx.x * 8 + wid; t < T; t += nw) {
        float* roww = rep == 0 ? a.out + (size_t)t * D : (float*)(a.ws + 25 * MB) + (size_t)(t & 4095) * D;
        const size_t sa = (size_t)tok_slot[t * 2] * D, sb = (size_t)tok_slot[t * 2 + 1] * D;
        float h[4][8]; float s = 0.f;
#pragma unroll
        for (int i = 0; i < 4; ++i) { const int k = i * 512 + lane * 8;
            const u32x4 hv = *(const u32x4*)(h1b + (size_t)t * D + k);
            const u32x2 ya = *(const u32x2*)(ys + sa + k), yb = *(const u32x2*)(ys + sb + k);
            float y[8];
#pragma unroll
            for (int e = 0; e < 8; ++e) y[e] = 0.f;
            fp8x8_acc(ya, y); fp8x8_acc(yb, y);
#pragma unroll
            for (int e = 0; e < 4; ++e) { h[i][2 * e] = ALPHA * bflo(hv[e]) + YSCALE_INV * y[2 * e]; h[i][2 * e + 1] = ALPHA * bfhi(hv[e]) + YSCALE_INV * y[2 * e + 1]; }
#pragma unroll
            for (int e = 0; e < 8; ++e) s += h[i][e]; }
        const float mu = wave_sum(s) * (1.0f / D); float vq = 0.f;
#pragma unroll
        for (int i = 0; i < 4; ++i)
#pragma unroll
            for (int e = 0; e < 8; ++e) { const float d = h[i][e] - mu; vq += d * d; }
        const float rstd = rsqrtf(wave_sum(vq) * (1.0f / D) + LN_EPS);
#pragma unroll
        for (int i = 0; i < 4; ++i) { const int k = i * 512 + lane * 8;
            const f32x4 ga = *(const f32x4*)(g2 + k), gb = *(const f32x4*)(g2 + k + 4), ba = *(const f32x4*)(b2 + k), bb = *(const f32x4*)(b2 + k + 4);
            f32x4 o0, o1;
#pragma unroll
            for (int e = 0; e < 4; ++e) { o0[e] = (h[i][e] - mu) * rstd * ga[e] + ba[e]; o1[e] = (h[i][4 + e] - mu) * rstd * gb[e] + bb[e]; }
            *(f32x4*)(roww + k) = o0; *(f32x4*)(roww + k + 4) = o1; }
    }
}

constexpr int NPHASE = 10;
__global__ void __launch_bounds__(512, 2) fwd(Args a) {
    extern __shared__ __attribute__((aligned(16))) unsigned char lds[];
    cg::grid_group grid = cg::this_grid();
    unsigned char* ws = a.ws;
    int* tstart = (int*)(lds + MISC_OFF);
    volatile LAS unsigned* bst = (volatile LAS unsigned*)((LAS unsigned char*)lds + MISC_OFF + 256);
    if (threadIdx.x < 4) bst[threadIdx.x] = 0u;
    __syncthreads();
    XcdBarrier xbar = xcd_barrier_post((unsigned*)(ws + WS_BAR), bst);
    if (a.ph_hi > 1000) grid.sync();
#define IN(k) (a.ph_lo <= (k) && (k) < a.ph_hi)
    volatile unsigned long long* tsv = (volatile unsigned long long*)(lds + MISC_OFF + 512);
#define TS_START(k) do { if ((k) == PROBE_TS_A && blockIdx.x == PROBE_BLK && threadIdx.x == 0) tsv[0] = __builtin_amdgcn_s_memrealtime(); } while (0)
#define TS_END(k) do { if ((k) == PROBE_TS_B && blockIdx.x == PROBE_BLK && threadIdx.x == 0) tsv[1] = __builtin_amdgcn_s_memrealtime(); } while (0)
#define SEAM(k) do { if (IN(k) && IN((k) + 1)) xcd_barrier(xbar); } while (0)
    for (int q = 0; q < PROBE_SYNC; ++q) xcd_barrier(xbar);
    TS_START(0);
    if (IN(0)) for (int rep = 0; rep < (0 == PROBE_PHASE ? PROBE_REP : 1); ++rep) p0_prepass(a, lds, rep);
    SEAM(0); TS_END(0);
    TS_START(1);
    if (IN(1)) { DescProj d{(const char*)(ws + WS_XB), (const char*)(ws + WS_WIN), (bf16_t*)(ws + WS_PROJ), (bf16_t*)(ws + WS_A2), D, D}; gemm_run<0>(lds, d); }
    SEAM(1); TS_END(1);
    TS_START(2);
    if (IN(2)) {
        const int G_ = (int)gridDim.x, nS = 128, nP_ = G_ - nS, bx = (int)blockIdx.x;
        if (bx < nS) {
            const int job = bx;
            TS_START(20);
            { DescS1 d{(const char*)(ws + WS_A2), (const char*)(ws + WS_W1T), (bf16_t*)(ws + WS_S), job, 256, 256}; gemm_run<6>(lds, d);
              if (PROBE_DUP) { asm volatile("s_waitcnt vmcnt(0)" ::: "memory"); __syncthreads(); TS_START(30); for (int q = 0; q < PROBE_DUP; ++q) gemm_run<6>(lds, d); TS_END(30); } }
            asm volatile("s_waitcnt vmcnt(0)" ::: "memory"); __syncthreads(); TS_END(21); TS_START(21);
            ssm_scan(a, lds, job >> 1, job & 1);
            asm volatile("s_waitcnt vmcnt(0)" ::: "memory"); __syncthreads(); TS_END(22); TS_START(22);
            { DescS2 d{(const char*)(ws + WS_A2), (const char*)(ws + WS_W2T), (bf16_t*)(ws + WS_YSSM), job, 512, 512}; gemm_run<7>(lds, d); }
            TS_END(23);
        } else {
            const int pb = bx - nS;
            TS_START(24);
            for (int j = pb; j < 256; j += nP_) pooldiff_job(a, j);
            asm volatile("s_waitcnt vmcnt(0)" ::: "memory"); __syncthreads(); TS_END(24); TS_START(25);
            { DescPool d{(const char*)(ws + WS_DPOOL), (const char*)(ws + WS_POOLW), (bf16_t*)(ws + WS_XB), a.in[3], pb, nP_, 256, 256}; gemm_run<1>(lds, d); }
            TS_END(25);
        }
    }
    SEAM(2); TS_END(2);
    TS_START(3);
    if (IN(3)) { DescGlu d{(const char*)(ws + WS_YSSM), (const char*)(ws + WS_GLU), (bf16_t*)(ws + WS_XB), a.in[13], DS, DS}; gemm_run<2>(lds, d); }
    SEAM(3); TS_END(3);
    TS_START(4);
    if (IN(4)) { DescOut d{(const char*)(ws + WS_XB), (const char*)(ws + WS_WOUT), (bf16_t*)(ws + WS_V1B), a.in[0], (float*)(ws + WS_ST), D, D}; gemm_run<3>(lds, d); }
    SEAM(4); TS_END(4);
    TS_START(5);
    if (IN(5)) for (int rep = 0; rep < (5 == PROBE_PHASE ? PROBE_REP : 1); ++rep) p5_ln1_router(a, lds, rep);
    SEAM(5); TS_END(5);
    TS_START(6);
    if (IN(6)) { for (int rep = 0; rep < (6 == PROBE_PHASE ? PROBE_REP : 1); ++rep) p6_slots(a, lds, tstart); }
    SEAM(6); TS_END(6);
    TS_START(7);
    if (IN(7)) { moe_build_tab(a, tstart);
        int* utab = (int*)(lds + UTAB_OFF); const int* slot_tok = (const int*)(ws + WS_ROUTE + RT_STOK);
        for (int k = 0; k < 8; ++k) { int tile, pn; if (!moe_order(tstart[NE], 4, (int)blockIdx.x + k * (int)gridDim.x, tile, pn)) break;
            if (threadIdx.x < 256) { const int t = slot_tok[tile * 256 + threadIdx.x]; utab[k * 256 + threadIdx.x] = t < 0 ? 0 : t; } }
        __syncthreads();
        DescGU d{(const char*)(ws + WS_H1F8), (const char*)(ws + WS_WGU), (bf16_t*)(ws + WS_HH), utab, tstart, D / 2, D / 2}; gemm_run<4>(lds, d); }
    SEAM(7); TS_END(7);
    TS_START(8);
    if (IN(8)) { moe_build_tab(a, tstart);
        float* gtab = (float*)(lds + UTAB_OFF); const float* slot_gate = (const float*)(ws + WS_ROUTE + RT_SGATE);
        for (int k = 0; k < 8; ++k) { int tile, pn; if (!moe_order(tstart[NE], 8, (int)blockIdx.x + k * (int)gridDim.x, tile, pn)) break;
            if (threadIdx.x < 256) gtab[k * 256 + threadIdx.x] = slot_gate[tile * 256 + threadIdx.x] * (WSCALE_INV * YSCALE); }
        __syncthreads();
        DescDown d{(const char*)(ws + WS_HH), (const char*)(ws + WS_WD), (bf16_t*)(ws + WS_YS), gtab, tstart, DE / 2, DE / 2}; gemm_run<5>(lds, d); }
    SEAM(8); TS_END(8);
    TS_START(9);
    if (IN(9)) { moe_build_tab(a, tstart); for (int rep = 0; rep < (9 == PROBE_PHASE ? PROBE_REP : 1); ++rep) p9_ln2(a, tstart, rep); }
    TS_END(9);
    if (PROBE_TS_A >= 0 && blockIdx.x == PROBE_BLK && threadIdx.x == 0) { const unsigned long long dt = tsv[1] - tsv[0], te = __builtin_amdgcn_s_memrealtime(); while (__builtin_amdgcn_s_memrealtime() - te < 4ull * dt) __builtin_amdgcn_s_sleep(32); }
#undef IN
#undef SEAM
}

extern "C" void kernel_launch(void* const* d_in, const int* in_sizes, int n_in, void* d_out, int out_size, void* d_ws, size_t ws_size, hipStream_t stream) {
    static int grid = 0;
    if (grid == 0) {
        if (n_in != 26 || out_size != T * D || ws_size < WS_END) { fprintf(stderr, "kernel_launch: unexpected shapes (n_in %d out %d ws %zu)\n", n_in, out_size, ws_size); grid = -1; return; }
        int dev = 0, cus = 0, per_cu = 0;
        (void)hipGetDevice(&dev); (void)hipDeviceGetAttribute(&cus, hipDeviceAttributeMultiprocessorCount, dev);
        (void)hipFuncSetAttribute((const void*)fwd, hipFuncAttributeMaxDynamicSharedMemorySize, LDS_BYTES);
        (void)hipOccupancyMaxActiveBlocksPerMultiprocessor(&per_cu, (const void*)fwd, 512, LDS_BYTES);
        if (per_cu < 1) { fprintf(stderr, "kernel_launch: occupancy query says %d blocks/CU\n", per_cu); per_cu = 1; }
        grid = cus;
        if (grid < 256) { fprintf(stderr, "kernel_launch: built for >= 256 CUs (got %d)\n", grid); grid = -1; return; }
    }
    if (grid < 0) return;
    (void)hipMemsetAsync((char*)d_ws + WS_CTL, 0, CTL_ZERO_BYTES, stream);
    Args a{};
    for (int i = 0; i < 26; ++i) a.in[i] = (const float*)d_in[i];
    a.out = (float*)d_out; a.ws = (unsigned char*)d_ws;
#if N_LAUNCH_MODE == 0
    a.ph_lo = 0; a.ph_hi = NPHASE;
    void* args[] = {&a};
    hipError_t e = hipLaunchCooperativeKernel((const void*)fwd, dim3(grid), dim3(512), args, LDS_BYTES, stream);
    if (e != hipSuccess) fprintf(stderr, "cooperative launch failed: %s (grid %d)\n", hipGetErrorString(e), grid);
#else
    for (int p = 0; p < NPHASE; ++p) { a.ph_lo = p; a.ph_hi = p + 1; hipLaunchKernelGGL(fwd, dim3(grid), dim3(512), LDS_BYTES, stream, a); }
#endif
}
```

```cpp
#include <hip/hip_runtime.h>
#include <hip/hip_cooperative_groups.h>
#include <cstdio>
namespace cg = cooperative_groups;

#ifndef N_LAUNCH_MODE
#define N_LAUNCH_MODE 0
#endif
#ifndef PROBE_PHASE
#define PROBE_PHASE -1
#endif
#ifndef PROBE_REP
#define PROBE_REP 1
#endif
#ifndef PROBE_SYNC
#define PROBE_SYNC 0
#endif
#ifndef PROBE_TS_A
#define PROBE_TS_A -1
#endif
#ifndef PROBE_TS_B
#define PROBE_TS_B -1
#endif
#ifndef PROBE_NOSTORE
#define PROBE_NOSTORE 0
#endif
#ifndef PROBE_P0PART
#define PROBE_P0PART 0
#endif
#ifndef PROBE_BLK
#define PROBE_BLK 0
#endif
#ifndef PROBE_DUP
#define PROBE_DUP 0
#endif
#ifndef PROBE_GEMM
#define PROBE_GEMM -1
#endif
#ifndef NAIVE_MASK
#define NAIVE_MASK 0x00
#endif

typedef unsigned short bf16_t;
typedef short bf16x8 __attribute__((ext_vector_type(8)));
typedef float f32x4 __attribute__((ext_vector_type(4)));
typedef float f32x2 __attribute__((ext_vector_type(2)));
typedef unsigned u32x4 __attribute__((ext_vector_type(4)));
typedef unsigned u32x2 __attribute__((ext_vector_type(2)));
typedef int i32x8 __attribute__((ext_vector_type(8)));
typedef int i32x4 __attribute__((ext_vector_type(4)));

constexpr int T = 16384, D = 2048, S = 8192, NB = 2;
constexpr int DP = 1024, DS = 1024, NG = 64, GC = 16, NP = 64;
constexpr int NE = 32, DE = 512, NR = 36;
constexpr int MAXTILES = 161;
constexpr float LN_EPS = 1e-5f;
constexpr float ALPHA = 1.189207115002721f;
constexpr float WSCALE = 32.0f, WSCALE_INV = 1.0f / 32.0f;
constexpr float YSCALE = 64.0f, YSCALE_INV = 1.0f / 64.0f;

constexpr size_t MB = 1u << 20;
constexpr size_t WS_CTL = 0;
constexpr size_t WS_BAR = 65536;
constexpr size_t CTL_ZERO_BYTES = 131072;
constexpr size_t WS_YS = 281 * MB;
constexpr size_t WS_H1B = 217 * MB;
constexpr size_t WS_V1B = 281 * MB;
constexpr size_t WS_ST = 484 * MB;
constexpr size_t WS_S = 89 * MB;
constexpr size_t WS_H1F8 = 89 * MB;
constexpr size_t WS_HH = 442 * MB;
constexpr size_t WS_SSMP = 1 * MB;
constexpr size_t WS_RW = 3 * MB;
constexpr size_t WS_ROUTE = 4 * MB;
constexpr size_t WS_WIN = 6 * MB;
constexpr size_t WS_WOUT = 14 * MB;
constexpr size_t WS_GLU = 22 * MB;
constexpr size_t WS_POOLW = 24 * MB;
constexpr size_t WS_WGU = 25 * MB;
constexpr size_t WS_WD = 121 * MB;
constexpr size_t WS_XB = 153 * MB;
constexpr size_t WS_CC = 217 * MB;
constexpr size_t WS_PROJ = 281 * MB;
constexpr size_t WS_DPOOL = 409 * MB;
constexpr size_t WS_YSSM = 441 * MB;
constexpr size_t WS_A2 = 345 * MB;
constexpr size_t WS_W1T = 484 * MB;
constexpr size_t WS_W2T = 492 * MB;
constexpr size_t WS_END = 508 * MB;
constexpr size_t SSMP_A16 = 1536 * 1024;

constexpr size_t WS_GC = 5 * MB + 512 * 1024;
constexpr size_t RT_E = 0, RT_RANK = (size_t)T * 2 * 4, RT_GATE = (size_t)T * 4 * 4, RT_STOK = (size_t)T * 6 * 4, RT_SGATE = RT_STOK + (size_t)MAXTILES * 256 * 4;

constexpr int LDS_BYTES = 128 * 1024 + 4096 + 8192;
constexpr int UTAB_OFF = 128 * 1024 + 4096;
constexpr int MISC_OFF = 128 * 1024;

struct Args { const float* in[26]; float* out; unsigned char* ws; int ph_lo, ph_hi; };

__device__ __forceinline__ float bf2f(bf16_t b) { return __uint_as_float(((unsigned)b) << 16); }
__device__ __forceinline__ float bflo(unsigned w) { return __uint_as_float(w << 16); }
__device__ __forceinline__ float bfhi(unsigned w) { return __uint_as_float(w & 0xffff0000u); }
__device__ __forceinline__ unsigned cvt_pk_bf16(float lo, float hi) { unsigned r; asm("v_cvt_pk_bf16_f32 %0, %1, %2" : "=v"(r) : "v"(lo), "v"(hi)); return r; }
__device__ __forceinline__ unsigned pk4_fp8(float a, float b, float c, float d) { unsigned w = 0; w = __builtin_amdgcn_cvt_pk_fp8_f32(a, b, w, false); w = __builtin_amdgcn_cvt_pk_fp8_f32(c, d, w, true); return w; }
__device__ __forceinline__ float wave_sum(float v) {
#pragma unroll
    for (int o = 32; o >= 1; o >>= 1) v += __shfl_xor(v, o);
    return v;
}
__device__ __forceinline__ float gelu_tanh(float x) {
    const float u = 0.7978845608028654f * (x + 0.044715f * x * x * x);
    const float e = __expf(-2.0f * fabsf(u));
    float t = (1.0f - e) / (1.0f + e); t = u < 0.f ? -t : t;
    return 0.5f * x * (1.0f + t);
}
__device__ __forceinline__ float sigmoidf_(float z) { return 1.0f / (1.0f + __expf(-z)); }

#define LAS __attribute__((address_space(3)))
#define XB_TMO      128
#define XB_XCNT(j)  (256  + 64 * (j))
#define XB_XSUB(j)  (1280 + 64 * (j))
#define XB_XGEN(j)  (2304 + 64 * (j))
#define XB_TOP      3328
#define XB_TOPGEN   3392
#define XCD_BAR_WORDS 3456
#define XB_SPIN_CAP (1u << 18)
__device__ __forceinline__ unsigned xb_ld(unsigned* p)              { return __hip_atomic_load(p, __ATOMIC_RELAXED, __HIP_MEMORY_SCOPE_AGENT); }
__device__ __forceinline__ unsigned xb_add(unsigned* p, unsigned v) { return __hip_atomic_fetch_add(p, v, __ATOMIC_RELAXED, __HIP_MEMORY_SCOPE_AGENT); }
__device__ __forceinline__ unsigned xb_xcc_id() { return (unsigned)__builtin_amdgcn_s_getreg((3 << 11) | 20) & 0xFu; }
#define XB_SPIN(cond, bar) do { unsigned _sp = 0; while (cond) { __builtin_amdgcn_s_sleep(1); \
    if ((++_sp & 255u) == 0u) { if (xb_ld(&(bar)[XB_TMO])) break; if (_sp > XB_SPIN_CAP) { atomicAdd(&(bar)[XB_TMO], 1u); break; } } } } while (0)
struct XcdBarrier { unsigned* bar; unsigned x; volatile LAS unsigned* st; };
__device__ __forceinline__ XcdBarrier xcd_barrier_post(unsigned* bar, volatile LAS unsigned* st) {
    XcdBarrier b; b.bar = bar; b.x = xb_xcc_id(); b.st = st;
    if (threadIdx.x == 0) (void)xb_add(&bar[XB_XCNT(b.x)], 1u);
    return b;
}
__device__ __forceinline__ void xcd_barrier_complete(unsigned* bar, unsigned x, unsigned& nloc, unsigned& nx) {
    const unsigned G = gridDim.x * gridDim.y * gridDim.z;
    unsigned sum, cnt, mine, sp = 0u;
    for (;;) {
        sum = 0u; cnt = 0u; mine = 0u;
#pragma unroll
        for (unsigned j = 0; j < 16; ++j) { const unsigned c = xb_ld(&bar[XB_XCNT(j)]); sum += c; cnt += (c > 0u) ? 1u : 0u; mine = (j == x) ? c : mine; }
        if (sum == G) break;
        __builtin_amdgcn_s_sleep(1);
        if ((++sp & 255u) == 0u) { if (xb_ld(&bar[XB_TMO])) break; if (sp > XB_SPIN_CAP) { atomicAdd(&bar[XB_TMO], 1u); break; } }
    }
    nloc = mine > 0u ? mine : 1u; nx = cnt > 0u ? cnt : 1u;
}
__device__ __forceinline__ void xcd_barrier(const XcdBarrier& b) {
    asm volatile("s_waitcnt vmcnt(0)" ::: "memory");
    __syncthreads();
    if (threadIdx.x == 0) {
        unsigned* bar = b.bar;
        __builtin_amdgcn_s_waitcnt(0);
        unsigned nloc = b.st[0], nx = b.st[1];
        if (nloc == 0u) { xcd_barrier_complete(bar, b.x, nloc, nx); b.st[0] = nloc; b.st[1] = nx; }
        const unsigned old = xb_add(&bar[XB_XSUB(b.x)], 1u);
        const unsigned gen = old / nloc;
        if (old + 1u == (gen + 1u) * nloc) {
            __builtin_amdgcn_fence(__ATOMIC_RELEASE, "agent");
            asm volatile("s_waitcnt vmcnt(0)" ::: "memory");
            const unsigned og = xb_add(&bar[XB_TOP], 1u);
            const unsigned tg = og / nx;
            if (og + 1u == (tg + 1u) * nx) xb_add(&bar[XB_TOPGEN], 1u);
            else XB_SPIN(xb_ld(&bar[XB_TOPGEN]) == tg, bar);
            __builtin_amdgcn_fence(__ATOMIC_ACQUIRE, "agent");
            xb_add(&bar[XB_XGEN(b.x)], 1u);
            asm volatile("s_waitcnt vmcnt(0)" ::: "memory");
        } else {
            XB_SPIN(xb_ld(&bar[XB_XGEN(b.x)]) == gen, bar);
            __builtin_amdgcn_fence(__ATOMIC_ACQUIRE, "agent");
            asm volatile("s_waitcnt vmcnt(0)" ::: "memory");
        }
    }
    __syncthreads();
}

struct Unit { int r0, c0, e, pad; };

template <class DS_>
__device__ void gemm_naive(const DS_& d) {
    const int tid = threadIdx.x, wid = tid >> 6, lane = tid & 63, wr = wid >> 2, wc = wid & 3, fr = lane & 15, fq = lane >> 4;
    const int K = d.K; const size_t ldb2 = (size_t)d.ldb * 2;
    for (int ui = blockIdx.x;; ui += gridDim.x) {
        Unit u; if (!d.get(ui, u)) break;
        f32x4 acc[2][2][4][2];
        const char* Bp = d.b_ptr(u);
#pragma unroll
        for (int ai = 0; ai < 2; ++ai)
#pragma unroll
            for (int m = 0; m < 4; ++m) {
                const int r = 128 * ai + 64 * wr + 16 * m + fr;
                const char* ap = d.A + d.a_off(u, r);
#pragma unroll
                for (int bj = 0; bj < 2; ++bj)
#pragma unroll
                    for (int n = 0; n < 2; ++n) {
                        const int c = 128 * bj + 32 * wc + 8 * fq + 4 * n;
                        const char* bp = Bp + (size_t)c * ldb2;
                        float s0 = 0.f, s1 = 0.f, s2 = 0.f, s3 = 0.f;
                        for (int k = 0; k < K; k += 8) {
                            const u32x4 av = *(const u32x4*)(ap + k * 2);
                            const u32x4 b0 = *(const u32x4*)(bp + k * 2), b1 = *(const u32x4*)(bp + ldb2 + k * 2), b2 = *(const u32x4*)(bp + 2 * ldb2 + k * 2), b3 = *(const u32x4*)(bp + 3 * ldb2 + k * 2);
#pragma unroll
                            for (int j = 0; j < 4; ++j) {
                                const float al = bflo(av[j]), ah = bfhi(av[j]);
                                s0 += al * bflo(b0[j]); s0 += ah * bfhi(b0[j]);
                                s1 += al * bflo(b1[j]); s1 += ah * bfhi(b1[j]);
                                s2 += al * bflo(b2[j]); s2 += ah * bfhi(b2[j]);
                                s3 += al * bflo(b3[j]); s3 += ah * bfhi(b3[j]);
                            }
                        }
                        acc[ai][bj][m][n] = (f32x4){s0, s1, s2, s3};
                    }
            }
        d.epi(acc, u, wr, wc, fr, fq);
    }
}

constexpr int BK = 64, HALF = 128, HTB = HALF * BK * 2;
__device__ __forceinline__ int lds_byte(int r, int c) { const int st = (r >> 4) * 2 + (c >> 5), rr = r & 15, cc = c & 31, ob = rr * 64 + cc * 2; return st * 1024 + (ob ^ (((ob >> 9) & 1) << 5)); }
__device__ __forceinline__ int perm32(int rho) { const int n = rho >> 4, i = rho & 15; return 8 * (i >> 2) + 4 * n + (i & 3); }
__device__ __forceinline__ void stage_rc(int b, int& R, int& C) { const int st = b / 1024, sb = b % 1024, swz = sb ^ (((sb >> 9) & 1) << 5); R = (st >> 1) * 16 + swz / 64; C = (st & 1) * 32 + (swz % 64) / 2; }

template <bool FP8, class DS_>
__device__ __forceinline__ void gemm_fast(LAS unsigned char* lds, const DS_& d) {
    const int tid = threadIdx.x, wid = __builtin_amdgcn_readfirstlane(tid >> 6), lane = tid & 63, wr = wid >> 2, wc = wid & 3, fr = lane & 15, fq = lane >> 4;
    const int K = d.K, nt = K / BK;
    int Rr[2], Cc[2]; unsigned voffB[2];
#pragma unroll
    for (int i = 0; i < 2; ++i) { stage_rc(tid * 16 + i * 8192, Rr[i], Cc[i]); const int Rb = (Rr[i] & ~31) + perm32(Rr[i] & 31); voffB[i] = (unsigned)(Rb * d.ldb + Cc[i]) * 2u; }
    const size_t kstep = (size_t)(BK * 2);
    const size_t hstepB = (size_t)HALF * d.ldb * 2;
    const unsigned ldsw = (unsigned)wid * 1024u;
    const int aoff = lds_byte(wr * 64 + fr, fq * 8), boff = lds_byte(wc * 32 + fr, fq * 8);
#define G_SA(b, h) (((b) * 2 + (h)) * HTB)
#define G_SB(b, h) ((4 + (b) * 2 + (h)) * HTB)
#define G_STAGE(bufoff, gbase, voff) do { _Pragma("unroll") for (int _i = 0; _i < 2; ++_i) \
        __builtin_amdgcn_global_load_lds((const unsigned*)((const char*)(gbase) + (voff)[_i]), (LAS unsigned*)(lds + (bufoff) + ldsw + _i * 8192), 16, 0, 0); } while (0)
#define G_LDA(dst, b, h) do { _Pragma("unroll") for (int m = 0; m < 4; ++m) { const i32x4 l0_ = *(const LAS i32x4*)(lds + G_SA(b, h) + aoff + m * 2048), l1_ = *(const LAS i32x4*)(lds + G_SA(b, h) + aoff + m * 2048 + 1024); \
        dst[m] = __builtin_shufflevector(l0_, l1_, 0, 1, 2, 3, 4, 5, 6, 7); } } while (0)
#define G_LDB(dst, b, h) do { _Pragma("unroll") for (int n = 0; n < 2; ++n) { const i32x4 l0_ = *(const LAS i32x4*)(lds + G_SB(b, h) + boff + n * 2048), l1_ = *(const LAS i32x4*)(lds + G_SB(b, h) + boff + n * 2048 + 1024); \
        dst[n] = __builtin_shufflevector(l0_, l1_, 0, 1, 2, 3, 4, 5, 6, 7); } } while (0)
#define G_MMA(ai, bj, At, Bt) do { __builtin_amdgcn_s_setprio(1); _Pragma("unroll") for (int m = 0; m < 4; ++m) _Pragma("unroll") for (int n = 0; n < 2; ++n) { \
        if constexpr (FP8) asm volatile("v_mfma_f32_16x16x128_f8f6f4 %0, %1, %2, %0" : "+v"(acc[ai][bj][m][n]) : "v"(Bt[n]), "v"(At[m])); \
        else { acc[ai][bj][m][n] = __builtin_amdgcn_mfma_f32_16x16x32_bf16(__builtin_bit_cast(bf16x8, __builtin_shufflevector(Bt[n], Bt[n], 0, 1, 2, 3)), __builtin_bit_cast(bf16x8, __builtin_shufflevector(At[m], At[m], 0, 1, 2, 3)), acc[ai][bj][m][n], 0, 0, 0); \
               acc[ai][bj][m][n] = __builtin_amdgcn_mfma_f32_16x16x32_bf16(__builtin_bit_cast(bf16x8, __builtin_shufflevector(Bt[n], Bt[n], 4, 5, 6, 7)), __builtin_bit_cast(bf16x8, __builtin_shufflevector(At[m], At[m], 4, 5, 6, 7)), acc[ai][bj][m][n], 0, 0, 0); } } \
        __builtin_amdgcn_s_setprio(0); } while (0)
#define G_WAIT_V(n) asm volatile("s_waitcnt vmcnt(" #n ")" ::: "memory")
#define G_WAIT_L(n) asm volatile("s_waitcnt lgkmcnt(" #n ")" ::: "memory")
#define G_BAR __builtin_amdgcn_s_barrier()
#define G_SCHED __builtin_amdgcn_sched_barrier(0)
    Unit cur, nxt; int ui = blockIdx.x;
    if (!d.get(ui, cur)) return;
    f32x4 acc[2][2][4][2];
#pragma unroll
    for (int a_ = 0; a_ < 2; ++a_)
#pragma unroll
        for (int b_ = 0; b_ < 2; ++b_)
#pragma unroll
            for (int m = 0; m < 4; ++m)
#pragma unroll
                for (int n = 0; n < 2; ++n) acc[a_][b_][m][n] = (f32x4){0.f, 0.f, 0.f, 0.f};
    i32x8 At[4], B0[2], B1[2];
    unsigned vA[2][2], nvA[2][2];
#pragma unroll
    for (int h = 0; h < 2; ++h)
#pragma unroll
        for (int i = 0; i < 2; ++i) vA[h][i] = d.a_off(cur, h * HALF + Rr[i]) + (unsigned)Cc[i] * 2u;
    const char* const Ab = d.A;
    const char* cB = d.b_ptr(cur);
    G_STAGE(G_SB(0, 0), cB, voffB); G_STAGE(G_SA(0, 0), Ab, vA[0]); G_STAGE(G_SB(0, 1), cB + hstepB, voffB); G_STAGE(G_SA(0, 1), Ab, vA[1]);
    if (wr == 1) G_BAR;
    G_WAIT_V(4); G_BAR;
    G_STAGE(G_SB(1, 0), cB + kstep, voffB); G_STAGE(G_SA(1, 0), Ab + kstep, vA[0]); G_STAGE(G_SB(1, 1), cB + hstepB + kstep, voffB);
    G_WAIT_V(6); G_BAR;
    for (;;) {
        const bool has_next = d.get(ui + (int)gridDim.x, nxt);
        const char* nB = has_next ? d.b_ptr(nxt) : cB;
#pragma unroll
        for (int h = 0; h < 2; ++h)
#pragma unroll
            for (int i = 0; i < 2; ++i) nvA[h][i] = has_next ? (d.a_off(nxt, h * HALF + Rr[i]) + (unsigned)Cc[i] * 2u) : vA[h][i];
        for (int t = 0; t < nt; t += 2) {
            const bool last = (t == nt - 2);
            const char* a1 = Ab + (size_t)(t + 1) * kstep;
            const char* a2 = last ? Ab : Ab + (size_t)(t + 2) * kstep; const char* b2 = last ? nB : cB + (size_t)(t + 2) * kstep;
            const char* a3 = a2 + kstep; const char* b3 = b2 + kstep;
            unsigned va2[2][2];
#pragma unroll
            for (int h = 0; h < 2; ++h)
#pragma unroll
                for (int i = 0; i < 2; ++i) va2[h][i] = last ? nvA[h][i] : vA[h][i];
            G_LDB(B0, 0, 0); G_SCHED; G_LDA(At, 0, 0); G_STAGE(G_SA(1, 1), a1, vA[1]);
            G_WAIT_L(8); G_BAR; G_WAIT_L(0); G_MMA(0, 0, At, B0); G_BAR; G_SCHED;
            G_LDB(B1, 0, 1); G_STAGE(G_SB(0, 0), b2, voffB);
            G_BAR; G_WAIT_L(0); G_MMA(0, 1, At, B1); G_BAR;
            G_LDA(At, 0, 1); G_STAGE(G_SA(0, 0), a2, va2[0]);
            G_BAR; G_WAIT_L(0); G_MMA(1, 0, At, B0); G_BAR; G_SCHED;
            G_STAGE(G_SB(0, 1), b2 + hstepB, voffB);
            G_WAIT_V(6); G_BAR; G_MMA(1, 1, At, B1); G_BAR;
            G_LDB(B0, 1, 0); G_SCHED; G_LDA(At, 1, 0); G_STAGE(G_SA(0, 1), a2, va2[1]);
            G_WAIT_L(8); G_BAR; G_WAIT_L(0); G_MMA(0, 0, At, B0); G_BAR; G_SCHED;
            G_LDB(B1, 1, 1); G_STAGE(G_SB(1, 0), b3, voffB);
            G_BAR; G_WAIT_L(0); G_MMA(0, 1, At, B1); G_BAR;
            G_LDA(At, 1, 1); G_STAGE(G_SA(1, 0), a3, va2[0]);
            G_BAR; G_WAIT_L(0); G_MMA(1, 0, At, B0); G_BAR; G_SCHED;
            G_STAGE(G_SB(1, 1), b3 + hstepB, voffB);
            G_WAIT_V(6); G_BAR; G_MMA(1, 1, At, B1); G_BAR;
        }
        d.epi(acc, cur, wr, wc, fr, fq);
        if (!has_next) break;
#pragma unroll
        for (int a_ = 0; a_ < 2; ++a_)
#pragma unroll
            for (int b_ = 0; b_ < 2; ++b_)
#pragma unroll
                for (int m = 0; m < 4; ++m)
#pragma unroll
                    for (int n = 0; n < 2; ++n) acc[a_][b_][m][n] = (f32x4){0.f, 0.f, 0.f, 0.f};
        cur = nxt; cB = nB; ui += (int)gridDim.x;
#pragma unroll
        for (int h = 0; h < 2; ++h)
#pragma unroll
            for (int i = 0; i < 2; ++i) vA[h][i] = nvA[h][i];
    }
    G_WAIT_V(0);
    if (wr == 0) G_BAR;
    G_BAR;
#undef G_SA
#undef G_SB
#undef G_STAGE
#undef G_LDA
#undef G_LDB
#undef G_MMA
#undef G_WAIT_V
#undef G_WAIT_L
#undef G_BAR
#undef G_SCHED
}
template <int BIT, class DS_>
__device__ __forceinline__ void gemm_run(unsigned char* lds, const DS_& d) {
    if constexpr ((NAIVE_MASK >> BIT) & 1) gemm_naive(d); else gemm_fast<DS_::FP8>((LAS unsigned char*)lds, d);
}

__device__ __forceinline__ bool static_order(int L, int nM, int nN, int& pm, int& pn) {
    const int nwg = nM * nN; if (L >= nwg) return false;
    int wgid = L; { const int q = nwg / 8, r = nwg % 8, xcd = wgid % 8, off = wgid / 8; wgid = (xcd < r ? xcd * (q + 1) : r * (q + 1) + (xcd - r) * q) + off; }
    const int nig = 8 * nN, gid = wgid / nig, fm = gid * 8, gsz = (nM - fm) < 8 ? (nM - fm) : 8;
    pm = fm + ((wgid % nig) % gsz); pn = (wgid % nig) / gsz; return true;
}

#define EPI_LOOP_BEGIN _Pragma("unroll") for (int ai = 0; ai < 2; ++ai) _Pragma("unroll") for (int m = 0; m < 4; ++m) { const int lr = 128 * ai + 64 * wr + 16 * m + fr; \
    _Pragma("unroll") for (int bj = 0; bj < 2; ++bj) { const int lc = 128 * bj + 32 * wc + 8 * fq; const f32x4 v0 = acc[ai][bj][m][0], v1 = acc[ai][bj][m][1];
#define EPI_LOOP_END } }
__device__ __forceinline__ u32x4 pack8(const f32x4 a, const f32x4 b) { u32x4 w; w.x = cvt_pk_bf16(a[0], a[1]); w.y = cvt_pk_bf16(a[2], a[3]); w.z = cvt_pk_bf16(b[0], b[1]); w.w = cvt_pk_bf16(b[2], b[3]); return w; }

struct DescProj {
    static constexpr bool FP8 = false;
    const char* A; const char* Bt; bf16_t* O; bf16_t* A2; int K, ldb;
    __device__ bool get(int i, Unit& u) const { int pm, pn; if (i >= 512 * ((0) == PROBE_GEMM ? PROBE_REP : 1)) return false; i %= 512; if (!static_order(i, T / 256, D / 256, pm, pn)) return false; u.r0 = pm * 256; u.c0 = pn * 256; u.e = 0; u.pad = 0; return true; }
    __device__ unsigned a_off(const Unit& u, int r) const { return (unsigned)(u.r0 + r) * (unsigned)(D * 2); }
    __device__ const char* b_ptr(const Unit& u) const { return Bt + (size_t)u.c0 * D * 2; }
    __device__ void epi(const f32x4 (&acc)[2][2][4][2], const Unit& u, int wr, int wc, int fr, int fq) const {
        EPI_LOOP_BEGIN
            const u32x4 w = pack8(v0, v1);
            const int t = u.r0 + lr, nn = u.c0 + lc;
            if (u.c0 < DP) *(u32x4*)(O + (size_t)t * D + nn) = w;
            else { const int g = (nn - DP) >> 4, co = (nn - DP) & 15; *(u32x4*)(A2 + ((size_t)(g * 1024 + (t >> 4))) * 512 + (t & 15) * 16 + co) = w; }
        EPI_LOOP_END
    }
};
struct DescS1 {
    static constexpr bool FP8 = false;
    const char* A; const char* Bt; bf16_t* O; int job; int K, ldb;
    __device__ bool get(int i, Unit& u) const { const int k = i / (int)gridDim.x; if (k >= 2) return false; u.e = job >> 1; u.r0 = (job & 1) * 512 + k * 256; u.c0 = 0; u.pad = 0; return true; }
    __device__ unsigned a_off(const Unit& u, int r) const { return (unsigned)(u.e * 1024 + u.r0 + r) * 1024u; }
    __device__ const char* b_ptr(const Unit& u) const { return Bt + (size_t)u.e * 256 * 256 * 2; }
    __device__ void epi(const f32x4 (&acc)[2][2][4][2], const Unit& u, int wr, int wc, int fr, int fq) const {
        EPI_LOOP_BEGIN
            *(u32x4*)(O + ((size_t)(u.e * 1024 + u.r0 + lr)) * 256 + lc) = pack8(v0, v1);
        EPI_LOOP_END
    }
};
struct DescS2 {
    static constexpr bool FP8 = false;
    const char* A; const char* Bt; bf16_t* O; int job; int K, ldb;
    __device__ bool get(int i, Unit& u) const { const int k = i / (int)gridDim.x; if (k >= 2) return false; u.e = job >> 1; u.r0 = (job & 1) * 512 + k * 256; u.c0 = 0; u.pad = 0; return true; }
    __device__ unsigned a_off(const Unit& u, int r) const { return (unsigned)(u.e * 1024 + u.r0 + r) * 1024u; }
    __device__ const char* b_ptr(const Unit& u) const { return Bt + (size_t)u.e * 256 * 512 * 2; }
    __device__ void epi(const f32x4 (&acc)[2][2][4][2], const Unit& u, int wr, int wc, int fr, int fq) const {
        EPI_LOOP_BEGIN
            const int t = (u.r0 + lr) * 16 + (lc >> 4), co = lc & 15;
            const f32x4 g0 = (f32x4){gelu_tanh(v0[0]), gelu_tanh(v0[1]), gelu_tanh(v0[2]), gelu_tanh(v0[3])}, g1 = (f32x4){gelu_tanh(v1[0]), gelu_tanh(v1[1]), gelu_tanh(v1[2]), gelu_tanh(v1[3])};
            *(u32x4*)(O + (size_t)t * DS + u.e * 16 + co) = pack8(g0, g1);
        EPI_LOOP_END
    }
};
struct DescPool {
    static constexpr bool FP8 = false;
    const char* A; const char* Bt; bf16_t* O; const float* scale; int pb, nP; int K, ldb;
    __device__ bool get(int i, Unit& u) const { const int k = i / (int)gridDim.x, j = pb + k * nP; if (pb < 0 || j >= 256) return false; u.e = j & 3; u.r0 = (j >> 2) * 256; u.c0 = u.e * 256; u.pad = 0; return true; }
    __device__ unsigned a_off(const Unit& u, int r) const { return ((unsigned)(u.r0 + r) * (unsigned)DP + (unsigned)u.e * 256u) * 2u; }
    __device__ const char* b_ptr(const Unit& u) const { return Bt + (size_t)u.e * 256 * 256 * 2; }
    __device__ void epi(const f32x4 (&acc)[2][2][4][2], const Unit& u, int wr, int wc, int fr, int fq) const {
        f32x4 scv[2][2];
#pragma unroll
        for (int bj = 0; bj < 2; ++bj)
#pragma unroll
            for (int n = 0; n < 2; ++n) scv[bj][n] = *(const f32x4*)(scale + u.c0 + 128 * bj + 32 * wc + 8 * fq + 4 * n);
        EPI_LOOP_BEGIN
            *(u32x4*)(O + (size_t)(u.r0 + lr) * D + u.c0 + lc) = pack8(v0 * scv[bj][0], v1 * scv[bj][1]);
        EPI_LOOP_END
    }
};
struct DescGlu {
    static constexpr bool FP8 = false;
    const char* A; const char* Bt; bf16_t* O; const float* bias; int K, ldb;
    __device__ bool get(int i, Unit& u) const { int pm, pn; if (i >= 256 * ((2) == PROBE_GEMM ? PROBE_REP : 1)) return false; i %= 256; if (!static_order(i, T / 256, DS / 256, pm, pn)) return false; u.r0 = pm * 256; u.c0 = pn * 256; u.e = 0; u.pad = 0; return true; }
    __device__ unsigned a_off(const Unit& u, int r) const { return (unsigned)(u.r0 + r) * (unsigned)(DS * 2); }
    __device__ const char* b_ptr(const Unit& u) const { return Bt + (size_t)u.c0 * DS * 2; }
    __device__ void epi(const f32x4 (&acc)[2][2][4][2], const Unit& u, int wr, int wc, int fr, int fq) const {
        f32x4 bvv[2][2];
#pragma unroll
        for (int bj = 0; bj < 2; ++bj)
#pragma unroll
            for (int n = 0; n < 2; ++n) bvv[bj][n] = *(const f32x4*)(bias + u.c0 + 128 * bj + 32 * wc + 8 * fq + 4 * n);
        const char* __restrict__ Yp = A + ((size_t)(u.r0 + 64 * wr + fr) * DS + u.c0 + 32 * wc + 8 * fq) * 2;
        u32x4 yq[4][2];
#pragma unroll
        for (int p = 0; p < 4; ++p)
#pragma unroll
            for (int q = 0; q < 2; ++q) yq[p][q] = *(const u32x4*)(Yp + ((size_t)(128 * (p >> 2) + 16 * (p & 3)) * DS) * 2 + q * 256);
#pragma unroll
        for (int rg = 0; rg < 8; ++rg) { const int ai = rg >> 2, m = rg & 3; const int lr = 128 * ai + 64 * wr + 16 * m + fr;
            u32x4 yc[2]; yc[0] = yq[rg & 3][0]; yc[1] = yq[rg & 3][1];
            if (rg < 4) { const int r2 = rg + 4;
#pragma unroll
                for (int q = 0; q < 2; ++q) yq[rg & 3][q] = *(const u32x4*)(Yp + ((size_t)(128 * (r2 >> 2) + 16 * (r2 & 3)) * DS) * 2 + q * 256); }
#pragma unroll
            for (int bj = 0; bj < 2; ++bj) { const int lc = 128 * bj + 32 * wc + 8 * fq; const f32x4 v0 = acc[ai][bj][m][0] + bvv[bj][0], v1 = acc[ai][bj][m][1] + bvv[bj][1]; const u32x4 yw = yc[bj];
                const f32x4 o0 = (f32x4){bflo(yw.x) * sigmoidf_(v0[0]), bfhi(yw.x) * sigmoidf_(v0[1]), bflo(yw.y) * sigmoidf_(v0[2]), bfhi(yw.y) * sigmoidf_(v0[3])};
                const f32x4 o1 = (f32x4){bflo(yw.z) * sigmoidf_(v1[0]), bfhi(yw.z) * sigmoidf_(v1[1]), bflo(yw.w) * sigmoidf_(v1[2]), bfhi(yw.w) * sigmoidf_(v1[3])};
                *(u32x4*)(O + (size_t)(u.r0 + lr) * D + DP + u.c0 + lc) = pack8(o0, o1); } }
    }
};
struct DescOut {
    static constexpr bool FP8 = false;
    const char* A; const char* Bt; bf16_t* O; const bf16_t* X; float* ST; int K, ldb;
    __device__ bool get(int i, Unit& u) const { int pm, pn; if (i >= 512 * ((3) == PROBE_GEMM ? PROBE_REP : 1)) return false; i %= 512; if (!static_order(i, T / 256, D / 256, pm, pn)) return false; u.r0 = pm * 256; u.c0 = pn * 256; u.e = 0; u.pad = 0; return true; }
    __device__ unsigned a_off(const Unit& u, int r) const { return (unsigned)(u.r0 + r) * (unsigned)(D * 2); }
    __device__ const char* b_ptr(const Unit& u) const { return Bt + (size_t)u.c0 * D * 2; }
    __device__ void epi(const f32x4 (&acc)[2][2][4][2], const Unit& u, int wr, int wc, int fr, int fq) const {
        const bf16_t* __restrict__ Xp = X + (size_t)(u.r0 + 64 * wr + fr) * D + u.c0 + 32 * wc + 8 * fq;
        u32x4 xq[4][2];
#pragma unroll
        for (int p = 0; p < 4; ++p)
#pragma unroll
            for (int q = 0; q < 2; ++q) xq[p][q] = *(const u32x4*)(Xp + (size_t)(128 * (p >> 2) + 16 * (p & 3)) * D + q * 128);
#pragma unroll
        for (int rg = 0; rg < 8; ++rg) { const int ai = rg >> 2, m = rg & 3; const int lr = 128 * ai + 64 * wr + 16 * m + fr; float s = 0.f, ss = 0.f;
            u32x4 xc[2]; xc[0] = xq[rg & 3][0]; xc[1] = xq[rg & 3][1];
            if (rg < 4) { const int r2 = rg + 4;
#pragma unroll
                for (int q = 0; q < 2; ++q) xq[rg & 3][q] = *(const u32x4*)(Xp + (size_t)(128 * (r2 >> 2) + 16 * (r2 & 3)) * D + q * 128); }
#pragma unroll
            for (int bj = 0; bj < 2; ++bj) { const int lc = 128 * bj + 32 * wc + 8 * fq; const size_t o = (size_t)(u.r0 + lr) * D + u.c0 + lc; const u32x4 xw = xc[bj];
                const f32x4 x0 = (f32x4){bflo(xw.x), bfhi(xw.x), bflo(xw.y), bfhi(xw.y)}, x1 = (f32x4){bflo(xw.z), bfhi(xw.z), bflo(xw.w), bfhi(xw.w)};
                const f32x4 v0 = x0 * ALPHA + acc[ai][bj][m][0], v1 = x1 * ALPHA + acc[ai][bj][m][1];
                s += ((v0[0] + v0[1]) + (v0[2] + v0[3])) + ((v1[0] + v1[1]) + (v1[2] + v1[3]));
                ss += ((v0[0] * v0[0] + v0[1] * v0[1]) + (v0[2] * v0[2] + v0[3] * v0[3])) + ((v1[0] * v1[0] + v1[1] * v1[1]) + (v1[2] * v1[2] + v1[3] * v1[3]));
                *(u32x4*)(O + o) = pack8(v0, v1); }
            s += __shfl_xor(s, 16); s += __shfl_xor(s, 32); ss += __shfl_xor(ss, 16); ss += __shfl_xor(ss, 32);
            if (fq == 0) *(f32x2*)(ST + ((size_t)(u.r0 + lr) * 32 + (u.c0 >> 8) * 4 + wc) * 2) = (f32x2){s, ss}; }
    }
};
struct MoeTab { const int* tstart; };
__device__ __forceinline__ int moe_expert_of_tile(const int* tstart, int tile) { int e = 0;
#pragma unroll 1
    for (int j = 1; j < NE; ++j) e += (tile >= tstart[j]) ? 1 : 0;
    return e; }
__device__ __forceinline__ bool moe_order(int nt, int npn, int i, int& tile, int& pn) {
    const int G = (int)gridDim.x, r = i / G, b = i - r * G, per = G >> 3, x = b & 7, j = b >> 3;
    const int lo = (x * nt) >> 3, hi = ((x + 1) * nt) >> 3, u = j + per * r;
    if (j >= per || u >= (hi - lo) * npn) return false;
    tile = lo + u / npn; pn = u - (u / npn) * npn; return true;
}
struct DescGU {
    static constexpr bool FP8 = true;
    const char* A; const char* Bt; bf16_t* O; const int* utab; const int* tstart; int K, ldb;
    __device__ bool get(int i, Unit& u) const { int tile, pn; if (!moe_order(tstart[NE], 4, i, tile, pn)) return false; u.r0 = tile * 256; u.c0 = pn * 256; u.e = tstart[256 + tile]; u.pad = i / (int)gridDim.x; return true; }
    __device__ unsigned a_off(const Unit& u, int r) const { return (unsigned)utab[u.pad * 256 + r] * (unsigned)D; }
    __device__ const char* b_ptr(const Unit& u) const { return Bt + ((size_t)u.e * 1024 + u.c0) * D; }
    __device__ void epi(const f32x4 (&acc)[2][2][4][2], const Unit& u, int wr, int wc, int fr, int fq) const {
#pragma unroll
        for (int ai = 0; ai < 2; ++ai)
#pragma unroll
            for (int m = 0; m < 4; ++m) { const int lr = 128 * ai + 64 * wr + 16 * m + fr; f32x4 h[2];
#pragma unroll
                for (int n = 0; n < 2; ++n) { const f32x4 g = acc[ai][0][m][n] * WSCALE_INV, up = acc[ai][1][m][n] * WSCALE_INV;
#pragma unroll
                    for (int j = 0; j < 4; ++j) h[n][j] = g[j] * sigmoidf_(g[j]) * up[j]; }
                u32x2 w; w.x = pk4_fp8(h[0][0], h[0][1], h[0][2], h[0][3]); w.y = pk4_fp8(h[1][0], h[1][1], h[1][2], h[1][3]);
                *(u32x2*)((unsigned char*)O + (size_t)(u.r0 + lr) * DE + (u.c0 >> 1) + 32 * wc + 8 * fq) = w; }
    }
};
struct DescDown {
    static constexpr bool FP8 = true;
    const char* A; const char* Bt; bf16_t* O; const float* gtab; const int* tstart; int K, ldb;
    __device__ bool get(int i, Unit& u) const { int tile, pn; if (!moe_order(tstart[NE], 8, i, tile, pn)) return false; u.r0 = tile * 256; u.c0 = pn * 256; u.pad = i / (int)gridDim.x; u.e = tstart[256 + tile]; return true; }
    __device__ unsigned a_off(const Unit& u, int r) const { return (unsigned)(u.r0 + r) * (unsigned)DE; }
    __device__ const char* b_ptr(const Unit& u) const { return Bt + ((size_t)u.e * D + u.c0) * DE; }
    __device__ void epi(const f32x4 (&acc)[2][2][4][2], const Unit& u, int wr, int wc, int fr, int fq) const {
        float gts[8];
#pragma unroll
        for (int rg = 0; rg < 8; ++rg) gts[rg] = gtab[u.pad * 256 + 128 * (rg >> 2) + 64 * wr + 16 * (rg & 3) + fr];
#pragma unroll
        for (int ai = 0; ai < 2; ++ai)
#pragma unroll
            for (int m = 0; m < 4; ++m) { const int lr = 128 * ai + 64 * wr + 16 * m + fr; const float gt = gts[ai * 4 + m];
#pragma unroll
                for (int bj = 0; bj < 2; ++bj) { const int lc = 128 * bj + 32 * wc + 8 * fq;
                    const f32x4 y0 = acc[ai][bj][m][0] * gt, y1 = acc[ai][bj][m][1] * gt; u32x2 w; w.x = pk4_fp8(y0[0], y0[1], y0[2], y0[3]); w.y = pk4_fp8(y1[0], y1[1], y1[2], y1[3]);
                    *(u32x2*)((unsigned char*)O + (size_t)(u.r0 + lr) * D + u.c0 + lc) = w; } }
    }
};

__device__ __forceinline__ void tr_job(const Args& a, int j, const float*& src, int& lds_, unsigned char*& dst, int& ldd, int& f8) {
    unsigned char* ws = a.ws;
    if (j < 1024) { const int kt = j >> 5, nt = j & 31; src = a.in[1] + (size_t)kt * 64 * D + nt * 64; lds_ = D; dst = ws + WS_WIN + ((size_t)nt * 64 * D + kt * 64) * 2; ldd = D * 2; f8 = 0; return; }
    j -= 1024;
    if (j < 1024) { const int kt = j >> 5, nt = j & 31; src = a.in[14] + (size_t)kt * 64 * D + nt * 64; lds_ = D; dst = ws + WS_WOUT + ((size_t)nt * 64 * D + kt * 64) * 2; ldd = D * 2; f8 = 0; return; }
    j -= 1024;
    if (j < 256) { const int kt = j >> 4, nt = j & 15; src = a.in[12] + (size_t)kt * 64 * DS + nt * 64; lds_ = DS; dst = ws + WS_GLU + ((size_t)nt * 64 * DS + kt * 64) * 2; ldd = DS * 2; f8 = 0; return; }
    j -= 256;
    if (j < 64) { const int g = j >> 4, r = j & 15, kt = r >> 2, nt = r & 3; src = a.in[2] + (size_t)g * 65536 + kt * 64 * 256 + nt * 64; lds_ = 256; dst = ws + WS_POOLW + ((size_t)g * 65536 + nt * 64 * 256 + kt * 64) * 2; ldd = 512; f8 = 0; return; }
    j -= 64;
    if (j < 16384) { const int up = j >= 8192; if (up) j -= 8192; const int e = j >> 8, r = j & 255, kt = r >> 3, nt = r & 7, n0 = nt * 64;
        src = (up ? a.in[22] : a.in[21]) + (size_t)e * D * DE + (size_t)kt * 64 * DE + n0; lds_ = DE;
        const int drow = (n0 >> 7) * 256 + (n0 & 127) + (up ? 128 : 0);
        dst = ws + WS_WGU + ((size_t)e * 1024 + drow) * D + kt * 64; ldd = D; f8 = 1; return; }
    j -= 16384;
    { const int e = j >> 8, r = j & 255, kt = r >> 5, nt = r & 31; src = a.in[23] + (size_t)e * DE * D + (size_t)kt * 64 * D + nt * 64; lds_ = D;
      dst = ws + WS_WD + ((size_t)e * D + nt * 64) * DE + kt * 64; ldd = DE; f8 = 1; }
}
constexpr int TR_JOBS = 1024 + 1024 + 256 + 64 + 16384 + 8192;

constexpr int NGRP = TR_JOBS / 8;
constexpr int NGRP_LATE = 512;
__device__ __forceinline__ void transpose_group(const Args& a, unsigned char* lds, int jg) {
    const int tid = threadIdx.x;
    bf16_t* tl = (bf16_t*)lds;
    const int lr = tid >> 4, lc4 = (tid & 15) * 4;
    const int on = tid >> 3, okg = (tid & 7) * 8;
            f32x4 v[8][2]; unsigned char* dst[8]; int ldd[8]; int f8[8];
#pragma unroll
    for (int q = 0; q < 8; ++q) { const float* src; int ls; tr_job(a, jg + q, src, ls, dst[q], ldd[q], f8[q]);
        v[q][0] = __builtin_nontemporal_load((const f32x4*)(src + (size_t)lr * ls + lc4)); v[q][1] = __builtin_nontemporal_load((const f32x4*)(src + (size_t)(lr + 32) * ls + lc4)); }
    __syncthreads();
#pragma unroll
    for (int q = 0; q < 8; ++q) { unsigned* t0 = (unsigned*)(tl + q * 64 * 66);
        t0[(lr * 66 + lc4) >> 1] = cvt_pk_bf16(v[q][0][0], v[q][0][1]); t0[((lr * 66 + lc4) >> 1) + 1] = cvt_pk_bf16(v[q][0][2], v[q][0][3]);
        t0[((lr + 32) * 66 + lc4) >> 1] = cvt_pk_bf16(v[q][1][0], v[q][1][1]); t0[(((lr + 32) * 66 + lc4) >> 1) + 1] = cvt_pk_bf16(v[q][1][2], v[q][1][3]); }
    __syncthreads();
#pragma unroll
    for (int q = 0; q < 8; ++q) { const bf16_t* t0 = tl + q * 64 * 66; unsigned f[8];
#pragma unroll
        for (int e = 0; e < 8; ++e) f[e] = t0[(okg + e) * 66 + on];
        if (f8[q]) { u32x2 o; o.x = pk4_fp8(WSCALE * bflo(f[0]), WSCALE * bflo(f[1]), WSCALE * bflo(f[2]), WSCALE * bflo(f[3])); o.y = pk4_fp8(WSCALE * bflo(f[4]), WSCALE * bflo(f[5]), WSCALE * bflo(f[6]), WSCALE * bflo(f[7]));
            *(u32x2*)(dst[q] + (size_t)on * ldd[q] + okg) = o; }
        else { u32x4 o; o.x = f[0] | (f[1] << 16); o.y = f[2] | (f[3] << 16); o.z = f[4] | (f[5] << 16); o.w = f[6] | (f[7] << 16);
            *(u32x4*)(dst[q] + (size_t)on * ldd[q] + okg * 2) = o; } }
        }

__device__ void p0_prepass(const Args& a, unsigned char* lds, int rep) {
    const int tid = threadIdx.x, G = gridDim.x, bid = blockIdx.x;
    volatile unsigned long long* tsv = (volatile unsigned long long*)(lds + MISC_OFF + 512);
#define TSP(k) do { if ((k) == PROBE_TS_A && blockIdx.x == PROBE_BLK && threadIdx.x == 0) tsv[0] = __builtin_amdgcn_s_memrealtime(); if ((k) == PROBE_TS_B && blockIdx.x == PROBE_BLK && threadIdx.x == 0) tsv[1] = __builtin_amdgcn_s_memrealtime(); } while (0)
    TSP(40);
    unsigned char* ws = a.ws;
    if (rep == 0 || PROBE_P0PART == 1) {
        const f32x4* x4 = (const f32x4*)a.in[0]; u32x4* xb = (u32x4*)(ws + WS_XB);
        const size_t n8 = (size_t)T * D / 8, stride = (size_t)G * 512;
        for (size_t i = (size_t)bid * 512 + tid; i < n8; i += 8 * stride) {
            f32x4 v[16];
#pragma unroll
            for (int q = 0; q < 8; ++q) { const size_t ii = i + q * stride; if (ii < n8) { v[2 * q] = __builtin_nontemporal_load(x4 + 2 * ii); v[2 * q + 1] = __builtin_nontemporal_load(x4 + 2 * ii + 1); } }
#pragma unroll
            for (int q = 0; q < 8; ++q) { const size_t ii = i + q * stride; if (ii < n8) { u32x4 o; o.x = cvt_pk_bf16(v[2 * q][0], v[2 * q][1]); o.y = cvt_pk_bf16(v[2 * q][2], v[2 * q][3]);
                o.z = cvt_pk_bf16(v[2 * q + 1][0], v[2 * q + 1][1]); o.w = cvt_pk_bf16(v[2 * q + 1][2], v[2 * q + 1][3]); xb[ii] = o; } }
        }
    }
    TSP(41);
    if (rep == 0 || PROBE_P0PART == 2) {
        constexpr int NG0 = NGRP - NGRP_LATE;
        int g_lo, g_hi, g_x = -1;
        if (G == 256) { constexpr int S1 = 8, S2 = 14, REM0 = 128 * S1 + 128 * S2;
            if (bid >= 128) { g_lo = (bid - 128) * S2; g_hi = g_lo + S2; if (REM0 + (bid - 128) < NG0) g_x = REM0 + (bid - 128); }
            else { g_lo = 128 * S2 + bid * S1; g_hi = g_lo + S1; } }
        else { const int per = (NG0 + G - 1) / G; g_lo = bid * per; g_hi = g_lo + per; if (g_hi > NG0) g_hi = NG0; if (g_lo > NG0) g_lo = NG0; }
        for (int gi = g_lo; gi <= g_hi; ++gi) {
            int jg; if (gi < g_hi) jg = gi * 8; else { if (g_x < 0) break; jg = g_x * 8; }
            transpose_group(a, lds, jg);
        }
        __syncthreads();
    }
    TSP(42);
    if (rep == 0 || PROBE_P0PART == 3)
    {
        f32x2* pw = (f32x2*)lds;
        f32x2* Bb = (f32x2*)(lds + 17408);
        f32x2* Cc = (f32x2*)(lds + 17408 + 16384);
        float* KT = (float*)(lds + 17408 + 16384 + 16640);
        for (int job = bid; job < 2 * NG; job += G) {
            const int g = job >> 1, half = job & 1;
            __syncthreads();
            for (int i = tid; i < 2 * 17 * 64; i += 512) { const int dr = i / (17 * 64), l = (i >> 6) % 17, p = i & 63, ix = (dr * NG + g) * NP + p;
                const float lre = a.in[4][ix], lim = a.in[5][ix], dt = expf(a.in[6][dr * NG + g]);
                const float mg = expf(lre * dt * (float)l); float sn, cs; sincosf(lim * dt * (float)l, &sn, &cs); pw[i] = (f32x2){mg * cs, mg * sn}; }
            for (int i = tid; i < 2 * 64; i += 512) { const int dr = i >> 6, p = i & 63, ix = (dr * NG + g) * NP + p;
                const float lre = a.in[4][ix], lim = a.in[5][ix], dt = expf(a.in[6][dr * NG + g]);
                const float mg = expf(lre * dt), ar = mg * cosf(lim * dt), ai = mg * sinf(lim * dt), den = lre * lre + lim * lim;
                const float zr = ((ar - 1.0f) * lre + ai * lim) / den, zi = (ai * lre - (ar - 1.0f) * lim) / den;
#pragma unroll
                for (int c = 0; c < GC; ++c) { const float br = a.in[7][(size_t)ix * GC + c], bi = a.in[8][(size_t)ix * GC + c]; Bb[i * GC + c] = (f32x2){zr * br - zi * bi, zr * bi + zi * br}; } }
            for (int i = tid; i < 2 * GC * NP; i += 512) { const int dr = i >> 10, r = i & 1023; const size_t o = ((size_t)(dr * NG + g) * GC) * NP + r; Cc[(i >> 6) * 65 + (i & 63)] = (f32x2){a.in[9][o], a.in[10][o]}; }
            __syncthreads();
            { const int dr = tid >> 8, l = (tid >> 4) & 15, co = tid & 15; float ac[16];
#pragma unroll
              for (int c = 0; c < 16; ++c) ac[c] = 0.f;
              for (int p = 0; p < NP; ++p) { const f32x2 cv = Cc[(dr * 16 + co) * 65 + p], wv = pw[(dr * 17 + l) * 64 + p]; const float cr = cv.x * wv.x - cv.y * wv.y, ci = cv.x * wv.y + cv.y * wv.x;
                  const f32x4* bq = (const f32x4*)(Bb + (dr * 64 + p) * 16);
#pragma unroll
                  for (int c = 0; c < 8; ++c) { const f32x4 bv = bq[c]; ac[2 * c] += cr * bv[0] - ci * bv[1]; ac[2 * c + 1] += cr * bv[2] - ci * bv[3]; } }
#pragma unroll
              for (int c = 0; c < 16; ++c) KT[((dr * 16 + l) * 16 + co) * 16 + c] = ac[c]; }
            __syncthreads();
            bf16_t* w2 = (bf16_t*)(ws + WS_W2T) + (size_t)g * 256 * 512;
            for (int it = tid; it < 128 * 64; it += 512) { const int rr = it >> 6, kg = it & 63, n = half * 128 + rr, j = n >> 4, co = n & 15; float f[8];
                if (kg < 32) { const int i = kg >> 1, ci0 = (kg & 1) * 8;
#pragma unroll
                    for (int e = 0; e < 8; ++e) { const int ci = ci0 + e; float v = 0.f;
                        if (i <= j) v += KT[((0 * 16 + (j - i)) * 16 + co) * 16 + ci];
                        if (i >= j) v += KT[((1 * 16 + (i - j)) * 16 + co) * 16 + ci];
                        if (i == j && ci == co) v += a.in[11][g * GC + co];
                        f[e] = v; } }
                else { const int kk = (kg - 32) * 8, dr = kk >> 7, ri = (kk >> 6) & 1, p0 = kk & 63, ex = dr == 0 ? j + 1 : 16 - j;
#pragma unroll
                    for (int e = 0; e < 8; ++e) { const f32x2 cv = Cc[(dr * 16 + co) * 65 + p0 + e], wv = pw[(dr * 17 + ex) * 64 + p0 + e];
                        f[e] = ri == 0 ? (cv.x * wv.x - cv.y * wv.y) : -(cv.x * wv.y + cv.y * wv.x); } }
                u32x4 o; o.x = cvt_pk_bf16(f[0], f[1]); o.y = cvt_pk_bf16(f[2], f[3]); o.z = cvt_pk_bf16(f[4], f[5]); o.w = cvt_pk_bf16(f[6], f[7]);
                *(u32x4*)(w2 + (size_t)n * 512 + kg * 8) = o; }
            bf16_t* w1 = (bf16_t*)(ws + WS_W1T) + (size_t)g * 256 * 256;
            for (int it = tid; it < 128 * 32; it += 512) { const int rr = it >> 5, kg = it & 31, dr = half, ri = rr & 1, p = rr >> 1, i = kg >> 1, ci0 = (kg & 1) * 8, ex = dr == 0 ? 15 - i : i;
                const f32x2 wv = pw[(dr * 17 + ex) * 64 + p]; float f[8];
#pragma unroll
                for (int e = 0; e < 8; ++e) { const f32x2 bv = Bb[(dr * 64 + p) * 16 + ci0 + e]; f[e] = ri == 0 ? (wv.x * bv.x - wv.y * bv.y) : (wv.x * bv.y + wv.y * bv.x); }
                u32x4 o; o.x = cvt_pk_bf16(f[0], f[1]); o.y = cvt_pk_bf16(f[2], f[3]); o.z = cvt_pk_bf16(f[4], f[5]); o.w = cvt_pk_bf16(f[6], f[7]);
                *(u32x4*)(w1 + (size_t)(half * 128 + rr) * 256 + kg * 8) = o; }
            if (tid < 64) ((f32x2*)(ws + WS_SSMP + SSMP_A16))[(half * NG + g) * NP + tid] = pw[(half * 17 + 16) * 64 + tid];
        }
        __syncthreads();
    }
    TSP(43);
    {
        u32x4* rwf = (u32x4*)(ws + WS_RW);
        for (int i = bid * 512 + tid; i < 8 * 8 * 3 * 64; i += G * 512) {
            const int lane_ = i & 63, f = i >> 6, nt = f % 3, ks = (f / 3) & 7, w = f / 24, n = lane_ & 15, fq = lane_ >> 4, j = nt * 16 + n;
            float wv[8];
#pragma unroll
            for (int e = 0; e < 8; ++e) { const int k = w * 256 + ks * 32 + fq * 8 + e; wv[e] = j < 4 ? a.in[17][k * 4 + j] : (j < NR ? a.in[19][k * NE + (j - 4)] : 0.f); }
            u32x4 hi; hi.x = cvt_pk_bf16(wv[0], wv[1]); hi.y = cvt_pk_bf16(wv[2], wv[3]); hi.z = cvt_pk_bf16(wv[4], wv[5]); hi.w = cvt_pk_bf16(wv[6], wv[7]);
            u32x4 lo; lo.x = cvt_pk_bf16(wv[0] - bflo(hi.x), wv[1] - bfhi(hi.x)); lo.y = cvt_pk_bf16(wv[2] - bflo(hi.y), wv[3] - bfhi(hi.y));
            lo.z = cvt_pk_bf16(wv[4] - bflo(hi.z), wv[5] - bfhi(hi.z)); lo.w = cvt_pk_bf16(wv[6] - bflo(hi.w), wv[7] - bfhi(hi.w));
            rwf[(size_t)(f * 2 + 0) * 64 + lane_] = hi; rwf[(size_t)(f * 2 + 1) * 64 + lane_] = lo;
        }
    }
}

template <int W>
__device__ __forceinline__ void pooldiff_item(const bf16_t* proj, bf16_t* dp, int t, int c8) {
    const int s = t & (S - 1);
    const bf16_t* base = proj + (size_t)t * D + c8;
    float sum[8];
#pragma unroll
    for (int e = 0; e < 8; ++e) sum[e] = 0.f;
    u32x4 self;
#pragma unroll
    for (int q = -W / 2; q < W / 2; ++q) { const bool ok = (s + q >= 0) && (s + q < S);
        u32x4 v = (u32x4){0u, 0u, 0u, 0u}; if (ok) v = *(const u32x4*)(base + (ptrdiff_t)q * D);
        if (q == 0) self = v;
#pragma unroll
        for (int e = 0; e < 4; ++e) { sum[2 * e] += bflo(v[e]); sum[2 * e + 1] += bfhi(v[e]); } }
    int lo = s - W / 2, hi = s + W / 2; lo = lo < 0 ? 0 : lo; hi = hi > S ? S : hi;
    const float inv = 1.0f / (float)(hi - lo);
    u32x4 o;
#pragma unroll
    for (int e = 0; e < 4; ++e) o[e] = cvt_pk_bf16(sum[2 * e] * inv - bflo(self[e]), sum[2 * e + 1] * inv - bfhi(self[e]));
    *(u32x4*)(dp + (size_t)t * DP + c8) = o;
}
__device__ void pooldiff_job(const Args& a, int job) {
    const bf16_t* proj = (const bf16_t*)(a.ws + WS_PROJ); bf16_t* dp = (bf16_t*)(a.ws + WS_DPOOL);
    const int g = job & 3, r0 = (job >> 2) * 256;
    for (int i = threadIdx.x; i < 256 * 32; i += 512) {
        const int t = r0 + (i >> 5), c8 = (g * 32 + (i & 31)) * 8;
        if (g == 0) pooldiff_item<2>(proj, dp, t, c8); else if (g == 1) pooldiff_item<4>(proj, dp, t, c8); else if (g == 2) pooldiff_item<8>(proj, dp, t, c8); else pooldiff_item<16>(proj, dp, t, c8);
    }
}

__device__ void ssm_scan(const Args& a, unsigned char* lds, int g, int b) {
    const int tid = threadIdx.x, wid = tid >> 6, lane = tid & 63, p = lane;
    unsigned char* ws = a.ws;
    const unsigned* Sb = (const unsigned*)(ws + WS_S); bf16_t* A2 = (bf16_t*)(ws + WS_A2); const f32x2* a16 = (const f32x2*)(ws + WS_SSMP + SSMP_A16);
    f32x2* F = (f32x2*)lds;
    const f32x2 Af = a16[(0 * NG + g) * NP + p], Ab = a16[(1 * NG + g) * NP + p];
    float pfr = Af.x, pfi = Af.y, pbr = Ab.x, pbi = Ab.y;
#pragma unroll
    for (int q = 0; q < 6; ++q) { const float nr = pfr * pfr - pfi * pfi, ni = 2.0f * pfr * pfi; pfr = nr; pfi = ni; const float mr = pbr * pbr - pbi * pbi, mi = 2.0f * pbr * pbi; pbr = mr; pbi = mi; }
    const unsigned* sp = Sb + ((size_t)(g * 1024 + b * 512 + wid * 64)) * 128 + p;
    float fr_ = 0.f, fi_ = 0.f, br_ = 0.f, bi_ = 0.f;
#pragma unroll 16
    for (int q = 0; q < 64; ++q) { const unsigned wf = sp[q * 128], wb = sp[(63 - q) * 128 + 64];
        const float sfr = bflo(wf), sfi = bfhi(wf), sbr = bflo(wb), sbi = bfhi(wb);
        const float nfr = Af.x * fr_ - Af.y * fi_ + sfr, nfi = Af.x * fi_ + Af.y * fr_ + sfi; fr_ = nfr; fi_ = nfi;
        const float nbr = Ab.x * br_ - Ab.y * bi_ + sbr, nbi = Ab.x * bi_ + Ab.y * br_ + sbi; br_ = nbr; bi_ = nbi; }
    __syncthreads();
    F[wid * 64 + p] = (f32x2){fr_, fi_}; F[512 + wid * 64 + p] = (f32x2){br_, bi_};
    __syncthreads();
    float cfr = 0.f, cfi = 0.f, cbr = 0.f, cbi = 0.f;
    for (int v = 0; v < wid; ++v) { const f32x2 f = F[v * 64 + p]; const float nr = pfr * cfr - pfi * cfi + f.x, ni = pfr * cfi + pfi * cfr + f.y; cfr = nr; cfi = ni; }
    for (int v = 7; v > wid; --v) { const f32x2 f = F[512 + v * 64 + p]; const float nr = pbr * cbr - pbi * cbi + f.x, ni = pbr * cbi + pbi * cbr + f.y; cbr = nr; cbi = ni; }
    fr_ = cfr; fi_ = cfi; br_ = cbr; bi_ = cbi;
    bf16_t* op = A2 + ((size_t)(g * 1024 + b * 512 + wid * 64)) * 512 + 256 + p;
#pragma unroll 16
    for (int q = 0; q < 64; ++q) { const unsigned wf = sp[q * 128], wb = sp[(63 - q) * 128 + 64];
        const float sfr = bflo(wf), sfi = bfhi(wf), sbr = bflo(wb), sbi = bfhi(wb);
        bf16_t* of = op + q * 512; bf16_t* ob = op + (63 - q) * 512 + 128;
        of[0] = (bf16_t)(cvt_pk_bf16(fr_, fr_) & 0xffffu); of[64] = (bf16_t)(cvt_pk_bf16(fi_, fi_) & 0xffffu);
        ob[0] = (bf16_t)(cvt_pk_bf16(br_, br_) & 0xffffu); ob[64] = (bf16_t)(cvt_pk_bf16(bi_, bi_) & 0xffffu);
        const float nfr = Af.x * fr_ - Af.y * fi_ + sfr, nfi = Af.x * fi_ + Af.y * fr_ + sfi; fr_ = nfr; fi_ = nfi;
        const float nbr = Ab.x * br_ - Ab.y * bi_ + sbr, nbi = Ab.x * bi_ + Ab.y * br_ + sbi; br_ = nbr; bi_ = nbi; }
}

__device__ void p5_ln1_router(const Args& a, unsigned char* lds, int rep) {
    const int tid = threadIdx.x, wid = tid >> 6, lane = tid & 63, m = lane & 15, fq = lane >> 4;
    unsigned char* ws = a.ws;
    const bf16_t* __restrict__ v1b = (const bf16_t*)(ws + WS_V1B); const float* __restrict__ stt = (const float*)(ws + WS_ST); bf16_t* __restrict__ h1b = (bf16_t*)(ws + WS_H1B); const u32x4* __restrict__ rwf = (const u32x4*)(ws + WS_RW);
    unsigned char* __restrict__ h1f8 = ws + WS_H1F8;
    if (rep) { h1b = (bf16_t*)(ws + 345 * MB); h1f8 = ws + 409 * MB; }
    const float* g1 = a.in[15]; const float* b1 = a.in[16];
    int* tok_e = (int*)(ws + WS_ROUTE + RT_E); int* tok_rank = (int*)(ws + WS_ROUTE + RT_RANK); float* tok_gate = (float*)(ws + WS_ROUTE + RT_GATE);
    float* PL = (float*)(lds + 1024);
    float* LG = (float*)(lds + 1024 + 24576);
    float* GB = (float*)(lds + 32768);
    int* EL = (int*)(lds + 512);
    unsigned char* gc = (unsigned char*)(ws + WS_GC);
    __syncthreads();
    for (int i = tid; i < D; i += 512) { GB[i] = g1[i]; GB[D + i] = b1[i]; }
    __syncthreads();
    u32x4 vn[8]; f32x4 qn[4];
    { const int grp = blockIdx.x; if (grp < T / 16) { const size_t ro = (size_t)(grp * 16 + m) * D + wid * 256 + fq * 8;
#pragma unroll
        for (int ks = 0; ks < 8; ++ks) vn[ks] = *(const u32x4*)(v1b + ro + ks * 32);
#pragma unroll
        for (int q = 0; q < 4; ++q) qn[q] = *(const f32x4*)(stt + ((size_t)(grp * 16 + m) * 32 + fq * 8) * 2 + q * 4); } }
    for (int grp = blockIdx.x; grp < T / 16; grp += gridDim.x) {
        const int t = grp * 16 + m; const size_t ro = (size_t)t * D + wid * 256 + fq * 8;
        u32x4 v[8]; f32x4 qv[4];
#pragma unroll
        for (int ks = 0; ks < 8; ++ks) v[ks] = vn[ks];
#pragma unroll
        for (int q = 0; q < 4; ++q) qv[q] = qn[q];
        float s = (qv[0][0] + qv[0][2]) + (qv[1][0] + qv[1][2]) + (qv[2][0] + qv[2][2]) + (qv[3][0] + qv[3][2]);
        float ss = (qv[0][1] + qv[0][3]) + (qv[1][1] + qv[1][3]) + (qv[2][1] + qv[2][3]) + (qv[3][1] + qv[3][3]);
        s += __shfl_xor(s, 16); s += __shfl_xor(s, 32); ss += __shfl_xor(ss, 16); ss += __shfl_xor(ss, 32);
        const float mu = s * (1.0f / D); const float rstd = rsqrtf(fmaxf(ss * (1.0f / D) - mu * mu, 0.f) + LN_EPS);
        f32x4 acc[3];
#pragma unroll
        for (int nt = 0; nt < 3; ++nt) acc[nt] = (f32x4){0.f, 0.f, 0.f, 0.f};
        u32x4 wc_[6], wn_[6];
#pragma unroll
        for (int q = 0; q < 6; ++q) wc_[q] = rwf[(size_t)((wid * 8 + 0) * 6 + q) * 64 + lane];
#pragma unroll
        for (int ks = 0; ks < 8; ++ks) {
            if (ks < 7) {
#pragma unroll
                for (int q = 0; q < 6; ++q) wn_[q] = rwf[(size_t)((wid * 8 + ks + 1) * 6 + q) * 64 + lane]; }
            const int kk = wid * 256 + ks * 32 + fq * 8;
            const f32x4 ga = *(const f32x4*)(GB + kk), gb = *(const f32x4*)(GB + kk + 4), ba = *(const f32x4*)(GB + D + kk), bb = *(const f32x4*)(GB + D + kk + 4);
            const f32x4 va = (f32x4){bflo(v[ks].x), bfhi(v[ks].x), bflo(v[ks].y), bfhi(v[ks].y)}, vb = (f32x4){bflo(v[ks].z), bfhi(v[ks].z), bflo(v[ks].w), bfhi(v[ks].w)};
            const f32x4 h0 = (va - mu) * rstd * ga + ba, h1 = (vb - mu) * rstd * gb + bb;
            u32x4 hi; hi.x = cvt_pk_bf16(h0[0], h0[1]); hi.y = cvt_pk_bf16(h0[2], h0[3]); hi.z = cvt_pk_bf16(h1[0], h1[1]); hi.w = cvt_pk_bf16(h1[2], h1[3]);
            *(u32x4*)(h1b + ro + ks * 32) = hi;
            { u32x2 q8; q8.x = pk4_fp8(h0[0], h0[1], h0[2], h0[3]); q8.y = pk4_fp8(h1[0], h1[1], h1[2], h1[3]); *(u32x2*)(h1f8 + ro + ks * 32) = q8; }
            u32x4 lo; lo.x = cvt_pk_bf16(h0[0] - bflo(hi.x), h0[1] - bfhi(hi.x)); lo.y = cvt_pk_bf16(h0[2] - bflo(hi.y), h0[3] - bfhi(hi.y));
            lo.z = cvt_pk_bf16(h1[0] - bflo(hi.z), h1[1] - bfhi(hi.z)); lo.w = cvt_pk_bf16(h1[2] - bflo(hi.w), h1[3] - bfhi(hi.w));
            const bf16x8 ahi = __builtin_bit_cast(bf16x8, hi), alo = __builtin_bit_cast(bf16x8, lo);
#pragma unroll
            for (int nt = 0; nt < 3; ++nt) {
                const bf16x8 whi = __builtin_bit_cast(bf16x8, wc_[nt * 2]), wlo = __builtin_bit_cast(bf16x8, wc_[nt * 2 + 1]);
                acc[nt] = __builtin_amdgcn_mfma_f32_16x16x32_bf16(whi, ahi, acc[nt], 0, 0, 0);
                acc[nt] = __builtin_amdgcn_mfma_f32_16x16x32_bf16(whi, alo, acc[nt], 0, 0, 0);
                acc[nt] = __builtin_amdgcn_mfma_f32_16x16x32_bf16(wlo, ahi, acc[nt], 0, 0, 0); }
#pragma unroll
            for (int q = 0; q < 6; ++q) wc_[q] = wn_[q];
        }
        { const int gn = grp + gridDim.x; if (gn < T / 16) { const size_t rn = (size_t)(gn * 16 + m) * D + wid * 256 + fq * 8;
#pragma unroll
            for (int ks = 0; ks < 8; ++ks) vn[ks] = *(const u32x4*)(v1b + rn + ks * 32);
#pragma unroll
            for (int q = 0; q < 4; ++q) qn[q] = *(const f32x4*)(stt + ((size_t)(gn * 16 + m) * 32 + fq * 8) * 2 + q * 4); } }
#pragma unroll
        for (int nt = 0; nt < 3; ++nt) *(f32x4*)(PL + (wid * 16 + m) * 48 + nt * 16 + fq * 4) = acc[nt];
        __syncthreads();
        for (int i = tid; i < 16 * 48; i += 512) { const int mm = i / 48, j = i - mm * 48; float sm = 0.f;
#pragma unroll
            for (int w = 0; w < 8; ++w) sm += PL[(w * 16 + mm) * 48 + j];
            LG[i] = sm + (j < 4 ? a.in[18][j] : (j < NR ? a.in[20][j - 4] : 0.f)); }
        __syncthreads();
        if (tid < 16 && rep == 0) {
            const float* l = LG + tid * 48;
            const float g0 = l[0], g1v = l[1], g2 = l[2], g3 = l[3];
            int gsel = 0; float gm = g0; if (g1v > gm) { gm = g1v; gsel = 1; } if (g2 > gm) { gm = g2; gsel = 2; } if (g3 > gm) { gm = g3; gsel = 3; }
            const float pg = 1.0f / (expf(g0 - gm) + expf(g1v - gm) + expf(g2 - gm) + expf(g3 - gm));
            float el[8];
#pragma unroll
            for (int i = 0; i < 8; ++i) el[i] = l[4 + gsel * 8 + i];
            int i1 = 0; float m1 = el[0];
#pragma unroll
            for (int i = 1; i < 8; ++i) if (el[i] > m1) { m1 = el[i]; i1 = i; }
            int i2 = -1; float m2 = -3.0e38f;
#pragma unroll
            for (int i = 0; i < 8; ++i) if (i != i1 && el[i] > m2) { m2 = el[i]; i2 = i; }
            const float e2 = expf(m2 - m1), inv = 1.0f / (1.0f + e2);
            const int tt = grp * 16 + tid; const int ea = gsel * 8 + i1, eb = gsel * 8 + i2;
            EL[tid * 2] = ea; EL[tid * 2 + 1] = eb;
            tok_e[tt * 2] = ea; tok_e[tt * 2 + 1] = eb; tok_gate[tt * 2] = pg * inv; tok_gate[tt * 2 + 1] = pg * e2 * inv;
        }
        __syncthreads();
        if (tid < 32 && rep == 0) { const int me = EL[tid]; int r = 0;
            for (int q = 0; q < tid; ++q) r += (EL[q] == me) ? 1 : 0;
            tok_rank[(grp * 16) * 2 + tid] = r; }
        else if (tid >= 32 && tid < 64 && rep == 0) { const int e = tid - 32; int c = 0;
#pragma unroll
            for (int q = 0; q < 32; ++q) c += (EL[q] == e) ? 1 : 0;
            gc[grp * 32 + e] = (unsigned char)c; }
    }
    __syncthreads();
}

__device__ __forceinline__ void moe_build_tab(const Args& a, int* tstart) {
    if (threadIdx.x == 0) { const unsigned* cnt = (const unsigned*)(a.ws + WS_CTL); int acc = 0;
        for (int e = 0; e < NE; ++e) { tstart[e] = acc; acc += ((int)__hip_atomic_load(cnt + e, __ATOMIC_RELAXED, __HIP_MEMORY_SCOPE_AGENT) + 255) >> 8; }
        tstart[NE] = acc; }
    __syncthreads();
    if ((int)threadIdx.x < tstart[NE]) tstart[256 + threadIdx.x] = moe_expert_of_tile(tstart, (int)threadIdx.x);
    __syncthreads();
}

__device__ void p6_slots(const Args& a, unsigned char* lds, int* tstart) {
    const int tid = threadIdx.x;
    unsigned char* ws = a.ws;
    const int* tok_e = (const int*)(ws + WS_ROUTE + RT_E); const int* tok_rank = (const int*)(ws + WS_ROUTE + RT_RANK); const float* tok_gate = (const float*)(ws + WS_ROUTE + RT_GATE);
    int* slot_tok = (int*)(ws + WS_ROUTE + RT_STOK); float* slot_gate = (float*)(ws + WS_ROUTE + RT_SGATE); int* tok_slot = (int*)(ws + WS_ROUTE + RT_SGATE + (size_t)MAXTILES * 256 * 4);
    unsigned char* GC = lds;
    unsigned short* BASE = (unsigned short*)(lds + 32768);
    int* CS = (int*)(lds + 98304);
    int* CNT = (int*)(lds + 98304 + 2048);
    __syncthreads();
    { const u32x4* src = (const u32x4*)(ws + WS_GC); u32x4* dst = (u32x4*)GC;
#pragma unroll
      for (int q = 0; q < 4; ++q) dst[tid + q * 512] = src[tid + q * 512]; }
    __syncthreads();
    const int e = tid & 31, c = tid >> 5;
    { int sm = 0; for (int g = c * 64; g < c * 64 + 64; ++g) sm += GC[g * 32 + e]; CS[e * 16 + c] = sm; }
    __syncthreads();
    if (tid < 32) { int run = 0; for (int q = 0; q < 16; ++q) { const int tmp = CS[tid * 16 + q]; CS[tid * 16 + q] = run; run += tmp; } CNT[tid] = run; }
    __syncthreads();
    if (tid == 0) { int acc = 0; for (int q = 0; q < NE; ++q) { tstart[q] = acc; acc += (CNT[q] + 255) >> 8; } tstart[NE] = acc; }
    __syncthreads();
    if (tid < tstart[NE]) tstart[256 + tid] = moe_expert_of_tile(tstart, tid);
    if (blockIdx.x == 0 && tid < 32) ((unsigned*)(ws + WS_CTL))[tid] = (unsigned)CNT[tid];
    { int run = CS[e * 16 + c]; for (int g = c * 64; g < c * 64 + 64; ++g) { BASE[g * 32 + e] = (unsigned short)run; run += GC[g * 32 + e]; } }
    __syncthreads();
    for (int i = blockIdx.x * 512 + tid; i < T * 2; i += gridDim.x * 512) {
        const int ee = tok_e[i], s = tstart[ee] * 256 + (int)BASE[(i >> 5) * 32 + ee] + tok_rank[i]; slot_tok[s] = i >> 1; slot_gate[s] = tok_gate[i]; tok_slot[i] = s; }
    const int ns = tstart[NE] * 256;
    for (int s = blockIdx.x * 512 + tid; s < ns; s += gridDim.x * 512) {
        const int ee = moe_expert_of_tile(tstart, s >> 8); const int r = s - tstart[ee] * 256;
        if (r >= CNT[ee]) { slot_tok[s] = -1; slot_gate[s] = 0.f; } }
    __syncthreads();
}

__device__ __forceinline__ void fp8x8_acc(const u32x2 w, float (&f)[8]) {
    const f32x2 a = __builtin_amdgcn_cvt_pk_f32_fp8((int)w.x, false), b = __builtin_amdgcn_cvt_pk_f32_fp8((int)w.x, true), c = __builtin_amdgcn_cvt_pk_f32_fp8((int)w.y, false), d = __builtin_amdgcn_cvt_pk_f32_fp8((int)w.y, true);
    f[0] += a[0]; f[1] += a[1]; f[2] += b[0]; f[3] += b[1]; f[4] += c[0]; f[5] += c[1]; f[6] += d[0]; f[7] += d[1];
}
__device__ void p9_ln2(const Args& a, const int* tstart, int rep) {
    const int tid = threadIdx.x, wid = tid >> 6, lane = tid & 63;
    const float* g2 = a.in[24]; const float* b2 = a.in[25];
    const unsigned char* ys = a.ws + WS_YS; const bf16_t* h1b = (const bf16_t*)(a.ws + WS_H1B);
    const int* tok_slot = (const int*)(a.ws + WS_ROUTE + RT_SGATE + (size_t)MAXTILES * 256 * 4);
    const int nw = gridDim.x * 8;
    for (int t = blockIdx.x * 8 + wid; t < T; t += nw) {
        float* roww = rep == 0 ? a.out + (size_t)t * D : (float*)(a.ws + 25 * MB) + (size_t)(t & 4095) * D;
        const size_t sa = (size_t)tok_slot[t * 2] * D, sb = (size_t)tok_slot[t * 2 + 1] * D;
        float h[4][8]; float s = 0.f;
#pragma unroll
        for (int i = 0; i < 4; ++i) { const int k = i * 512 + lane * 8;
            const u32x4 hv = *(const u32x4*)(h1b + (size_t)t * D + k);
            const u32x2 ya = *(const u32x2*)(ys + sa + k), yb = *(const u32x2*)(ys + sb + k);
            float y[8];
#pragma unroll
            for (int e = 0; e < 8; ++e) y[e] = 0.f;
            fp8x8_acc(ya, y); fp8x8_acc(yb, y);
#pragma unroll
            for (int e = 0; e < 4; ++e) { h[i][2 * e] = ALPHA * bflo(hv[e]) + YSCALE_INV * y[2 * e]; h[i][2 * e + 1] = ALPHA * bfhi(hv[e]) + YSCALE_INV * y[2 * e + 1]; }
#pragma unroll
            for (int e = 0; e < 8; ++e) s += h[i][e]; }
        const float mu = wave_sum(s) * (1.0f / D); float vq = 0.f;
#pragma unroll
        for (int i = 0; i < 4; ++i)
#pragma unroll
            for (int e = 0; e < 8; ++e) { const float d = h[i][e] - mu; vq += d * d; }
        const float rstd = rsqrtf(wave_sum(vq) * (1.0f / D) + LN_EPS);
#pragma unroll
        for (int i = 0; i < 4; ++i) { const int k = i * 512 + lane * 8;
            const f32x4 ga = *(const f32x4*)(g2 + k), gb = *(const f32x4*)(g2 + k + 4), ba = *(const f32x4*)(b2 + k), bb = *(const f32x4*)(b2 + k + 4);
            f32x4 o0, o1;
#pragma unroll
            for (int e = 0; e < 4; ++e) { o0[e] = (h[i][e] - mu) * rstd * ga[e] + ba[e]; o1[e] = (h[i][4 + e] - mu) * rstd * gb[e] + bb[e]; }
            *(f32x4*)(roww + k) = o0; *(f32x4*)(roww + k + 4) = o1; }
    }
}

constexpr int NPHASE = 10;
__global__ void __launch_bounds__(512, 2) fwd(Args a) {
    extern __shared__ __attribute__((aligned(16))) unsigned char lds[];
    cg::grid_group grid = cg::this_grid();
    unsigned char* ws = a.ws;
    int* tstart = (int*)(lds + MISC_OFF);
    volatile LAS unsigned* bst = (volatile LAS unsigned*)((LAS unsigned char*)lds + MISC_OFF + 256);
    if (threadIdx.x < 4) bst[threadIdx.x] = 0u;
    __syncthreads();
    XcdBarrier xbar = xcd_barrier_post((unsigned*)(ws + WS_BAR), bst);
    if (a.ph_hi > 1000) grid.sync();
#define IN(k) (a.ph_lo <= (k) && (k) < a.ph_hi)
    volatile unsigned long long* tsv = (volatile unsigned long long*)(lds + MISC_OFF + 512);
#define TS_START(k) do { if ((k) == PROBE_TS_A && blockIdx.x == PROBE_BLK && threadIdx.x == 0) tsv[0] = __builtin_amdgcn_s_memrealtime(); } while (0)
#define TS_END(k) do { if ((k) == PROBE_TS_B && blockIdx.x == PROBE_BLK && threadIdx.x == 0) tsv[1] = __builtin_amdgcn_s_memrealtime(); } while (0)
#define SEAM(k) do { if (IN(k) && IN((k) + 1)) xcd_barrier(xbar); } while (0)
    for (int q = 0; q < PROBE_SYNC; ++q) xcd_barrier(xbar);
    TS_START(0);
    if (IN(0)) for (int rep = 0; rep < (0 == PROBE_PHASE ? PROBE_REP : 1); ++rep) p0_prepass(a, lds, rep);
    SEAM(0); TS_END(0);
    TS_START(1);
    if (IN(1)) { DescProj d{(const char*)(ws + WS_XB), (const char*)(ws + WS_WIN), (bf16_t*)(ws + WS_PROJ), (bf16_t*)(ws + WS_A2), D, D}; gemm_run<0>(lds, d); }
    SEAM(1); TS_END(1);
    TS_START(2);
    if (IN(2)) {
        const int G_ = (int)gridDim.x, nS = 128, nP_ = G_ - nS, bx = (int)blockIdx.x;
        if (bx < nS) {
            const int job = bx;
            TS_START(20);
            { DescS1 d{(const char*)(ws + WS_A2), (const char*)(ws + WS_W1T), (bf16_t*)(ws + WS_S), job, 256, 256}; gemm_run<6>(lds, d);
              if (PROBE_DUP) { asm volatile("s_waitcnt vmcnt(0)" ::: "memory"); __syncthreads(); TS_START(30); for (int q = 0; q < PROBE_DUP; ++q) gemm_run<6>(lds, d); TS_END(30); } }
            asm volatile("s_waitcnt vmcnt(0)" ::: "memory"); __syncthreads(); TS_END(21); TS_START(21);
            ssm_scan(a, lds, job >> 1, job & 1);
            asm volatile("s_waitcnt vmcnt(0)" ::: "memory"); __syncthreads(); TS_END(22); TS_START(22);
            { DescS2 d{(const char*)(ws + WS_A2), (const char*)(ws + WS_W2T), (bf16_t*)(ws + WS_YSSM), job, 512, 512}; gemm_run<7>(lds, d); }
            TS_END(23);
        } else {
            const int pb = bx - nS;
            TS_START(24);
            for (int j = pb; j < 256; j += nP_) pooldiff_job(a, j);
            asm volatile("s_waitcnt vmcnt(0)" ::: "memory"); __syncthreads(); TS_END(24); TS_START(25);
            { DescPool d{(const char*)(ws + WS_DPOOL), (const char*)(ws + WS_POOLW), (bf16_t*)(ws + WS_CC), a.in[3], pb, nP_, 256, 256}; gemm_run<1>(lds, d); }
            TS_END(25);
            for (int gi = (NGRP - NGRP_LATE) + pb; gi < NGRP; gi += nP_) transpose_group(a, lds, gi * 8);
            __syncthreads();
        }
    }
    SEAM(2); TS_END(2);
    TS_START(3);
    if (IN(3)) { DescGlu d{(const char*)(ws + WS_YSSM), (const char*)(ws + WS_GLU), (bf16_t*)(ws + WS_CC), a.in[13], DS, DS}; gemm_run<2>(lds, d); }
    SEAM(3); TS_END(3);
    TS_START(4);
    if (IN(4)) { DescOut d{(const char*)(ws + WS_CC), (const char*)(ws + WS_WOUT), (bf16_t*)(ws + WS_V1B), (const bf16_t*)(ws + WS_XB), (float*)(ws + WS_ST), D, D}; gemm_run<3>(lds, d); }
    SEAM(4); TS_END(4);
    TS_START(5);
    if (IN(5)) for (int rep = 0; rep < (5 == PROBE_PHASE ? PROBE_REP : 1); ++rep) p5_ln1_router(a, lds, rep);
    SEAM(5); TS_END(5);
    TS_START(6);
    if (IN(6)) { for (int rep = 0; rep < (6 == PROBE_PHASE ? PROBE_REP : 1); ++rep) p6_slots(a, lds, tstart); }
    SEAM(6); TS_END(6);
    TS_START(7);
    if (IN(7)) { moe_build_tab(a, tstart);
        int* utab = (int*)(lds + UTAB_OFF); const int* slot_tok = (const int*)(ws + WS_ROUTE + RT_STOK);
        for (int k = 0; k < 8; ++k) { int tile, pn; if (!moe_order(tstart[NE], 4, (int)blockIdx.x + k * (int)gridDim.x, tile, pn)) break;
            if (threadIdx.x < 256) { const int t = slot_tok[tile * 256 + threadIdx.x]; utab[k * 256 + threadIdx.x] = t < 0 ? 0 : t; } }
        __syncthreads();
        DescGU d{(const char*)(ws + WS_H1F8), (const char*)(ws + WS_WGU), (bf16_t*)(ws + WS_HH), utab, tstart, D / 2, D / 2}; gemm_run<4>(lds, d); }
    SEAM(7); TS_END(7);
    TS_START(8);
    if (IN(8)) { moe_build_tab(a, tstart);
        float* gtab = (float*)(lds + UTAB_OFF); const float* slot_gate = (const float*)(ws + WS_ROUTE + RT_SGATE);
        for (int k = 0; k < 8; ++k) { int tile, pn; if (!moe_order(tstart[NE], 8, (int)blockIdx.x + k * (int)gridDim.x, tile, pn)) break;
            if (threadIdx.x < 256) gtab[k * 256 + threadIdx.x] = slot_gate[tile * 256 + threadIdx.x] * (WSCALE_INV * YSCALE); }
        __syncthreads();
        DescDown d{(const char*)(ws + WS_HH), (const char*)(ws + WS_WD), (bf16_t*)(ws + WS_YS), gtab, tstart, DE / 2, DE / 2}; gemm_run<5>(lds, d); }
    SEAM(8); TS_END(8);
    TS_START(9);
    if (IN(9)) { moe_build_tab(a, tstart); for (int rep = 0; rep < (9 == PROBE_PHASE ? PROBE_REP : 1); ++rep) p9_ln2(a, tstart, rep); }
    TS_END(9);
    if (PROBE_TS_A >= 0 && blockIdx.x == PROBE_BLK && threadIdx.x == 0) { const unsigned long long dt = tsv[1] - tsv[0], te = __builtin_amdgcn_s_memrealtime(); while (__builtin_amdgcn_s_memrealtime() - te < 4ull * dt) __builtin_amdgcn_s_sleep(32); }
#undef IN
#undef SEAM
}

extern "C" void kernel_launch(void* const* d_in, const int* in_sizes, int n_in, void* d_out, int out_size, void* d_ws, size_t ws_size, hipStream_t stream) {
    static int grid = 0;
    if (grid == 0) {
        if (n_in != 26 || out_size != T * D || ws_size < WS_END) { fprintf(stderr, "kernel_launch: unexpected shapes (n_in %d out %d ws %zu)\n", n_in, out_size, ws_size); grid = -1; return; }
        int dev = 0, cus = 0, per_cu = 0;
        (void)hipGetDevice(&dev); (void)hipDeviceGetAttribute(&cus, hipDeviceAttributeMultiprocessorCount, dev);
        (void)hipFuncSetAttribute((const void*)fwd, hipFuncAttributeMaxDynamicSharedMemorySize, LDS_BYTES);
        (void)hipOccupancyMaxActiveBlocksPerMultiprocessor(&per_cu, (const void*)fwd, 512, LDS_BYTES);
        if (per_cu < 1) { fprintf(stderr, "kernel_launch: occupancy query says %d blocks/CU\n", per_cu); per_cu = 1; }
        grid = cus;
        if (grid < 256) { fprintf(stderr, "kernel_launch: built for >= 256 CUs (got %d)\n", grid); grid = -1; return; }
    }
    if (grid < 0) return;
    (void)hipMemsetAsync((char*)d_ws + WS_CTL, 0, CTL_ZERO_BYTES, stream);
    Args a{};
    for (int i = 0; i < 26; ++i) a.in[i] = (const float*)d_in[i];
    a.out = (float*)d_out; a.ws = (unsigned char*)d_ws;
#if N_LAUNCH_MODE == 0
    a.ph_lo = 0; a.ph_hi = NPHASE;
    void* args[] = {&a};
    hipError_t e = hipLaunchCooperativeKernel((const void*)fwd, dim3(grid), dim3(512), args, LDS_BYTES, stream);
    if (e != hipSuccess) fprintf(stderr, "cooperative launch failed: %s (grid %d)\n", hipGetErrorString(e), grid);
#else
    for (int p = 0; p < NPHASE; ++p) { a.ph_lo = p; a.ph_hi = p + 1; hipLaunchKernelGGL(fwd, dim3(grid), dim3(512), LDS_BYTES, stream, a); }
#endif
}
```

```cpp
#include <hip/hip_runtime.h>
#include <hip/hip_cooperative_groups.h>
#include <cstdio>
namespace cg = cooperative_groups;

#ifndef N_LAUNCH_MODE
#define N_LAUNCH_MODE 0
#endif
#ifndef PROBE_PHASE
#define PROBE_PHASE -1
#endif
#ifndef PROBE_REP
#define PROBE_REP 1
#endif
#ifndef PROBE_SYNC
#define PROBE_SYNC 0
#endif
#ifndef PROBE_TS_A
#define PROBE_TS_A -1
#endif
#ifndef PROBE_TS_B
#define PROBE_TS_B -1
#endif
#ifndef PROBE_NOSTORE
#define PROBE_NOSTORE 0
#endif
#ifndef PROBE_P0PART
#define PROBE_P0PART 0
#endif
#ifndef PROBE_BLK
#define PROBE_BLK 0
#endif
#ifndef PROBE_DUP
#define PROBE_DUP 0
#endif
#ifndef PROBE_GEMM
#define PROBE_GEMM -1
#endif
#ifndef NAIVE_MASK
#define NAIVE_MASK 0x00
#endif

typedef unsigned short bf16_t;
typedef short bf16x8 __attribute__((ext_vector_type(8)));
typedef float f32x4 __attribute__((ext_vector_type(4)));
typedef float f32x2 __attribute__((ext_vector_type(2)));
typedef unsigned u32x4 __attribute__((ext_vector_type(4)));
typedef unsigned u32x2 __attribute__((ext_vector_type(2)));
typedef int i32x8 __attribute__((ext_vector_type(8)));
typedef int i32x4 __attribute__((ext_vector_type(4)));

constexpr int T = 16384, D = 2048, S = 8192, NB = 2;
constexpr int DP = 1024, DS = 1024, NG = 64, GC = 16, NP = 64;
constexpr int NE = 32, DE = 512, NR = 36;
constexpr int MAXTILES = 161;
constexpr float LN_EPS = 1e-5f;
constexpr float ALPHA = 1.189207115002721f;
constexpr float WSCALE = 32.0f, WSCALE_INV = 1.0f / 32.0f;
constexpr float YSCALE = 64.0f, YSCALE_INV = 1.0f / 64.0f;

constexpr size_t MB = 1u << 20;
constexpr size_t WS_CTL = 0;
constexpr size_t WS_BAR = 65536;
constexpr size_t CTL_ZERO_BYTES = 131072;
constexpr size_t WS_YS = 281 * MB;
constexpr size_t WS_H1B = 217 * MB;
constexpr size_t WS_V1B = 281 * MB;
constexpr size_t WS_ST = 484 * MB;
constexpr size_t WS_S = 89 * MB;
constexpr size_t WS_H1F8 = 89 * MB;
constexpr size_t WS_HH = 442 * MB;
constexpr size_t WS_SSMP = 1 * MB;
constexpr size_t WS_RW = 3 * MB;
constexpr size_t WS_ROUTE = 4 * MB;
constexpr size_t WS_WIN = 6 * MB;
constexpr size_t WS_WOUT = 14 * MB;
constexpr size_t WS_GLU = 22 * MB;
constexpr size_t WS_POOLW = 24 * MB;
constexpr size_t WS_WGU = 25 * MB;
constexpr size_t WS_WD = 121 * MB;
constexpr size_t WS_XB = 153 * MB;
constexpr size_t WS_CC = 217 * MB;
constexpr size_t WS_PROJ = 281 * MB;
constexpr size_t WS_DPOOL = 409 * MB;
constexpr size_t WS_YSSM = 441 * MB;
constexpr size_t WS_A2 = 345 * MB;
constexpr size_t WS_W1T = 484 * MB;
constexpr size_t WS_W2T = 492 * MB;
constexpr size_t WS_END = 508 * MB;
constexpr size_t SSMP_A16 = 1536 * 1024;

constexpr size_t WS_GC = 5 * MB + 512 * 1024;
constexpr size_t RT_E = 0, RT_RANK = (size_t)T * 2 * 4, RT_GATE = (size_t)T * 4 * 4, RT_STOK = (size_t)T * 6 * 4, RT_SGATE = RT_STOK + (size_t)MAXTILES * 256 * 4;

constexpr int LDS_BYTES = 128 * 1024 + 4096 + 8192;
constexpr int UTAB_OFF = 128 * 1024 + 4096;
constexpr int MISC_OFF = 128 * 1024;

struct Args { const float* in[26]; float* out; unsigned char* ws; int ph_lo, ph_hi; };

__device__ __forceinline__ float bf2f(bf16_t b) { return __uint_as_float(((unsigned)b) << 16); }
__device__ __forceinline__ float bflo(unsigned w) { return __uint_as_float(w << 16); }
__device__ __forceinline__ float bfhi(unsigned w) { return __uint_as_float(w & 0xffff0000u); }
__device__ __forceinline__ unsigned cvt_pk_bf16(float lo, float hi) { unsigned r; asm("v_cvt_pk_bf16_f32 %0, %1, %2" : "=v"(r) : "v"(lo), "v"(hi)); return r; }
__device__ __forceinline__ unsigned pk4_fp8(float a, float b, float c, float d) { unsigned w = 0; w = __builtin_amdgcn_cvt_pk_fp8_f32(a, b, w, false); w = __builtin_amdgcn_cvt_pk_fp8_f32(c, d, w, true); return w; }
__device__ __forceinline__ float xor16_sum(float v) { const auto r = __builtin_amdgcn_permlane16_swap(__float_as_uint(v), __float_as_uint(v), false, false); return __uint_as_float(r[0]) + __uint_as_float(r[1]); }
__device__ __forceinline__ float xor32_sum(float v) { const auto r = __builtin_amdgcn_permlane32_swap(__float_as_uint(v), __float_as_uint(v), false, false); return __uint_as_float(r[0]) + __uint_as_float(r[1]); }
__device__ __forceinline__ float wave_sum(float v) {
#pragma unroll
    for (int o = 32; o >= 1; o >>= 1) v += __shfl_xor(v, o);
    return v;
}
__device__ __forceinline__ float gelu_tanh(float x) {
    const float u2 = 1.5957691216057308f * (x + 0.044715f * x * x * x);
    return x * __builtin_amdgcn_rcpf(1.0f + __expf(-u2));
}
__device__ __forceinline__ float sigmoidf_(float z) { return __builtin_amdgcn_rcpf(1.0f + __expf(-z)); }

#define LAS __attribute__((address_space(3)))
#define XB_TMO      128
#define XB_XCNT(j)  (256  + 64 * (j))
#define XB_XSUB(j)  (1280 + 64 * (j))
#define XB_XGEN(j)  (2304 + 64 * (j))
#define XB_TOP      3328
#define XB_TOPGEN   3392
#define XCD_BAR_WORDS 3456
#define XB_SPIN_CAP (1u << 18)
__device__ __forceinline__ unsigned xb_ld(unsigned* p)              { return __hip_atomic_load(p, __ATOMIC_RELAXED, __HIP_MEMORY_SCOPE_AGENT); }
__device__ __forceinline__ unsigned xb_add(unsigned* p, unsigned v) { return __hip_atomic_fetch_add(p, v, __ATOMIC_RELAXED, __HIP_MEMORY_SCOPE_AGENT); }
__device__ __forceinline__ unsigned xb_xcc_id() { return (unsigned)__builtin_amdgcn_s_getreg((3 << 11) | 20) & 0xFu; }
#define XB_SPIN(cond, bar) do { unsigned _sp = 0; while (cond) { __builtin_amdgcn_s_sleep(1); \
    if ((++_sp & 255u) == 0u) { if (xb_ld(&(bar)[XB_TMO])) break; if (_sp > XB_SPIN_CAP) { atomicAdd(&(bar)[XB_TMO], 1u); break; } } } } while (0)
struct XcdBarrier { unsigned* bar; unsigned x; volatile LAS unsigned* st; };
__device__ __forceinline__ XcdBarrier xcd_barrier_post(unsigned* bar, volatile LAS unsigned* st) {
    XcdBarrier b; b.bar = bar; b.x = xb_xcc_id(); b.st = st;
    if (threadIdx.x == 0) (void)xb_add(&bar[XB_XCNT(b.x)], 1u);
    return b;
}
__device__ __forceinline__ void xcd_barrier_complete(unsigned* bar, unsigned x, unsigned& nloc, unsigned& nx) {
    const unsigned G = gridDim.x * gridDim.y * gridDim.z;
    unsigned sum, cnt, mine, sp = 0u;
    for (;;) {
        sum = 0u; cnt = 0u; mine = 0u;
#pragma unroll
        for (unsigned j = 0; j < 16; ++j) { const unsigned c = xb_ld(&bar[XB_XCNT(j)]); sum += c; cnt += (c > 0u) ? 1u : 0u; mine = (j == x) ? c : mine; }
        if (sum == G) break;
        __builtin_amdgcn_s_sleep(1);
        if ((++sp & 255u) == 0u) { if (xb_ld(&bar[XB_TMO])) break; if (sp > XB_SPIN_CAP) { atomicAdd(&bar[XB_TMO], 1u); break; } }
    }
    nloc = mine > 0u ? mine : 1u; nx = cnt > 0u ? cnt : 1u;
}
__device__ __forceinline__ void xcd_barrier(const XcdBarrier& b) {
    asm volatile("s_waitcnt vmcnt(0)" ::: "memory");
    __syncthreads();
    if (threadIdx.x == 0) {
        unsigned* bar = b.bar;
        __builtin_amdgcn_s_waitcnt(0);
        unsigned nloc = b.st[0], nx = b.st[1];
        if (nloc == 0u) { xcd_barrier_complete(bar, b.x, nloc, nx); b.st[0] = nloc; b.st[1] = nx; }
        const unsigned old = xb_add(&bar[XB_XSUB(b.x)], 1u);
        const unsigned gen = old / nloc;
        if (old + 1u == (gen + 1u) * nloc) {
            __builtin_amdgcn_fence(__ATOMIC_RELEASE, "agent");
            asm volatile("s_waitcnt vmcnt(0)" ::: "memory");
            const unsigned og = xb_add(&bar[XB_TOP], 1u);
            const unsigned tg = og / nx;
            if (og + 1u == (tg + 1u) * nx) xb_add(&bar[XB_TOPGEN], 1u);
            else XB_SPIN(xb_ld(&bar[XB_TOPGEN]) == tg, bar);
            __builtin_amdgcn_fence(__ATOMIC_ACQUIRE, "agent");
            xb_add(&bar[XB_XGEN(b.x)], 1u);
            asm volatile("s_waitcnt vmcnt(0)" ::: "memory");
        } else {
            XB_SPIN(xb_ld(&bar[XB_XGEN(b.x)]) == gen, bar);
            __builtin_amdgcn_fence(__ATOMIC_ACQUIRE, "agent");
            asm volatile("s_waitcnt vmcnt(0)" ::: "memory");
        }
    }
    __syncthreads();
}

struct Unit { int r0, c0, e, pad; };

template <class DS_>
__device__ void gemm_naive(const DS_& d) {
    const int tid = threadIdx.x, wid = tid >> 6, lane = tid & 63, wr = wid >> 2, wc = wid & 3, fr = lane & 15, fq = lane >> 4;
    const int K = d.K; const size_t ldb2 = (size_t)d.ldb * 2;
    for (int ui = blockIdx.x;; ui += gridDim.x) {
        Unit u; if (!d.get(ui, u)) break;
        f32x4 acc[2][2][4][2];
        const char* Bp = d.b_ptr(u);
#pragma unroll
        for (int ai = 0; ai < 2; ++ai)
#pragma unroll
            for (int m = 0; m < 4; ++m) {
                const int r = 128 * ai + 64 * wr + 16 * m + fr;
                const char* ap = d.A + d.a_off(u, r);
#pragma unroll
                for (int bj = 0; bj < 2; ++bj)
#pragma unroll
                    for (int n = 0; n < 2; ++n) {
                        const int c = 128 * bj + 32 * wc + 8 * fq + 4 * n;
                        const char* bp = Bp + (size_t)c * ldb2;
                        float s0 = 0.f, s1 = 0.f, s2 = 0.f, s3 = 0.f;
                        for (int k = 0; k < K; k += 8) {
                            const u32x4 av = *(const u32x4*)(ap + k * 2);
                            const u32x4 b0 = *(const u32x4*)(bp + k * 2), b1 = *(const u32x4*)(bp + ldb2 + k * 2), b2 = *(const u32x4*)(bp + 2 * ldb2 + k * 2), b3 = *(const u32x4*)(bp + 3 * ldb2 + k * 2);
#pragma unroll
                            for (int j = 0; j < 4; ++j) {
                                const float al = bflo(av[j]), ah = bfhi(av[j]);
                                s0 += al * bflo(b0[j]); s0 += ah * bfhi(b0[j]);
                                s1 += al * bflo(b1[j]); s1 += ah * bfhi(b1[j]);
                                s2 += al * bflo(b2[j]); s2 += ah * bfhi(b2[j]);
                                s3 += al * bflo(b3[j]); s3 += ah * bfhi(b3[j]);
                            }
                        }
                        acc[ai][bj][m][n] = (f32x4){s0, s1, s2, s3};
                    }
            }
        d.epi(acc, u, wr, wc, fr, fq);
    }
}

constexpr int BK = 64, HALF = 128, HTB = HALF * BK * 2;
__device__ __forceinline__ int lds_byte(int r, int c) { const int st = (r >> 4) * 2 + (c >> 5), rr = r & 15, cc = c & 31, ob = rr * 64 + cc * 2; return st * 1024 + (ob ^ (((ob >> 9) & 1) << 5)); }
__device__ __forceinline__ int perm32(int rho) { const int n = rho >> 4, i = rho & 15; return 8 * (i >> 2) + 4 * n + (i & 3); }
__device__ __forceinline__ void stage_rc(int b, int& R, int& C) { const int st = b / 1024, sb = b % 1024, swz = sb ^ (((sb >> 9) & 1) << 5); R = (st >> 1) * 16 + swz / 64; C = (st & 1) * 32 + (swz % 64) / 2; }

template <bool FP8, class DS_>
__device__ __forceinline__ void gemm_fast(LAS unsigned char* lds, const DS_& d) {
    const int tid = threadIdx.x, wid = __builtin_amdgcn_readfirstlane(tid >> 6), lane = tid & 63, wr = wid >> 2, wc = wid & 3, fr = lane & 15, fq = lane >> 4;
    const int K = d.K, nt = K / BK;
    int Rr[2], Cc[2]; unsigned voffB[2];
#pragma unroll
    for (int i = 0; i < 2; ++i) { stage_rc(tid * 16 + i * 8192, Rr[i], Cc[i]); const int Rb = (Rr[i] & ~31) + perm32(Rr[i] & 31); voffB[i] = (unsigned)(Rb * d.ldb + Cc[i]) * 2u; }
    const size_t kstep = (size_t)(BK * 2);
    const size_t hstepB = (size_t)HALF * d.ldb * 2;
    const unsigned ldsw = (unsigned)wid * 1024u;
    const int aoff = lds_byte(wr * 64 + fr, fq * 8), boff = lds_byte(wc * 32 + fr, fq * 8);
#define G_SA(b, h) (((b) * 2 + (h)) * HTB)
#define G_SB(b, h) ((4 + (b) * 2 + (h)) * HTB)
#define G_STAGE(bufoff, gbase, voff) do { _Pragma("unroll") for (int _i = 0; _i < 2; ++_i) \
        __builtin_amdgcn_global_load_lds((const unsigned*)((const char*)(gbase) + (voff)[_i]), (LAS unsigned*)(lds + (bufoff) + ldsw + _i * 8192), 16, 0, 0); } while (0)
#define G_LDA(dst, b, h) do { _Pragma("unroll") for (int m = 0; m < 4; ++m) { const i32x4 l0_ = *(const LAS i32x4*)(lds + G_SA(b, h) + aoff + m * 2048), l1_ = *(const LAS i32x4*)(lds + G_SA(b, h) + aoff + m * 2048 + 1024); \
        dst[m] = __builtin_shufflevector(l0_, l1_, 0, 1, 2, 3, 4, 5, 6, 7); } } while (0)
#define G_LDB(dst, b, h) do { _Pragma("unroll") for (int n = 0; n < 2; ++n) { const i32x4 l0_ = *(const LAS i32x4*)(lds + G_SB(b, h) + boff + n * 2048), l1_ = *(const LAS i32x4*)(lds + G_SB(b, h) + boff + n * 2048 + 1024); \
        dst[n] = __builtin_shufflevector(l0_, l1_, 0, 1, 2, 3, 4, 5, 6, 7); } } while (0)
#define G_MMA(ai, bj, At, Bt) do { __builtin_amdgcn_s_setprio(1); _Pragma("unroll") for (int m = 0; m < 4; ++m) _Pragma("unroll") for (int n = 0; n < 2; ++n) { \
        if constexpr (FP8) asm volatile("v_mfma_f32_16x16x128_f8f6f4 %0, %1, %2, %0" : "+v"(acc[ai][bj][m][n]) : "v"(Bt[n]), "v"(At[m])); \
        else { acc[ai][bj][m][n] = __builtin_amdgcn_mfma_f32_16x16x32_bf16(__builtin_bit_cast(bf16x8, __builtin_shufflevector(Bt[n], Bt[n], 0, 1, 2, 3)), __builtin_bit_cast(bf16x8, __builtin_shufflevector(At[m], At[m], 0, 1, 2, 3)), acc[ai][bj][m][n], 0, 0, 0); \
               acc[ai][bj][m][n] = __builtin_amdgcn_mfma_f32_16x16x32_bf16(__builtin_bit_cast(bf16x8, __builtin_shufflevector(Bt[n], Bt[n], 4, 5, 6, 7)), __builtin_bit_cast(bf16x8, __builtin_shufflevector(At[m], At[m], 4, 5, 6, 7)), acc[ai][bj][m][n], 0, 0, 0); } } \
        __builtin_amdgcn_s_setprio(0); } while (0)
#define G_WAIT_V(n) asm volatile("s_waitcnt vmcnt(" #n ")" ::: "memory")
#define G_WAIT_L(n) asm volatile("s_waitcnt lgkmcnt(" #n ")" ::: "memory")
#define G_BAR __builtin_amdgcn_s_barrier()
#define G_SCHED __builtin_amdgcn_sched_barrier(0)
    Unit cur, nxt; int ui = blockIdx.x;
    if (!d.get(ui, cur)) return;
    f32x4 acc[2][2][4][2];
#pragma unroll
    for (int a_ = 0; a_ < 2; ++a_)
#pragma unroll
        for (int b_ = 0; b_ < 2; ++b_)
#pragma unroll
            for (int m = 0; m < 4; ++m)
#pragma unroll
                for (int n = 0; n < 2; ++n) acc[a_][b_][m][n] = (f32x4){0.f, 0.f, 0.f, 0.f};
    i32x8 At[4], B0[2], B1[2];
    unsigned vA[2][2], nvA[2][2];
#pragma unroll
    for (int h = 0; h < 2; ++h)
#pragma unroll
        for (int i = 0; i < 2; ++i) vA[h][i] = d.a_off(cur, h * HALF + Rr[i]) + (unsigned)Cc[i] * 2u;
    const char* const Ab = d.A;
    const char* cB = d.b_ptr(cur);
    G_STAGE(G_SB(0, 0), cB, voffB); G_STAGE(G_SA(0, 0), Ab, vA[0]); G_STAGE(G_SB(0, 1), cB + hstepB, voffB); G_STAGE(G_SA(0, 1), Ab, vA[1]);
    if (wr == 1) G_BAR;
    G_WAIT_V(4); G_BAR;
    G_STAGE(G_SB(1, 0), cB + kstep, voffB); G_STAGE(G_SA(1, 0), Ab + kstep, vA[0]); G_STAGE(G_SB(1, 1), cB + hstepB + kstep, voffB);
    G_WAIT_V(6); G_BAR;
    for (;;) {
        const bool has_next = d.get(ui + (int)gridDim.x, nxt);
        const char* nB = has_next ? d.b_ptr(nxt) : cB;
#pragma unroll
        for (int h = 0; h < 2; ++h)
#pragma unroll
            for (int i = 0; i < 2; ++i) nvA[h][i] = has_next ? (d.a_off(nxt, h * HALF + Rr[i]) + (unsigned)Cc[i] * 2u) : vA[h][i];
        for (int t = 0; t < nt; t += 2) {
            const bool last = (t == nt - 2);
            const char* a1 = Ab + (size_t)(t + 1) * kstep;
            const char* a2 = last ? Ab : Ab + (size_t)(t + 2) * kstep; const char* b2 = last ? nB : cB + (size_t)(t + 2) * kstep;
            const char* a3 = a2 + kstep; const char* b3 = b2 + kstep;
            unsigned va2[2][2];
#pragma unroll
            for (int h = 0; h < 2; ++h)
#pragma unroll
                for (int i = 0; i < 2; ++i) va2[h][i] = last ? nvA[h][i] : vA[h][i];
            G_LDB(B0, 0, 0); G_SCHED; G_LDA(At, 0, 0); G_STAGE(G_SA(1, 1), a1, vA[1]);
            G_WAIT_L(8); G_BAR; G_WAIT_L(0); G_MMA(0, 0, At, B0); G_BAR; G_SCHED;
            G_LDB(B1, 0, 1); G_STAGE(G_SB(0, 0), b2, voffB);
            G_BAR; G_WAIT_L(0); G_MMA(0, 1, At, B1); G_BAR;
            G_LDA(At, 0, 1); G_STAGE(G_SA(0, 0), a2, va2[0]);
            G_BAR; G_WAIT_L(0); G_MMA(1, 0, At, B0); G_BAR; G_SCHED;
            G_STAGE(G_SB(0, 1), b2 + hstepB, voffB);
            G_WAIT_V(6); G_BAR; G_MMA(1, 1, At, B1); G_BAR;
            G_LDB(B0, 1, 0); G_SCHED; G_LDA(At, 1, 0); G_STAGE(G_SA(0, 1), a2, va2[1]);
            G_WAIT_L(8); G_BAR; G_WAIT_L(0); G_MMA(0, 0, At, B0); G_BAR; G_SCHED;
            G_LDB(B1, 1, 1); G_STAGE(G_SB(1, 0), b3, voffB);
            G_BAR; G_WAIT_L(0); G_MMA(0, 1, At, B1); G_BAR;
            G_LDA(At, 1, 1); G_STAGE(G_SA(1, 0), a3, va2[0]);
            G_BAR; G_WAIT_L(0); G_MMA(1, 0, At, B0); G_BAR; G_SCHED;
            G_STAGE(G_SB(1, 1), b3 + hstepB, voffB);
            G_WAIT_V(6); G_BAR; G_MMA(1, 1, At, B1); G_BAR;
        }
        d.epi(acc, cur, wr, wc, fr, fq);
        if (!has_next) break;
#pragma unroll
        for (int a_ = 0; a_ < 2; ++a_)
#pragma unroll
            for (int b_ = 0; b_ < 2; ++b_)
#pragma unroll
                for (int m = 0; m < 4; ++m)
#pragma unroll
                    for (int n = 0; n < 2; ++n) acc[a_][b_][m][n] = (f32x4){0.f, 0.f, 0.f, 0.f};
        cur = nxt; cB = nB; ui += (int)gridDim.x;
#pragma unroll
        for (int h = 0; h < 2; ++h)
#pragma unroll
            for (int i = 0; i < 2; ++i) vA[h][i] = nvA[h][i];
    }
    G_WAIT_V(0);
    if (wr == 0) G_BAR;
    G_BAR;
#undef G_SA
#undef G_SB
#undef G_STAGE
#undef G_LDA
#undef G_LDB
#undef G_MMA
#undef G_WAIT_V
#undef G_WAIT_L
#undef G_BAR
#undef G_SCHED
}
template <int BIT, class DS_>
__device__ __forceinline__ void gemm_run(unsigned char* lds, const DS_& d) {
    if constexpr ((NAIVE_MASK >> BIT) & 1) gemm_naive(d); else gemm_fast<DS_::FP8>((LAS unsigned char*)lds, d);
}

__device__ __forceinline__ bool static_order(int L, int nM, int nN, int& pm, int& pn) {
    const int nwg = nM * nN; if (L >= nwg) return false;
    int wgid = L; { const int q = nwg / 8, r = nwg % 8, xcd = wgid % 8, off = wgid / 8; wgid = (xcd < r ? xcd * (q + 1) : r * (q + 1) + (xcd - r) * q) + off; }
    const int nig = 8 * nN, gid = wgid / nig, fm = gid * 8, gsz = (nM - fm) < 8 ? (nM - fm) : 8;
    pm = fm + ((wgid % nig) % gsz); pn = (wgid % nig) / gsz; return true;
}

#define EPI_LOOP_BEGIN _Pragma("unroll") for (int ai = 0; ai < 2; ++ai) _Pragma("unroll") for (int m = 0; m < 4; ++m) { const int lr = 128 * ai + 64 * wr + 16 * m + fr; \
    _Pragma("unroll") for (int bj = 0; bj < 2; ++bj) { const int lc = 128 * bj + 32 * wc + 8 * fq; const f32x4 v0 = acc[ai][bj][m][0], v1 = acc[ai][bj][m][1];
#define EPI_LOOP_END } }
__device__ __forceinline__ u32x4 pack8(const f32x4 a, const f32x4 b) { u32x4 w; w.x = cvt_pk_bf16(a[0], a[1]); w.y = cvt_pk_bf16(a[2], a[3]); w.z = cvt_pk_bf16(b[0], b[1]); w.w = cvt_pk_bf16(b[2], b[3]); return w; }

struct DescProj {
    static constexpr bool FP8 = false;
    const char* A; const char* Bt; bf16_t* O; bf16_t* A2; int K, ldb;
    __device__ bool get(int i, Unit& u) const { int pm, pn; if (i >= 512 * ((0) == PROBE_GEMM ? PROBE_REP : 1)) return false; i %= 512; if (!static_order(i, T / 256, D / 256, pm, pn)) return false; u.r0 = pm * 256; u.c0 = pn * 256; u.e = 0; u.pad = 0; return true; }
    __device__ unsigned a_off(const Unit& u, int r) const { return (unsigned)(u.r0 + r) * (unsigned)(D * 2); }
    __device__ const char* b_ptr(const Unit& u) const { return Bt + (size_t)u.c0 * D * 2; }
    __device__ void epi(const f32x4 (&acc)[2][2][4][2], const Unit& u, int wr, int wc, int fr, int fq) const {
        EPI_LOOP_BEGIN
            const u32x4 w = pack8(v0, v1);
            const int t = u.r0 + lr, nn = u.c0 + lc;
            if (u.c0 < DP) *(u32x4*)(O + (size_t)t * D + nn) = w;
            else { const int g = (nn - DP) >> 4, co = (nn - DP) & 15; *(u32x4*)(A2 + ((size_t)(g * 1024 + (t >> 4))) * 512 + (t & 15) * 16 + co) = w; }
        EPI_LOOP_END
    }
};
struct DescS1 {
    static constexpr bool FP8 = false;
    const char* A; const char* Bt; bf16_t* O; int job; int K, ldb;
    __device__ bool get(int i, Unit& u) const { const int k = i / (int)gridDim.x; if (k >= 2) return false; u.e = job >> 1; u.r0 = (job & 1) * 512 + k * 256; u.c0 = 0; u.pad = 0; return true; }
    __device__ unsigned a_off(const Unit& u, int r) const { return (unsigned)(u.e * 1024 + u.r0 + r) * 1024u; }
    __device__ const char* b_ptr(const Unit& u) const { return Bt + (size_t)u.e * 256 * 256 * 2; }
    __device__ void epi(const f32x4 (&acc)[2][2][4][2], const Unit& u, int wr, int wc, int fr, int fq) const {
        EPI_LOOP_BEGIN
            *(u32x4*)(O + ((size_t)(u.e * 1024 + u.r0 + lr)) * 256 + lc) = pack8(v0, v1);
        EPI_LOOP_END
    }
};
struct DescS2 {
    static constexpr bool FP8 = false;
    const char* A; const char* Bt; bf16_t* O; int job; int K, ldb;
    __device__ bool get(int i, Unit& u) const { const int k = i / (int)gridDim.x; if (k >= 2) return false; u.e = job >> 1; u.r0 = (job & 1) * 512 + k * 256; u.c0 = 0; u.pad = 0; return true; }
    __device__ unsigned a_off(const Unit& u, int r) const { return (unsigned)(u.e * 1024 + u.r0 + r) * 1024u; }
    __device__ const char* b_ptr(const Unit& u) const { return Bt + (size_t)u.e * 256 * 512 * 2; }
    __device__ void epi(const f32x4 (&acc)[2][2][4][2], const Unit& u, int wr, int wc, int fr, int fq) const {
        EPI_LOOP_BEGIN
            const int t = (u.r0 + lr) * 16 + (lc >> 4), co = lc & 15;
            const f32x4 g0 = (f32x4){gelu_tanh(v0[0]), gelu_tanh(v0[1]), gelu_tanh(v0[2]), gelu_tanh(v0[3])}, g1 = (f32x4){gelu_tanh(v1[0]), gelu_tanh(v1[1]), gelu_tanh(v1[2]), gelu_tanh(v1[3])};
            *(u32x4*)(O + (size_t)t * DS + u.e * 16 + co) = pack8(g0, g1);
        EPI_LOOP_END
    }
};
struct DescPool {
    static constexpr bool FP8 = false;
    const char* A; const char* Bt; bf16_t* O; const float* scale; int pb, nP; int K, ldb;
    __device__ bool get(int i, Unit& u) const { const int k = i / (int)gridDim.x, j = pb + k * nP; if (pb < 0 || j >= 256) return false; u.e = j & 3; u.r0 = (j >> 2) * 256; u.c0 = u.e * 256; u.pad = 0; return true; }
    __device__ unsigned a_off(const Unit& u, int r) const { return ((unsigned)(u.r0 + r) * (unsigned)DP + (unsigned)u.e * 256u) * 2u; }
    __device__ const char* b_ptr(const Unit& u) const { return Bt + (size_t)u.e * 256 * 256 * 2; }
    __device__ void epi(const f32x4 (&acc)[2][2][4][2], const Unit& u, int wr, int wc, int fr, int fq) const {
        f32x4 scv[2][2];
#pragma unroll
        for (int bj = 0; bj < 2; ++bj)
#pragma unroll
            for (int n = 0; n < 2; ++n) scv[bj][n] = *(const f32x4*)(scale + u.c0 + 128 * bj + 32 * wc + 8 * fq + 4 * n);
        EPI_LOOP_BEGIN
            *(u32x4*)(O + (size_t)(u.r0 + lr) * D + u.c0 + lc) = pack8(v0 * scv[bj][0], v1 * scv[bj][1]);
        EPI_LOOP_END
    }
};
struct DescGlu {
    static constexpr bool FP8 = false;
    const char* A; const char* Bt; bf16_t* O; const float* bias; int K, ldb;
    __device__ bool get(int i, Unit& u) const { int pm, pn; if (i >= 256 * ((2) == PROBE_GEMM ? PROBE_REP : 1)) return false; i %= 256; if (!static_order(i, T / 256, DS / 256, pm, pn)) return false; u.r0 = pm * 256; u.c0 = pn * 256; u.e = 0; u.pad = 0; return true; }
    __device__ unsigned a_off(const Unit& u, int r) const { return (unsigned)(u.r0 + r) * (unsigned)(DS * 2); }
    __device__ const char* b_ptr(const Unit& u) const { return Bt + (size_t)u.c0 * DS * 2; }
    __device__ void epi(const f32x4 (&acc)[2][2][4][2], const Unit& u, int wr, int wc, int fr, int fq) const {
        f32x4 bvv[2][2];
#pragma unroll
        for (int bj = 0; bj < 2; ++bj)
#pragma unroll
            for (int n = 0; n < 2; ++n) bvv[bj][n] = *(const f32x4*)(bias + u.c0 + 128 * bj + 32 * wc + 8 * fq + 4 * n);
        const char* __restrict__ Yp = A + ((size_t)(u.r0 + 64 * wr + fr) * DS + u.c0 + 32 * wc + 8 * fq) * 2;
        u32x4 yq[4][2];
#pragma unroll
        for (int p = 0; p < 4; ++p)
#pragma unroll
            for (int q = 0; q < 2; ++q) yq[p][q] = *(const u32x4*)(Yp + ((size_t)(128 * (p >> 2) + 16 * (p & 3)) * DS) * 2 + q * 256);
#pragma unroll
        for (int rg = 0; rg < 8; ++rg) { const int ai = rg >> 2, m = rg & 3; const int lr = 128 * ai + 64 * wr + 16 * m + fr;
            u32x4 yc[2]; yc[0] = yq[rg & 3][0]; yc[1] = yq[rg & 3][1];
            if (rg < 4) { const int r2 = rg + 4;
#pragma unroll
                for (int q = 0; q < 2; ++q) yq[rg & 3][q] = *(const u32x4*)(Yp + ((size_t)(128 * (r2 >> 2) + 16 * (r2 & 3)) * DS) * 2 + q * 256); }
#pragma unroll
            for (int bj = 0; bj < 2; ++bj) { const int lc = 128 * bj + 32 * wc + 8 * fq; const f32x4 v0 = acc[ai][bj][m][0] + bvv[bj][0], v1 = acc[ai][bj][m][1] + bvv[bj][1]; const u32x4 yw = yc[bj];
                const f32x4 o0 = (f32x4){bflo(yw.x) * sigmoidf_(v0[0]), bfhi(yw.x) * sigmoidf_(v0[1]), bflo(yw.y) * sigmoidf_(v0[2]), bfhi(yw.y) * sigmoidf_(v0[3])};
                const f32x4 o1 = (f32x4){bflo(yw.z) * sigmoidf_(v1[0]), bfhi(yw.z) * sigmoidf_(v1[1]), bflo(yw.w) * sigmoidf_(v1[2]), bfhi(yw.w) * sigmoidf_(v1[3])};
                *(u32x4*)(O + (size_t)(u.r0 + lr) * D + DP + u.c0 + lc) = pack8(o0, o1); } }
    }
};
struct DescOut {
    static constexpr bool FP8 = false;
    const char* A; const char* Bt; bf16_t* O; const bf16_t* X; float* ST; int K, ldb;
    __device__ bool get(int i, Unit& u) const { int pm, pn; if (i >= 512 * ((3) == PROBE_GEMM ? PROBE_REP : 1)) return false; i %= 512; if (!static_order(i, T / 256, D / 256, pm, pn)) return false; u.r0 = pm * 256; u.c0 = pn * 256; u.e = 0; u.pad = 0; return true; }
    __device__ unsigned a_off(const Unit& u, int r) const { return (unsigned)(u.r0 + r) * (unsigned)(D * 2); }
    __device__ const char* b_ptr(const Unit& u) const { return Bt + (size_t)u.c0 * D * 2; }
    __device__ void epi(const f32x4 (&acc)[2][2][4][2], const Unit& u, int wr, int wc, int fr, int fq) const {
        const bf16_t* __restrict__ Xp = X + (size_t)(u.r0 + 64 * wr + fr) * D + u.c0 + 32 * wc + 8 * fq;
        u32x4 xq[4][2];
#pragma unroll
        for (int p = 0; p < 4; ++p)
#pragma unroll
            for (int q = 0; q < 2; ++q) xq[p][q] = *(const u32x4*)(Xp + (size_t)(128 * (p >> 2) + 16 * (p & 3)) * D + q * 128);
#pragma unroll
        for (int rg = 0; rg < 8; ++rg) { const int ai = rg >> 2, m = rg & 3; const int lr = 128 * ai + 64 * wr + 16 * m + fr; float s = 0.f, ss = 0.f;
            u32x4 xc[2]; xc[0] = xq[rg & 3][0]; xc[1] = xq[rg & 3][1];
            if (rg < 4) { const int r2 = rg + 4;
#pragma unroll
                for (int q = 0; q < 2; ++q) xq[rg & 3][q] = *(const u32x4*)(Xp + (size_t)(128 * (r2 >> 2) + 16 * (r2 & 3)) * D + q * 128); }
#pragma unroll
            for (int bj = 0; bj < 2; ++bj) { const int lc = 128 * bj + 32 * wc + 8 * fq; const size_t o = (size_t)(u.r0 + lr) * D + u.c0 + lc; const u32x4 xw = xc[bj];
                const f32x4 x0 = (f32x4){bflo(xw.x), bfhi(xw.x), bflo(xw.y), bfhi(xw.y)}, x1 = (f32x4){bflo(xw.z), bfhi(xw.z), bflo(xw.w), bfhi(xw.w)};
                const f32x4 v0 = x0 * ALPHA + acc[ai][bj][m][0], v1 = x1 * ALPHA + acc[ai][bj][m][1];
                s += ((v0[0] + v0[1]) + (v0[2] + v0[3])) + ((v1[0] + v1[1]) + (v1[2] + v1[3]));
                ss += ((v0[0] * v0[0] + v0[1] * v0[1]) + (v0[2] * v0[2] + v0[3] * v0[3])) + ((v1[0] * v1[0] + v1[1] * v1[1]) + (v1[2] * v1[2] + v1[3] * v1[3]));
                *(u32x4*)(O + o) = pack8(v0, v1); }
            s = xor32_sum(xor16_sum(s)); ss = xor32_sum(xor16_sum(ss));
            if (fq == 0) *(f32x2*)(ST + ((size_t)(u.r0 + lr) * 32 + (u.c0 >> 8) * 4 + wc) * 2) = (f32x2){s, ss}; }
    }
};
struct MoeTab { const int* tstart; };
__device__ __forceinline__ int moe_expert_of_tile(const int* tstart, int tile) { int e = 0;
#pragma unroll 1
    for (int j = 1; j < NE; ++j) e += (tile >= tstart[j]) ? 1 : 0;
    return e; }
__device__ __forceinline__ bool moe_order(int nt, int npn, int i, int& tile, int& pn) {
    const int G = (int)gridDim.x, r = i / G, b = i - r * G, per = G >> 3, x = b & 7, j = b >> 3;
    const int lo = (x * nt) >> 3, hi = ((x + 1) * nt) >> 3, u = j + per * r;
    if (j >= per || u >= (hi - lo) * npn) return false;
    tile = lo + u / npn; pn = u - (u / npn) * npn; return true;
}
struct DescGU {
    static constexpr bool FP8 = true;
    const char* A; const char* Bt; bf16_t* O; const int* utab; const int* tstart; int K, ldb;
    __device__ bool get(int i, Unit& u) const { int tile, pn; if (!moe_order(tstart[NE], 4, i, tile, pn)) return false; u.r0 = tile * 256; u.c0 = pn * 256; u.e = tstart[256 + tile]; u.pad = i / (int)gridDim.x; return true; }
    __device__ unsigned a_off(const Unit& u, int r) const { return (unsigned)utab[u.pad * 256 + r] * (unsigned)D; }
    __device__ const char* b_ptr(const Unit& u) const { return Bt + ((size_t)u.e * 1024 + u.c0) * D; }
    __device__ void epi(const f32x4 (&acc)[2][2][4][2], const Unit& u, int wr, int wc, int fr, int fq) const {
#pragma unroll
        for (int ai = 0; ai < 2; ++ai)
#pragma unroll
            for (int m = 0; m < 4; ++m) { const int lr = 128 * ai + 64 * wr + 16 * m + fr; f32x4 h[2];
#pragma unroll
                for (int n = 0; n < 2; ++n) { const f32x4 g = acc[ai][0][m][n] * WSCALE_INV, up = acc[ai][1][m][n] * WSCALE_INV;
#pragma unroll
                    for (int j = 0; j < 4; ++j) h[n][j] = g[j] * sigmoidf_(g[j]) * up[j]; }
                u32x2 w; w.x = pk4_fp8(h[0][0], h[0][1], h[0][2], h[0][3]); w.y = pk4_fp8(h[1][0], h[1][1], h[1][2], h[1][3]);
                *(u32x2*)((unsigned char*)O + (size_t)(u.r0 + lr) * DE + (u.c0 >> 1) + 32 * wc + 8 * fq) = w; }
    }
};
struct DescDown {
    static constexpr bool FP8 = true;
    const char* A; const char* Bt; bf16_t* O; const float* gtab; const int* tstart; int K, ldb;
    __device__ bool get(int i, Unit& u) const { int tile, pn; if (!moe_order(tstart[NE], 8, i, tile, pn)) return false; u.r0 = tile * 256; u.c0 = pn * 256; u.pad = i / (int)gridDim.x; u.e = tstart[256 + tile]; return true; }
    __device__ unsigned a_off(const Unit& u, int r) const { return (unsigned)(u.r0 + r) * (unsigned)DE; }
    __device__ const char* b_ptr(const Unit& u) const { return Bt + ((size_t)u.e * D + u.c0) * DE; }
    __device__ void epi(const f32x4 (&acc)[2][2][4][2], const Unit& u, int wr, int wc, int fr, int fq) const {
        float gts[8];
#pragma unroll
        for (int rg = 0; rg < 8; ++rg) gts[rg] = gtab[u.pad * 256 + 128 * (rg >> 2) + 64 * wr + 16 * (rg & 3) + fr];
#pragma unroll
        for (int ai = 0; ai < 2; ++ai)
#pragma unroll
            for (int m = 0; m < 4; ++m) { const int lr = 128 * ai + 64 * wr + 16 * m + fr; const float gt = gts[ai * 4 + m];
#pragma unroll
                for (int bj = 0; bj < 2; ++bj) { const int lc = 128 * bj + 32 * wc + 8 * fq;
                    const f32x4 y0 = acc[ai][bj][m][0] * gt, y1 = acc[ai][bj][m][1] * gt; u32x2 w; w.x = pk4_fp8(y0[0], y0[1], y0[2], y0[3]); w.y = pk4_fp8(y1[0], y1[1], y1[2], y1[3]);
                    *(u32x2*)((unsigned char*)O + (size_t)(u.r0 + lr) * D + u.c0 + lc) = w; } }
    }
};

__device__ __forceinline__ void tr_job(const Args& a, int j, const float*& src, int& lds_, unsigned char*& dst, int& ldd, int& f8) {
    unsigned char* ws = a.ws;
    if (j < 1024) { const int kt = j >> 5, nt = j & 31; src = a.in[1] + (size_t)kt * 64 * D + nt * 64; lds_ = D; dst = ws + WS_WIN + ((size_t)nt * 64 * D + kt * 64) * 2; ldd = D * 2; f8 = 0; return; }
    j -= 1024;
    if (j < 1024) { const int kt = j >> 5, nt = j & 31; src = a.in[14] + (size_t)kt * 64 * D + nt * 64; lds_ = D; dst = ws + WS_WOUT + ((size_t)nt * 64 * D + kt * 64) * 2; ldd = D * 2; f8 = 0; return; }
    j -= 1024;
    if (j < 256) { const int kt = j >> 4, nt = j & 15; src = a.in[12] + (size_t)kt * 64 * DS + nt * 64; lds_ = DS; dst = ws + WS_GLU + ((size_t)nt * 64 * DS + kt * 64) * 2; ldd = DS * 2; f8 = 0; return; }
    j -= 256;
    if (j < 64) { const int g = j >> 4, r = j & 15, kt = r >> 2, nt = r & 3; src = a.in[2] + (size_t)g * 65536 + kt * 64 * 256 + nt * 64; lds_ = 256; dst = ws + WS_POOLW + ((size_t)g * 65536 + nt * 64 * 256 + kt * 64) * 2; ldd = 512; f8 = 0; return; }
    j -= 64;
    if (j < 16384) { const int up = j >= 8192; if (up) j -= 8192; const int e = j >> 8, r = j & 255, kt = r >> 3, nt = r & 7, n0 = nt * 64;
        src = (up ? a.in[22] : a.in[21]) + (size_t)e * D * DE + (size_t)kt * 64 * DE + n0; lds_ = DE;
        const int drow = (n0 >> 7) * 256 + (n0 & 127) + (up ? 128 : 0);
        dst = ws + WS_WGU + ((size_t)e * 1024 + drow) * D + kt * 64; ldd = D; f8 = 1; return; }
    j -= 16384;
    { const int e = j >> 8, r = j & 255, kt = r >> 5, nt = r & 31; src = a.in[23] + (size_t)e * DE * D + (size_t)kt * 64 * D + nt * 64; lds_ = D;
      dst = ws + WS_WD + ((size_t)e * D + nt * 64) * DE + kt * 64; ldd = DE; f8 = 1; }
}
constexpr int TR_JOBS = 1024 + 1024 + 256 + 64 + 16384 + 8192;

constexpr int NGRP = TR_JOBS / 8;
constexpr int NGRP_LATE = 512;
__device__ __forceinline__ void transpose_group(const Args& a, unsigned char* lds, int jg) {
    const int tid = threadIdx.x;
    bf16_t* tl = (bf16_t*)lds;
    const int lr = tid >> 4, lc4 = (tid & 15) * 4;
    const int on = tid >> 3, okg = (tid & 7) * 8;
            f32x4 v[8][2]; unsigned char* dst[8]; int ldd[8]; int f8[8];
#pragma unroll
    for (int q = 0; q < 8; ++q) { const float* src; int ls; tr_job(a, jg + q, src, ls, dst[q], ldd[q], f8[q]);
        v[q][0] = __builtin_nontemporal_load((const f32x4*)(src + (size_t)lr * ls + lc4)); v[q][1] = __builtin_nontemporal_load((const f32x4*)(src + (size_t)(lr + 32) * ls + lc4)); }
    __syncthreads();
#pragma unroll
    for (int q = 0; q < 8; ++q) { unsigned* t0 = (unsigned*)(tl + q * 64 * 66);
        t0[(lr * 66 + lc4) >> 1] = cvt_pk_bf16(v[q][0][0], v[q][0][1]); t0[((lr * 66 + lc4) >> 1) + 1] = cvt_pk_bf16(v[q][0][2], v[q][0][3]);
        t0[((lr + 32) * 66 + lc4) >> 1] = cvt_pk_bf16(v[q][1][0], v[q][1][1]); t0[(((lr + 32) * 66 + lc4) >> 1) + 1] = cvt_pk_bf16(v[q][1][2], v[q][1][3]); }
    __syncthreads();
#pragma unroll
    for (int q = 0; q < 8; ++q) { const bf16_t* t0 = tl + q * 64 * 66; unsigned f[8];
#pragma unroll
        for (int e = 0; e < 8; ++e) f[e] = t0[(okg + e) * 66 + on];
        if (f8[q]) { u32x2 o; o.x = pk4_fp8(WSCALE * bflo(f[0]), WSCALE * bflo(f[1]), WSCALE * bflo(f[2]), WSCALE * bflo(f[3])); o.y = pk4_fp8(WSCALE * bflo(f[4]), WSCALE * bflo(f[5]), WSCALE * bflo(f[6]), WSCALE * bflo(f[7]));
            *(u32x2*)(dst[q] + (size_t)on * ldd[q] + okg) = o; }
        else { u32x4 o; o.x = f[0] | (f[1] << 16); o.y = f[2] | (f[3] << 16); o.z = f[4] | (f[5] << 16); o.w = f[6] | (f[7] << 16);
            *(u32x4*)(dst[q] + (size_t)on * ldd[q] + okg * 2) = o; } }
        }

__device__ void p0_prepass(const Args& a, unsigned char* lds, int rep) {
    const int tid = threadIdx.x, G = gridDim.x, bid = blockIdx.x;
    volatile unsigned long long* tsv = (volatile unsigned long long*)(lds + MISC_OFF + 512);
#define TSP(k) do { if ((k) == PROBE_TS_A && blockIdx.x == PROBE_BLK && threadIdx.x == 0) tsv[0] = __builtin_amdgcn_s_memrealtime(); if ((k) == PROBE_TS_B && blockIdx.x == PROBE_BLK && threadIdx.x == 0) tsv[1] = __builtin_amdgcn_s_memrealtime(); } while (0)
    TSP(40);
    unsigned char* ws = a.ws;
    if (rep == 0 || PROBE_P0PART == 1) {
        const f32x4* x4 = (const f32x4*)a.in[0]; u32x4* xb = (u32x4*)(ws + WS_XB);
        const size_t n8 = (size_t)T * D / 8, stride = (size_t)G * 512;
        for (size_t i = (size_t)bid * 512 + tid; i < n8; i += 8 * stride) {
            f32x4 v[16];
#pragma unroll
            for (int q = 0; q < 8; ++q) { const size_t ii = i + q * stride; if (ii < n8) { v[2 * q] = __builtin_nontemporal_load(x4 + 2 * ii); v[2 * q + 1] = __builtin_nontemporal_load(x4 + 2 * ii + 1); } }
#pragma unroll
            for (int q = 0; q < 8; ++q) { const size_t ii = i + q * stride; if (ii < n8) { u32x4 o; o.x = cvt_pk_bf16(v[2 * q][0], v[2 * q][1]); o.y = cvt_pk_bf16(v[2 * q][2], v[2 * q][3]);
                o.z = cvt_pk_bf16(v[2 * q + 1][0], v[2 * q + 1][1]); o.w = cvt_pk_bf16(v[2 * q + 1][2], v[2 * q + 1][3]); xb[ii] = o; } }
        }
    }
    TSP(41);
    if (rep == 0 || PROBE_P0PART == 2) {
        constexpr int NG0 = NGRP - NGRP_LATE;
        int g_lo, g_hi, g_x = -1;
        if (G == 256) { constexpr int S1 = 8, S2 = 14, REM0 = 128 * S1 + 128 * S2;
            if (bid >= 128) { g_lo = (bid - 128) * S2; g_hi = g_lo + S2; if (REM0 + (bid - 128) < NG0) g_x = REM0 + (bid - 128); }
            else { g_lo = 128 * S2 + bid * S1; g_hi = g_lo + S1; } }
        else { const int per = (NG0 + G - 1) / G; g_lo = bid * per; g_hi = g_lo + per; if (g_hi > NG0) g_hi = NG0; if (g_lo > NG0) g_lo = NG0; }
        for (int gi = g_lo; gi <= g_hi; ++gi) {
            int jg; if (gi < g_hi) jg = gi * 8; else { if (g_x < 0) break; jg = g_x * 8; }
            transpose_group(a, lds, jg);
        }
        __syncthreads();
    }
    TSP(42);
    if (rep == 0 || PROBE_P0PART == 3)
    {
        f32x2* pw = (f32x2*)lds;
        f32x2* Bb = (f32x2*)(lds + 17408);
        f32x2* Cc = (f32x2*)(lds + 17408 + 16384);
        float* KT = (float*)(lds + 17408 + 16384 + 16640);
        for (int job = bid; job < 2 * NG; job += G) {
            const int g = job >> 1, half = job & 1;
            __syncthreads();
            for (int i = tid; i < 2 * 17 * 64; i += 512) { const int dr = i / (17 * 64), l = (i >> 6) % 17, p = i & 63, ix = (dr * NG + g) * NP + p;
                const float lre = a.in[4][ix], lim = a.in[5][ix], dt = expf(a.in[6][dr * NG + g]);
                const float mg = expf(lre * dt * (float)l); float sn, cs; sincosf(lim * dt * (float)l, &sn, &cs); pw[i] = (f32x2){mg * cs, mg * sn}; }
            for (int i = tid; i < 2 * 64; i += 512) { const int dr = i >> 6, p = i & 63, ix = (dr * NG + g) * NP + p;
                const float lre = a.in[4][ix], lim = a.in[5][ix], dt = expf(a.in[6][dr * NG + g]);
                const float mg = expf(lre * dt), ar = mg * cosf(lim * dt), ai = mg * sinf(lim * dt), den = lre * lre + lim * lim;
                const float zr = ((ar - 1.0f) * lre + ai * lim) / den, zi = (ai * lre - (ar - 1.0f) * lim) / den;
#pragma unroll
                for (int c = 0; c < GC; ++c) { const float br = a.in[7][(size_t)ix * GC + c], bi = a.in[8][(size_t)ix * GC + c]; Bb[i * GC + c] = (f32x2){zr * br - zi * bi, zr * bi + zi * br}; } }
            for (int i = tid; i < 2 * GC * NP; i += 512) { const int dr = i >> 10, r = i & 1023; const size_t o = ((size_t)(dr * NG + g) * GC) * NP + r; Cc[(i >> 6) * 65 + (i & 63)] = (f32x2){a.in[9][o], a.in[10][o]}; }
            __syncthreads();
            { const int dr = tid >> 8, l = (tid >> 4) & 15, co = tid & 15; float ac[16];
#pragma unroll
              for (int c = 0; c < 16; ++c) ac[c] = 0.f;
              for (int p = 0; p < NP; ++p) { const f32x2 cv = Cc[(dr * 16 + co) * 65 + p], wv = pw[(dr * 17 + l) * 64 + p]; const float cr = cv.x * wv.x - cv.y * wv.y, ci = cv.x * wv.y + cv.y * wv.x;
                  const f32x4* bq = (const f32x4*)(Bb + (dr * 64 + p) * 16);
#pragma unroll
                  for (int c = 0; c < 8; ++c) { const f32x4 bv = bq[c]; ac[2 * c] += cr * bv[0] - ci * bv[1]; ac[2 * c + 1] += cr * bv[2] - ci * bv[3]; } }
#pragma unroll
              for (int c = 0; c < 16; ++c) KT[((dr * 16 + l) * 16 + co) * 16 + c] = ac[c]; }
            __syncthreads();
            bf16_t* w2 = (bf16_t*)(ws + WS_W2T) + (size_t)g * 256 * 512;
            for (int it = tid; it < 128 * 64; it += 512) { const int rr = it >> 6, kg = it & 63, n = half * 128 + rr, j = n >> 4, co = n & 15; float f[8];
                if (kg < 32) { const int i = kg >> 1, ci0 = (kg & 1) * 8;
#pragma unroll
                    for (int e = 0; e < 8; ++e) { const int ci = ci0 + e; float v = 0.f;
                        if (i <= j) v += KT[((0 * 16 + (j - i)) * 16 + co) * 16 + ci];
                        if (i >= j) v += KT[((1 * 16 + (i - j)) * 16 + co) * 16 + ci];
                        if (i == j && ci == co) v += a.in[11][g * GC + co];
                        f[e] = v; } }
                else { const int kk = (kg - 32) * 8, dr = kk >> 7, ri = (kk >> 6) & 1, p0 = kk & 63, ex = dr == 0 ? j + 1 : 16 - j;
#pragma unroll
                    for (int e = 0; e < 8; ++e) { const f32x2 cv = Cc[(dr * 16 + co) * 65 + p0 + e], wv = pw[(dr * 17 + ex) * 64 + p0 + e];
                        f[e] = ri == 0 ? (cv.x * wv.x - cv.y * wv.y) : -(cv.x * wv.y + cv.y * wv.x); } }
                u32x4 o; o.x = cvt_pk_bf16(f[0], f[1]); o.y = cvt_pk_bf16(f[2], f[3]); o.z = cvt_pk_bf16(f[4], f[5]); o.w = cvt_pk_bf16(f[6], f[7]);
                *(u32x4*)(w2 + (size_t)n * 512 + kg * 8) = o; }
            bf16_t* w1 = (bf16_t*)(ws + WS_W1T) + (size_t)g * 256 * 256;
            for (int it = tid; it < 128 * 32; it += 512) { const int rr = it >> 5, kg = it & 31, dr = half, ri = rr & 1, p = rr >> 1, i = kg >> 1, ci0 = (kg & 1) * 8, ex = dr == 0 ? 15 - i : i;
                const f32x2 wv = pw[(dr * 17 + ex) * 64 + p]; float f[8];
#pragma unroll
                for (int e = 0; e < 8; ++e) { const f32x2 bv = Bb[(dr * 64 + p) * 16 + ci0 + e]; f[e] = ri == 0 ? (wv.x * bv.x - wv.y * bv.y) : (wv.x * bv.y + wv.y * bv.x); }
                u32x4 o; o.x = cvt_pk_bf16(f[0], f[1]); o.y = cvt_pk_bf16(f[2], f[3]); o.z = cvt_pk_bf16(f[4], f[5]); o.w = cvt_pk_bf16(f[6], f[7]);
                *(u32x4*)(w1 + (size_t)(half * 128 + rr) * 256 + kg * 8) = o; }
            if (tid < 64) ((f32x2*)(ws + WS_SSMP + SSMP_A16))[(half * NG + g) * NP + tid] = pw[(half * 17 + 16) * 64 + tid];
        }
        __syncthreads();
    }
    TSP(43);
    {
        u32x4* rwf = (u32x4*)(ws + WS_RW);
        for (int i = bid * 512 + tid; i < 8 * 8 * 3 * 64; i += G * 512) {
            const int lane_ = i & 63, f = i >> 6, nt = f % 3, ks = (f / 3) & 7, w = f / 24, n = lane_ & 15, fq = lane_ >> 4, j = nt * 16 + n;
            float wv[8];
#pragma unroll
            for (int e = 0; e < 8; ++e) { const int k = w * 256 + ks * 32 + fq * 8 + e; wv[e] = j < 4 ? a.in[17][k * 4 + j] : (j < NR ? a.in[19][k * NE + (j - 4)] : 0.f); }
            u32x4 hi; hi.x = cvt_pk_bf16(wv[0], wv[1]); hi.y = cvt_pk_bf16(wv[2], wv[3]); hi.z = cvt_pk_bf16(wv[4], wv[5]); hi.w = cvt_pk_bf16(wv[6], wv[7]);
            rwf[(size_t)f * 64 + lane_] = hi;
        }
    }
}

template <int W>
__device__ __forceinline__ void pooldiff_item(const bf16_t* proj, bf16_t* dp, int t, int c8) {
    const int s = t & (S - 1);
    const bf16_t* base = proj + (size_t)t * D + c8;
    float sum[8];
#pragma unroll
    for (int e = 0; e < 8; ++e) sum[e] = 0.f;
    u32x4 self;
#pragma unroll
    for (int q = -W / 2; q < W / 2; ++q) { const bool ok = (s + q >= 0) && (s + q < S);
        u32x4 v = (u32x4){0u, 0u, 0u, 0u}; if (ok) v = *(const u32x4*)(base + (ptrdiff_t)q * D);
        if (q == 0) self = v;
#pragma unroll
        for (int e = 0; e < 4; ++e) { sum[2 * e] += bflo(v[e]); sum[2 * e + 1] += bfhi(v[e]); } }
    int lo = s - W / 2, hi = s + W / 2; lo = lo < 0 ? 0 : lo; hi = hi > S ? S : hi;
    const float inv = 1.0f / (float)(hi - lo);
    u32x4 o;
#pragma unroll
    for (int e = 0; e < 4; ++e) o[e] = cvt_pk_bf16(sum[2 * e] * inv - bflo(self[e]), sum[2 * e + 1] * inv - bfhi(self[e]));
    *(u32x4*)(dp + (size_t)t * DP + c8) = o;
}
__device__ void pooldiff_job(const Args& a, int job) {
    const bf16_t* proj = (const bf16_t*)(a.ws + WS_PROJ); bf16_t* dp = (bf16_t*)(a.ws + WS_DPOOL);
    const int g = job & 3, r0 = (job >> 2) * 256;
    for (int i = threadIdx.x; i < 256 * 32; i += 512) {
        const int t = r0 + (i >> 5), c8 = (g * 32 + (i & 31)) * 8;
        if (g == 0) pooldiff_item<2>(proj, dp, t, c8); else if (g == 1) pooldiff_item<4>(proj, dp, t, c8); else if (g == 2) pooldiff_item<8>(proj, dp, t, c8); else pooldiff_item<16>(proj, dp, t, c8);
    }
}

__device__ void ssm_scan(const Args& a, unsigned char* lds, int g, int b) {
    const int tid = threadIdx.x, wid = tid >> 6, lane = tid & 63, p = lane;
    unsigned char* ws = a.ws;
    const unsigned* Sb = (const unsigned*)(ws + WS_S); bf16_t* A2 = (bf16_t*)(ws + WS_A2); const f32x2* a16 = (const f32x2*)(ws + WS_SSMP + SSMP_A16);
    f32x2* F = (f32x2*)lds;
    const f32x2 Af = a16[(0 * NG + g) * NP + p], Ab = a16[(1 * NG + g) * NP + p];
    float pfr = Af.x, pfi = Af.y, pbr = Ab.x, pbi = Ab.y;
#pragma unroll
    for (int q = 0; q < 6; ++q) { const float nr = pfr * pfr - pfi * pfi, ni = 2.0f * pfr * pfi; pfr = nr; pfi = ni; const float mr = pbr * pbr - pbi * pbi, mi = 2.0f * pbr * pbi; pbr = mr; pbi = mi; }
    const unsigned* sp = Sb + ((size_t)(g * 1024 + b * 512 + wid * 64)) * 128 + p;
    float fr_ = 0.f, fi_ = 0.f, br_ = 0.f, bi_ = 0.f;
#pragma unroll 16
    for (int q = 0; q < 64; ++q) { const unsigned wf = sp[q * 128], wb = sp[(63 - q) * 128 + 64];
        const float sfr = bflo(wf), sfi = bfhi(wf), sbr = bflo(wb), sbi = bfhi(wb);
        const float nfr = Af.x * fr_ - Af.y * fi_ + sfr, nfi = Af.x * fi_ + Af.y * fr_ + sfi; fr_ = nfr; fi_ = nfi;
        const float nbr = Ab.x * br_ - Ab.y * bi_ + sbr, nbi = Ab.x * bi_ + Ab.y * br_ + sbi; br_ = nbr; bi_ = nbi; }
    __syncthreads();
    F[wid * 64 + p] = (f32x2){fr_, fi_}; F[512 + wid * 64 + p] = (f32x2){br_, bi_};
    __syncthreads();
    float cfr = 0.f, cfi = 0.f, cbr = 0.f, cbi = 0.f;
    for (int v = 0; v < wid; ++v) { const f32x2 f = F[v * 64 + p]; const float nr = pfr * cfr - pfi * cfi + f.x, ni = pfr * cfi + pfi * cfr + f.y; cfr = nr; cfi = ni; }
    for (int v = 7; v > wid; --v) { const f32x2 f = F[512 + v * 64 + p]; const float nr = pbr * cbr - pbi * cbi + f.x, ni = pbr * cbi + pbi * cbr + f.y; cbr = nr; cbi = ni; }
    fr_ = cfr; fi_ = cfi; br_ = cbr; bi_ = cbi;
    bf16_t* op = A2 + ((size_t)(g * 1024 + b * 512 + wid * 64)) * 512 + 256 + p;
#pragma unroll 16
    for (int q = 0; q < 64; ++q) { const unsigned wf = sp[q * 128], wb = sp[(63 - q) * 128 + 64];
        const float sfr = bflo(wf), sfi = bfhi(wf), sbr = bflo(wb), sbi = bfhi(wb);
        bf16_t* of = op + q * 512; bf16_t* ob = op + (63 - q) * 512 + 128;
        of[0] = (bf16_t)(cvt_pk_bf16(fr_, fr_) & 0xffffu); of[64] = (bf16_t)(cvt_pk_bf16(fi_, fi_) & 0xffffu);
        ob[0] = (bf16_t)(cvt_pk_bf16(br_, br_) & 0xffffu); ob[64] = (bf16_t)(cvt_pk_bf16(bi_, bi_) & 0xffffu);
        const float nfr = Af.x * fr_ - Af.y * fi_ + sfr, nfi = Af.x * fi_ + Af.y * fr_ + sfi; fr_ = nfr; fi_ = nfi;
        const float nbr = Ab.x * br_ - Ab.y * bi_ + sbr, nbi = Ab.x * bi_ + Ab.y * br_ + sbi; br_ = nbr; bi_ = nbi; }
}

__device__ void p5_ln1_router(const Args& a, unsigned char* lds, int rep) {
    const int tid = threadIdx.x, wid = tid >> 6, lane = tid & 63, m = lane & 15, fq = lane >> 4;
    unsigned char* ws = a.ws;
    const bf16_t* __restrict__ v1b = (const bf16_t*)(ws + WS_V1B); const float* __restrict__ stt = (const float*)(ws + WS_ST); bf16_t* __restrict__ h1b = (bf16_t*)(ws + WS_H1B); const u32x4* __restrict__ rwf = (const u32x4*)(ws + WS_RW);
    unsigned char* __restrict__ h1f8 = ws + WS_H1F8;
    if (rep) { h1b = (bf16_t*)(ws + 345 * MB); h1f8 = ws + 409 * MB; }
    const float* g1 = a.in[15]; const float* b1 = a.in[16];
    int* tok_e = (int*)(ws + WS_ROUTE + RT_E); int* tok_rank = (int*)(ws + WS_ROUTE + RT_RANK); float* tok_gate = (float*)(ws + WS_ROUTE + RT_GATE);
    float* PL = (float*)(lds + 1024);
    float* LG = (float*)(lds + 1024 + 24576);
    float* GB = (float*)(lds + 32768);
    int* EL = (int*)(lds + 512);
    unsigned char* gc = (unsigned char*)(ws + WS_GC);
    __syncthreads();
    for (int i = tid; i < D; i += 512) { GB[i] = g1[i]; GB[D + i] = b1[i]; }
    __syncthreads();
    u32x4 vn[8]; f32x4 qn[4];
    { const int grp = blockIdx.x; if (grp < T / 16) { const size_t ro = (size_t)(grp * 16 + m) * D + wid * 256 + fq * 8;
#pragma unroll
        for (int ks = 0; ks < 8; ++ks) vn[ks] = *(const u32x4*)(v1b + ro + ks * 32);
#pragma unroll
        for (int q = 0; q < 4; ++q) qn[q] = *(const f32x4*)(stt + ((size_t)(grp * 16 + m) * 32 + fq * 8) * 2 + q * 4); } }
    for (int grp = blockIdx.x; grp < T / 16; grp += gridDim.x) {
        const int t = grp * 16 + m; const size_t ro = (size_t)t * D + wid * 256 + fq * 8;
        u32x4 v[8]; f32x4 qv[4];
#pragma unroll
        for (int ks = 0; ks < 8; ++ks) v[ks] = vn[ks];
#pragma unroll
        for (int q = 0; q < 4; ++q) qv[q] = qn[q];
        float s = (qv[0][0] + qv[0][2]) + (qv[1][0] + qv[1][2]) + (qv[2][0] + qv[2][2]) + (qv[3][0] + qv[3][2]);
        float ss = (qv[0][1] + qv[0][3]) + (qv[1][1] + qv[1][3]) + (qv[2][1] + qv[2][3]) + (qv[3][1] + qv[3][3]);
        s = xor32_sum(xor16_sum(s)); ss = xor32_sum(xor16_sum(ss));
        const float mu = s * (1.0f / D); const float rstd = rsqrtf(fmaxf(ss * (1.0f / D) - mu * mu, 0.f) + LN_EPS);
        f32x4 acc[3];
#pragma unroll
        for (int nt = 0; nt < 3; ++nt) acc[nt] = (f32x4){0.f, 0.f, 0.f, 0.f};
        u32x4 wr_[3][3];
#pragma unroll
        for (int p = 0; p < 2; ++p)
#pragma unroll
            for (int q = 0; q < 3; ++q) wr_[p][q] = rwf[(size_t)((wid * 8 + p) * 3 + q) * 64 + lane];
#pragma unroll
        for (int ks = 0; ks < 8; ++ks) {
            if (ks < 6) {
#pragma unroll
                for (int q = 0; q < 3; ++q) wr_[(ks + 2) % 3][q] = rwf[(size_t)((wid * 8 + ks + 2) * 3 + q) * 64 + lane]; }
            const int kk = wid * 256 + ks * 32 + fq * 8;
            const f32x4 ga = *(const f32x4*)(GB + kk), gb = *(const f32x4*)(GB + kk + 4), ba = *(const f32x4*)(GB + D + kk), bb = *(const f32x4*)(GB + D + kk + 4);
            const f32x4 va = (f32x4){bflo(v[ks].x), bfhi(v[ks].x), bflo(v[ks].y), bfhi(v[ks].y)}, vb = (f32x4){bflo(v[ks].z), bfhi(v[ks].z), bflo(v[ks].w), bfhi(v[ks].w)};
            const f32x4 h0 = (va - mu) * rstd * ga + ba, h1 = (vb - mu) * rstd * gb + bb;
            u32x4 hi; hi.x = cvt_pk_bf16(h0[0], h0[1]); hi.y = cvt_pk_bf16(h0[2], h0[3]); hi.z = cvt_pk_bf16(h1[0], h1[1]); hi.w = cvt_pk_bf16(h1[2], h1[3]);
            *(u32x4*)(h1b + ro + ks * 32) = hi;
            { u32x2 q8; q8.x = pk4_fp8(h0[0], h0[1], h0[2], h0[3]); q8.y = pk4_fp8(h1[0], h1[1], h1[2], h1[3]); *(u32x2*)(h1f8 + ro + ks * 32) = q8; }
            u32x4 lo; lo.x = cvt_pk_bf16(h0[0] - bflo(hi.x), h0[1] - bfhi(hi.x)); lo.y = cvt_pk_bf16(h0[2] - bflo(hi.y), h0[3] - bfhi(hi.y));
            lo.z = cvt_pk_bf16(h1[0] - bflo(hi.z), h1[1] - bfhi(hi.z)); lo.w = cvt_pk_bf16(h1[2] - bflo(hi.w), h1[3] - bfhi(hi.w));
            const bf16x8 ahi = __builtin_bit_cast(bf16x8, hi), alo = __builtin_bit_cast(bf16x8, lo);
#pragma unroll
            for (int nt = 0; nt < 3; ++nt) {
                const bf16x8 whi = __builtin_bit_cast(bf16x8, wr_[ks % 3][nt]);
                acc[nt] = __builtin_amdgcn_mfma_f32_16x16x32_bf16(whi, ahi, acc[nt], 0, 0, 0);
                acc[nt] = __builtin_amdgcn_mfma_f32_16x16x32_bf16(whi, alo, acc[nt], 0, 0, 0); }
        }
        { const int gn = grp + gridDim.x; if (gn < T / 16) { const size_t rn = (size_t)(gn * 16 + m) * D + wid * 256 + fq * 8;
#pragma unroll
            for (int ks = 0; ks < 8; ++ks) vn[ks] = *(const u32x4*)(v1b + rn + ks * 32);
#pragma unroll
            for (int q = 0; q < 4; ++q) qn[q] = *(const f32x4*)(stt + ((size_t)(gn * 16 + m) * 32 + fq * 8) * 2 + q * 4); } }
#pragma unroll
        for (int nt = 0; nt < 3; ++nt) *(f32x4*)(PL + (wid * 16 + m) * 48 + nt * 16 + fq * 4) = acc[nt];
        __syncthreads();
        for (int i = tid; i < 16 * 48; i += 512) { const int mm = i / 48, j = i - mm * 48; float sm = 0.f;
#pragma unroll
            for (int w = 0; w < 8; ++w) sm += PL[(w * 16 + mm) * 48 + j];
            LG[i] = sm + (j < 4 ? a.in[18][j] : (j < NR ? a.in[20][j - 4] : 0.f)); }
        __syncthreads();
        if (tid < 16 && rep == 0) {
            const float* l = LG + tid * 48;
            const float g0 = l[0], g1v = l[1], g2 = l[2], g3 = l[3];
            int gsel = 0; float gm = g0; if (g1v > gm) { gm = g1v; gsel = 1; } if (g2 > gm) { gm = g2; gsel = 2; } if (g3 > gm) { gm = g3; gsel = 3; }
            const float pg = 1.0f / (expf(g0 - gm) + expf(g1v - gm) + expf(g2 - gm) + expf(g3 - gm));
            float el[8];
#pragma unroll
            for (int i = 0; i < 8; ++i) el[i] = l[4 + gsel * 8 + i];
            int i1 = 0; float m1 = el[0];
#pragma unroll
            for (int i = 1; i < 8; ++i) if (el[i] > m1) { m1 = el[i]; i1 = i; }
            int i2 = -1; float m2 = -3.0e38f;
#pragma unroll
            for (int i = 0; i < 8; ++i) if (i != i1 && el[i] > m2) { m2 = el[i]; i2 = i; }
            const float e2 = expf(m2 - m1), inv = 1.0f / (1.0f + e2);
            const int tt = grp * 16 + tid; const int ea = gsel * 8 + i1, eb = gsel * 8 + i2;
            EL[tid * 2] = ea; EL[tid * 2 + 1] = eb;
            tok_e[tt * 2] = ea; tok_e[tt * 2 + 1] = eb; tok_gate[tt * 2] = pg * inv; tok_gate[tt * 2 + 1] = pg * e2 * inv;
        }
        __syncthreads();
        if (tid < 32 && rep == 0) { const int me = EL[tid]; int r = 0;
            for (int q = 0; q < tid; ++q) r += (EL[q] == me) ? 1 : 0;
            tok_rank[(grp * 16) * 2 + tid] = r; }
        else if (tid >= 32 && tid < 64 && rep == 0) { const int e = tid - 32; int c = 0;
#pragma unroll
            for (int q = 0; q < 32; ++q) c += (EL[q] == e) ? 1 : 0;
            gc[grp * 32 + e] = (unsigned char)c; }
    }
    __syncthreads();
}

__device__ __forceinline__ void moe_build_tab(const Args& a, int* tstart) {
    if (threadIdx.x == 0) { const unsigned* cnt = (const unsigned*)(a.ws + WS_CTL); int acc = 0;
        for (int e = 0; e < NE; ++e) { tstart[e] = acc; acc += ((int)__hip_atomic_load(cnt + e, __ATOMIC_RELAXED, __HIP_MEMORY_SCOPE_AGENT) + 255) >> 8; }
        tstart[NE] = acc; }
    __syncthreads();
    if ((int)threadIdx.x < tstart[NE]) tstart[256 + threadIdx.x] = moe_expert_of_tile(tstart, (int)threadIdx.x);
    __syncthreads();
}

__device__ void p6_slots(const Args& a, unsigned char* lds, int* tstart) {
    const int tid = threadIdx.x;
    unsigned char* ws = a.ws;
    const int* tok_e = (const int*)(ws + WS_ROUTE + RT_E); const int* tok_rank = (const int*)(ws + WS_ROUTE + RT_RANK); const float* tok_gate = (const float*)(ws + WS_ROUTE + RT_GATE);
    int* slot_tok = (int*)(ws + WS_ROUTE + RT_STOK); float* slot_gate = (float*)(ws + WS_ROUTE + RT_SGATE); int* tok_slot = (int*)(ws + WS_ROUTE + RT_SGATE + (size_t)MAXTILES * 256 * 4);
    unsigned char* GC = lds;
    unsigned short* BASE = (unsigned short*)(lds + 32768);
    int* CS = (int*)(lds + 98304);
    int* CNT = (int*)(lds + 98304 + 2048);
    __syncthreads();
    { const u32x4* src = (const u32x4*)(ws + WS_GC); u32x4* dst = (u32x4*)GC;
#pragma unroll
      for (int q = 0; q < 4; ++q) dst[tid + q * 512] = src[tid + q * 512]; }
    __syncthreads();
    const int e = tid & 31, c = tid >> 5;
    { int sm = 0; for (int g = c * 64; g < c * 64 + 64; ++g) sm += GC[g * 32 + e]; CS[e * 16 + c] = sm; }
    __syncthreads();
    if (tid < 32) { int run = 0; for (int q = 0; q < 16; ++q) { const int tmp = CS[tid * 16 + q]; CS[tid * 16 + q] = run; run += tmp; } CNT[tid] = run; }
    __syncthreads();
    if (tid == 0) { int acc = 0; for (int q = 0; q < NE; ++q) { tstart[q] = acc; acc += (CNT[q] + 255) >> 8; } tstart[NE] = acc; }
    __syncthreads();
    if (tid < tstart[NE]) tstart[256 + tid] = moe_expert_of_tile(tstart, tid);
    if (blockIdx.x == 0 && tid < 32) ((unsigned*)(ws + WS_CTL))[tid] = (unsigned)CNT[tid];
    { int run = CS[e * 16 + c]; for (int g = c * 64; g < c * 64 + 64; ++g) { BASE[g * 32 + e] = (unsigned short)run; run += GC[g * 32 + e]; } }
    __syncthreads();
    for (int i = blockIdx.x * 512 + tid; i < T * 2; i += gridDim.x * 512) {
        const int ee = tok_e[i], s = tstart[ee] * 256 + (int)BASE[(i >> 5) * 32 + ee] + tok_rank[i]; slot_tok[s] = i >> 1; slot_gate[s] = tok_gate[i]; tok_slot[i] = s; }
    const int ns = tstart[NE] * 256;
    for (int s = blockIdx.x * 512 + tid; s < ns; s += gridDim.x * 512) {
        const int ee = moe_expert_of_tile(tstart, s >> 8); const int r = s - tstart[ee] * 256;
        if (r >= CNT[ee]) { slot_tok[s] = -1; slot_gate[s] = 0.f; } }
    __syncthreads();
}

__device__ __forceinline__ void fp8x8_acc(const u32x2 w, float (&f)[8]) {
    const f32x2 a = __builtin_amdgcn_cvt_pk_f32_fp8((int)w.x, false), b = __builtin_amdgcn_cvt_pk_f32_fp8((int)w.x, true), c = __builtin_amdgcn_cvt_pk_f32_fp8((int)w.y, false), d = __builtin_amdgcn_cvt_pk_f32_fp8((int)w.y, true);
    f[0] += a[0]; f[1] += a[1]; f[2] += b[0]; f[3] += b[1]; f[4] += c[0]; f[5] += c[1]; f[6] += d[0]; f[7] += d[1];
}
__device__ void p9_ln2(const Args& a, const int* tstart, int rep) {
    const int tid = threadIdx.x, wid = tid >> 6, lane = tid & 63;
    const float* g2 = a.in[24]; const float* b2 = a.in[25];
    const unsigned char* ys = a.ws + WS_YS; const bf16_t* h1b = (const bf16_t*)(a.ws + WS_H1B);
    const int* tok_slot = (const int*)(a.ws + WS_ROUTE + RT_SGATE + (size_t)MAXTILES * 256 * 4);
    const int nw = gridDim.x * 8;
    for (int t = blockIdx.x * 8 + wid; t < T; t += nw) {
        float* roww = rep == 0 ? a.out + (size_t)t * D : (float*)(a.ws + 25 * MB) + (size_t)(t & 4095) * D;
        const size_t sa = (size_t)tok_slot[t * 2] * D, sb = (size_t)tok_slot[t * 2 + 1] * D;
        float h[4][8]; float s = 0.f;
#pragma unroll
        for (int i = 0; i < 4; ++i) { const int k = i * 512 + lane * 8;
            const u32x4 hv = *(const u32x4*)(h1b + (size_t)t * D + k);
            const u32x2 ya = *(const u32x2*)(ys + sa + k), yb = *(const u32x2*)(ys + sb + k);
            float y[8];
#pragma unroll
            for (int e = 0; e < 8; ++e) y[e] = 0.f;
            fp8x8_acc(ya, y); fp8x8_acc(yb, y);
#pragma unroll
            for (int e = 0; e < 4; ++e) { h[i][2 * e] = ALPHA * bflo(hv[e]) + YSCALE_INV * y[2 * e]; h[i][2 * e + 1] = ALPHA * bfhi(hv[e]) + YSCALE_INV * y[2 * e + 1]; }
#pragma unroll
            for (int e = 0; e < 8; ++e) s += h[i][e]; }
        const float mu = wave_sum(s) * (1.0f / D); float vq = 0.f;
#pragma unroll
        for (int i = 0; i < 4; ++i)
#pragma unroll
            for (int e = 0; e < 8; ++e) { const float d = h[i][e] - mu; vq += d * d; }
        const float rstd = rsqrtf(wave_sum(vq) * (1.0f / D) + LN_EPS);
#pragma unroll
        for (int i = 0; i < 4; ++i) { const int k = i * 512 + lane * 8;
            const f32x4 ga = *(const f32x4*)(g2 + k), gb = *(const f32x4*)(g2 + k + 4), ba = *(const f32x4*)(b2 + k), bb = *(const f32x4*)(b2 + k + 4);
            f32x4 o0, o1;
#pragma unroll
            for (int e = 0; e < 4; ++e) { o0[e] = (h[i][e] - mu) * rstd * ga[e] + ba[e]; o1[e] = (h[i][4 + e] - mu) * rstd * gb[e] + bb[e]; }
            *(f32x4*)(roww + k) = o0; *(f32x4*)(roww + k + 4) = o1; }
    }
}

constexpr int NPHASE = 10;
__global__ void __launch_bounds__(512, 2) fwd(Args a) {
    extern __shared__ __attribute__((aligned(16))) unsigned char lds[];
    cg::grid_group grid = cg::this_grid();
    unsigned char* ws = a.ws;
    int* tstart = (int*)(lds + MISC_OFF);
    volatile LAS unsigned* bst = (volatile LAS unsigned*)((LAS unsigned char*)lds + MISC_OFF + 256);
    if (threadIdx.x < 4) bst[threadIdx.x] = 0u;
    __syncthreads();
    XcdBarrier xbar = xcd_barrier_post((unsigned*)(ws + WS_BAR), bst);
    if (a.ph_hi > 1000) grid.sync();
#define IN(k) (a.ph_lo <= (k) && (k) < a.ph_hi)
    volatile unsigned long long* tsv = (volatile unsigned long long*)(lds + MISC_OFF + 512);
#define TS_START(k) do { if ((k) == PROBE_TS_A && blockIdx.x == PROBE_BLK && threadIdx.x == 0) tsv[0] = __builtin_amdgcn_s_memrealtime(); } while (0)
#define TS_END(k) do { if ((k) == PROBE_TS_B && blockIdx.x == PROBE_BLK && threadIdx.x == 0) tsv[1] = __builtin_amdgcn_s_memrealtime(); } while (0)
#define SEAM(k) do { if (IN(k) && IN((k) + 1)) xcd_barrier(xbar); } while (0)
    for (int q = 0; q < PROBE_SYNC; ++q) xcd_barrier(xbar);
    TS_START(0);
    if (IN(0)) for (int rep = 0; rep < (0 == PROBE_PHASE ? PROBE_REP : 1); ++rep) p0_prepass(a, lds, rep);
    SEAM(0); TS_END(0);
    TS_START(1);
    if (IN(1)) { DescProj d{(const char*)(ws + WS_XB), (const char*)(ws + WS_WIN), (bf16_t*)(ws + WS_PROJ), (bf16_t*)(ws + WS_A2), D, D}; gemm_run<0>(lds, d); }
    SEAM(1); TS_END(1);
    TS_START(2);
    if (IN(2)) {
        const int G_ = (int)gridDim.x, nS = 128, nP_ = G_ - nS, bx = (int)blockIdx.x;
        if (bx < nS) {
            const int job = bx;
            TS_START(20);
            { DescS1 d{(const char*)(ws + WS_A2), (const char*)(ws + WS_W1T), (bf16_t*)(ws + WS_S), job, 256, 256}; gemm_run<6>(lds, d);
              if (PROBE_DUP) { asm volatile("s_waitcnt vmcnt(0)" ::: "memory"); __syncthreads(); TS_START(30); for (int q = 0; q < PROBE_DUP; ++q) gemm_run<6>(lds, d); TS_END(30); } }
            asm volatile("s_waitcnt vmcnt(0)" ::: "memory"); __syncthreads(); TS_END(21); TS_START(21);
            ssm_scan(a, lds, job >> 1, job & 1);
            asm volatile("s_waitcnt vmcnt(0)" ::: "memory"); __syncthreads(); TS_END(22); TS_START(22);
            { DescS2 d{(const char*)(ws + WS_A2), (const char*)(ws + WS_W2T), (bf16_t*)(ws + WS_YSSM), job, 512, 512}; gemm_run<7>(lds, d); }
            TS_END(23);
        } else {
            const int pb = bx - nS;
            TS_START(24);
            for (int j = pb; j < 256; j += nP_) pooldiff_job(a, j);
            asm volatile("s_waitcnt vmcnt(0)" ::: "memory"); __syncthreads(); TS_END(24); TS_START(25);
            { DescPool d{(const char*)(ws + WS_DPOOL), (const char*)(ws + WS_POOLW), (bf16_t*)(ws + WS_CC), a.in[3], pb, nP_, 256, 256}; gemm_run<1>(lds, d); }
            TS_END(25);
            for (int gi = (NGRP - NGRP_LATE) + pb; gi < NGRP; gi += nP_) transpose_group(a, lds, gi * 8);
            __syncthreads();
        }
    }
    SEAM(2); TS_END(2);
    TS_START(3);
    if (IN(3)) { DescGlu d{(const char*)(ws + WS_YSSM), (const char*)(ws + WS_GLU), (bf16_t*)(ws + WS_CC), a.in[13], DS, DS}; gemm_run<2>(lds, d); }
    SEAM(3); TS_END(3);
    TS_START(4);
    if (IN(4)) { DescOut d{(const char*)(ws + WS_CC), (const char*)(ws + WS_WOUT), (bf16_t*)(ws + WS_V1B), (const bf16_t*)(ws + WS_XB), (float*)(ws + WS_ST), D, D}; gemm_run<3>(lds, d); }
    SEAM(4); TS_END(4);
    TS_START(5);
    if (IN(5)) for (int rep = 0; rep < (5 == PROBE_PHASE ? PROBE_REP : 1); ++rep) p5_ln1_router(a, lds, rep);
    SEAM(5); TS_END(5);
    TS_START(6);
    if (IN(6)) { for (int rep = 0; rep < (6 == PROBE_PHASE ? PROBE_REP : 1); ++rep) p6_slots(a, lds, tstart); }
    SEAM(6); TS_END(6);
    TS_START(7);
    if (IN(7)) { moe_build_tab(a, tstart);
        int* utab = (int*)(lds + UTAB_OFF); const int* slot_tok = (const int*)(ws + WS_ROUTE + RT_STOK);
        for (int k = 0; k < 8; ++k) { int tile, pn; if (!moe_order(tstart[NE], 4, (int)blockIdx.x + k * (int)gridDim.x, tile, pn)) break;
            if (threadIdx.x < 256) { const int t = slot_tok[tile * 256 + threadIdx.x]; utab[k * 256 + threadIdx.x] = t < 0 ? 0 : t; } }
        __syncthreads();
        DescGU d{(const char*)(ws + WS_H1F8), (const char*)(ws + WS_WGU), (bf16_t*)(ws + WS_HH), utab, tstart, D / 2, D / 2}; gemm_run<4>(lds, d); }
    SEAM(7); TS_END(7);
    TS_START(8);
    if (IN(8)) { moe_build_tab(a, tstart);
        float* gtab = (float*)(lds + UTAB_OFF); const float* slot_gate = (const float*)(ws + WS_ROUTE + RT_SGATE);
        for (int k = 0; k < 8; ++k) { int tile, pn; if (!moe_order(tstart[NE], 8, (int)blockIdx.x + k * (int)gridDim.x, tile, pn)) break;
            if (threadIdx.x < 256) gtab[k * 256 + threadIdx.x] = slot_gate[tile * 256 + threadIdx.x] * (WSCALE_INV * YSCALE); }
        __syncthreads();
        DescDown d{(const char*)(ws + WS_HH), (const char*)(ws + WS_WD), (bf16_t*)(ws + WS_YS), gtab, tstart, DE / 2, DE / 2}; gemm_run<5>(lds, d); }
    SEAM(8); TS_END(8);
    TS_START(9);
    if (IN(9)) { moe_build_tab(a, tstart); for (int rep = 0; rep < (9 == PROBE_PHASE ? PROBE_REP : 1); ++rep) p9_ln2(a, tstart, rep); }
    TS_END(9);
    if (PROBE_TS_A >= 0 && blockIdx.x == PROBE_BLK && threadIdx.x == 0) { const unsigned long long dt = tsv[1] - tsv[0], te = __builtin_amdgcn_s_memrealtime(); while (__builtin_amdgcn_s_memrealtime() - te < 4ull * dt) __builtin_amdgcn_s_sleep(32); }
#undef IN
#undef SEAM
}

extern "C" void kernel_launch(void* const* d_in, const int* in_sizes, int n_in, void* d_out, int out_size, void* d_ws, size_t ws_size, hipStream_t stream) {
    static int grid = 0;
    if (grid == 0) {
        if (n_in != 26 || out_size != T * D || ws_size < WS_END) { fprintf(stderr, "kernel_launch: unexpected shapes (n_in %d out %d ws %zu)\n", n_in, out_size, ws_size); grid = -1; return; }
        int dev = 0, cus = 0, per_cu = 0;
        (void)hipGetDevice(&dev); (void)hipDeviceGetAttribute(&cus, hipDeviceAttributeMultiprocessorCount, dev);
        (void)hipFuncSetAttribute((const void*)fwd, hipFuncAttributeMaxDynamicSharedMemorySize, LDS_BYTES);
        (void)hipOccupancyMaxActiveBlocksPerMultiprocessor(&per_cu, (const void*)fwd, 512, LDS_BYTES);
        if (per_cu < 1) { fprintf(stderr, "kernel_launch: occupancy query says %d blocks/CU\n", per_cu); per_cu = 1; }
        grid = cus;
        if (grid < 256) { fprintf(stderr, "kernel_launch: built for >= 256 CUs (got %d)\n", grid); grid = -1; return; }
    }
    if (grid < 0) return;
    (void)hipMemsetAsync((char*)d_ws + WS_CTL, 0, CTL_ZERO_BYTES, stream);
    Args a{};
    for (int i = 0; i < 26; ++i) a.in[i] = (const float*)d_in[i];
    a.out = (float*)d_out; a.ws = (unsigned char*)d_ws;
#if N_LAUNCH_MODE == 0
    a.ph_lo = 0; a.ph_hi = NPHASE;
    void* args[] = {&a};
    hipError_t e = hipLaunchCooperativeKernel((const void*)fwd, dim3(grid), dim3(512), args, LDS_BYTES, stream);
    if (e != hipSuccess) fprintf(stderr, "cooperative launch failed: %s (grid %d)\n", hipGetErrorString(e), grid);
#else
    for (int p = 0; p < NPHASE; ++p) { a.ph_lo = p; a.ph_hi = p + 1; hipLaunchKernelGGL(fwd, dim3(grid), dim3(512), LDS_BYTES, stream, a); }
#endif
}
```
